# Optimizing an MI355X kernel written in HIP

```python
import math
import jax, jax.numpy as jnp
from jax import lax
import numpy as np

D_MODEL = 1024
BATCH = 16
SEQ = 4096
DEPTH = 4
DEC_BATCH = 8
DEC_SEQ = 4096
PAST_LEN = 128

GRID_W = 64
QBLK = 128
D_PLE = 256
EPS = 1e-6

H_A = 4
DH_A = 64
W_A = H_A * 2 * DH_A
H_B = 8
KV_B = 2
REP_B = H_B // KV_B
DH_B = 64
W_B = H_B * DH_B
ROPE_THETA = 10000.0
H_C = 8
DH_C = 64
W_C = H_C * DH_C
NA_ROWS = 8
NA_COLS = 16
T5_BUCKETS = 32
T5_MAX_DIST = 128

IN_SIZES = (
    2 * H_A * DH_A, 2 * H_A * DH_A, W_A, W_A,
    W_B, KV_B * DH_B, KV_B * DH_B, W_B,
    W_C, W_C, W_C, W_C,
    3 * D_MODEL,
)
IN_W = sum(IN_SIZES)

kernel_name = "hybrid_diff_gqa_natten_encoder"


def rms_norm(x, g):
    x32 = x.astype(jnp.float32)
    y = x32 * lax.rsqrt(jnp.mean(x32 * x32, axis=-1, keepdims=True) + EPS)
    return (y * g.astype(jnp.float32)).astype(x.dtype)


def to_blocks(t):
    b, s = t.shape[:2]
    return jnp.moveaxis(t.reshape(b, s // QBLK, QBLK, *t.shape[2:]), 1, 0)


def from_blocks(t):
    nb, b, q = t.shape[:3]
    return jnp.moveaxis(t, 0, 1).reshape(b, nb * q, *t.shape[3:])


def t5_bucket(rel):
    nb = T5_BUCKETS // 2
    ret = jnp.where(rel > 0, nb, 0)
    n = jnp.abs(rel)
    max_exact = nb // 2
    nf = jnp.maximum(n, 1).astype(jnp.float32)
    large = max_exact + (jnp.log(nf / max_exact) / math.log(T5_MAX_DIST / max_exact)
                         * (nb - max_exact)).astype(jnp.int32)
    large = jnp.minimum(large, nb - 1)
    return ret + jnp.where(n < max_exact, n, large)


def axial_rope_tables(s):
    t = jnp.arange(s)
    row = (t // GRID_W).astype(jnp.float32)
    col = (t % GRID_W).astype(jnp.float32)
    n_freq = DH_B // 4
    inv = ROPE_THETA ** (-jnp.arange(n_freq, dtype=jnp.float32) / n_freq)
    ang = jnp.stack([row[:, None] * inv, col[:, None] * inv], axis=1)
    ang = jnp.stack([ang, ang], axis=2)
    return jnp.cos(ang), jnp.sin(ang)


def apply_axial_rope(x, cos, sin):
    shp = x.shape
    xr = x.reshape(*shp[:-1], 2, 2, DH_B // 4)
    rot = jnp.stack([-xr[..., 1, :], xr[..., 0, :]], axis=-2)
    c = cos[None, :, None].astype(x.dtype)
    s = sin[None, :, None].astype(x.dtype)
    return (xr * c + rot * s).reshape(shp)


def diff_attention(q, k, v, lam, lambda_init, subln_g, rel_bias):
    b, s = q.shape[:2]
    scale = DH_A ** -0.5
    kpos = jnp.arange(s)

    def block(args):
        qb, bi = args
        qpos = bi * QBLK + jnp.arange(QBLK)
        bias = rel_bias[kpos[None, :] - qpos[:, None] + s - 1]
        bias = jnp.transpose(bias, (2, 3, 0, 1))
        logits = jnp.einsum('bqhmd,bkhmd->bhmqk', qb, k).astype(jnp.float32) * scale + bias
        p = jax.nn.softmax(logits, axis=-1)
        attn = (p[:, :, 0] - lam * p[:, :, 1]).astype(v.dtype)
        return jnp.einsum('bhqk,bkhe->bqhe', attn, v)

    o = from_blocks(lax.map(block, (to_blocks(q), jnp.arange(s // QBLK))))
    o = rms_norm(o, subln_g) * (1.0 - lambda_init)
    return o.reshape(b, s, W_A)


def gqa_attention(q, k, v):
    b, s = q.shape[:2]
    scale = DH_B ** -0.5

    def block(qb):
        logits = jnp.einsum('bqgrd,bkgd->bgrqk', qb, k).astype(jnp.float32) * scale
        p = jax.nn.softmax(logits, axis=-1).astype(v.dtype)
        return jnp.einsum('bgrqk,bkgd->bqgrd', p, v)

    o = from_blocks(lax.map(block, to_blocks(q)))
    return o.reshape(b, s, W_B)


def neighbourhood_attention(q, k, v, rpb):
    b, s = q.shape[:2]
    rows = s // GRID_W
    wr = min(NA_ROWS, rows)
    band = min(wr + QBLK // GRID_W - 1, rows)
    scale = DH_C ** -0.5
    kg = k.reshape(b, rows, GRID_W, H_C, DH_C)
    vg = v.reshape(b, rows, GRID_W, H_C, DH_C)
    kc = jnp.tile(jnp.arange(GRID_W), band)
    kr_off = jnp.repeat(jnp.arange(band), GRID_W)

    def block(args):
        qb, bi = args
        t = bi * QBLK + jnp.arange(QBLK)
        qr = t // GRID_W
        qc = t % GRID_W
        sr = jnp.clip(qr - wr // 2, 0, rows - wr)
        sc = jnp.clip(qc - NA_COLS // 2, 0, GRID_W - NA_COLS)
        b0 = jnp.clip(sr[0], 0, rows - band)
        kb = lax.dynamic_slice_in_dim(kg, b0, band, axis=1).reshape(b, band * GRID_W, H_C, DH_C)
        vb = lax.dynamic_slice_in_dim(vg, b0, band, axis=1).reshape(b, band * GRID_W, H_C, DH_C)
        kr = b0 + kr_off
        mask = ((kr[None] >= sr[:, None]) & (kr[None] < (sr + wr)[:, None])
                & (kc[None] >= sc[:, None]) & (kc[None] < (sc + NA_COLS)[:, None]))
        ri = jnp.clip(kr[None] - qr[:, None] + NA_ROWS - 1, 0, 2 * NA_ROWS - 2)
        ci = jnp.clip(kc[None] - qc[:, None] + NA_COLS - 1, 0, 2 * NA_COLS - 2)
        bias = rpb[:, ri, ci].astype(jnp.float32)
        logits = jnp.einsum('bqhd,bkhd->bhqk', qb, kb).astype(jnp.float32) * scale + bias
        logits = jnp.where(mask, logits, -jnp.inf)
        p = jax.nn.softmax(logits, axis=-1).astype(vb.dtype)
        return jnp.einsum('bhqk,bkhd->bqhd', p, vb)

    o = from_blocks(lax.map(block, (to_blocks(q), jnp.arange(s // QBLK))))
    return o.reshape(b, s, W_C)


def mixer_layer(x, p_i, layer_idx, pre_g, w_in, lam_p, subln_g, qn_g, kn_g, rpb,
                wa, wb, wc, w_out, post_g, w_pe, w_pg, rel_bias, rope_cos, rope_sin):
    b, s, _ = x.shape
    h = rms_norm(x, pre_g)
    u = h @ w_in
    split_points = np.cumsum(IN_SIZES)[:-1].tolist()
    aq, ak, av, ag, bq, bk, bv, bg, cq, ck, cv, cg, mg = jnp.split(u, split_points, axis=-1)

    lambda_init = 0.8 - 0.6 * math.exp(-0.3 * layer_idx)
    lp = lam_p.astype(jnp.float32)
    lam = jnp.exp(jnp.sum(lp[0] * lp[1])) - jnp.exp(jnp.sum(lp[2] * lp[3])) + lambda_init
    ya = diff_attention(aq.reshape(b, s, H_A, 2, DH_A), ak.reshape(b, s, H_A, 2, DH_A),
                        av.reshape(b, s, H_A, 2 * DH_A), lam, lambda_init, subln_g, rel_bias)
    ya = ya * jax.nn.silu(ag)

    qh = apply_axial_rope(rms_norm(bq.reshape(b, s, H_B, DH_B), qn_g), rope_cos, rope_sin)
    kh = apply_axial_rope(rms_norm(bk.reshape(b, s, KV_B, DH_B), kn_g), rope_cos, rope_sin)
    yb = gqa_attention(qh.reshape(b, s, KV_B, REP_B, DH_B), kh, bv.reshape(b, s, KV_B, DH_B))
    yb = yb * jax.nn.silu(bg)

    yc = neighbourhood_attention(cq.reshape(b, s, H_C, DH_C), ck.reshape(b, s, H_C, DH_C),
                                 cv.reshape(b, s, H_C, DH_C), rpb)
    yc = yc * jax.nn.silu(cg)

    gates = jax.nn.sigmoid(mg).reshape(b, s, 3, D_MODEL)
    m = gates[:, :, 0] * (ya @ wa) + gates[:, :, 1] * (yb @ wb) + gates[:, :, 2] * (yc @ wc)
    x = x + rms_norm(m @ w_out, post_g)

    x = x + jax.nn.sigmoid(x @ w_pg) * (p_i @ w_pe)
    return x


def trunk(x, p, t5_table, pre_norm_g, w_in, lambda_qk, subln_g, q_norm_g, k_norm_g, na_rpb,
          w_branch_a, w_branch_b, w_branch_c, w_out, post_norm_g, w_ple_proj, w_ple_gate):
    s = x.shape[1]
    rel = jnp.arange(-(s - 1), s)
    rel_bias = t5_table[t5_bucket(rel)].astype(jnp.float32).reshape(2 * s - 1, H_A, 2)
    rope_cos, rope_sin = axial_rope_tables(s)
    for i in range(DEPTH):
        x = mixer_layer(x, p[i], i, pre_norm_g[i], w_in[i], lambda_qk[i], subln_g[i],
                        q_norm_g[i], k_norm_g[i], na_rpb[i], w_branch_a[i], w_branch_b[i],
                        w_branch_c[i], w_out[i], post_norm_g[i], w_ple_proj[i], w_ple_gate[i],
                        rel_bias, rope_cos, rope_sin)
    return x


def setup_inputs(seed: int = 0) -> dict:
    key = jax.random.key(seed)
    ks = jax.random.split(key, 20)
    f32 = jnp.float32

    def nrm(k, shape, scale):
        return jax.random.normal(k, shape, f32) * scale

    return {
        "x_prompt": nrm(ks[0], (BATCH, SEQ, D_MODEL), 1.0),
        "x_sample": nrm(ks[1], (DEC_BATCH, DEC_SEQ, D_MODEL), 1.0),
        "p_prompt": nrm(ks[2], (DEPTH, BATCH, SEQ, D_PLE), 1.0),
        "p_sample": nrm(ks[3], (DEPTH, DEC_BATCH, DEC_SEQ, D_PLE), 1.0),
        "t5_table": nrm(ks[4], (T5_BUCKETS, 2 * H_A), 0.2),
        "pre_norm_g": 1.0 + nrm(ks[5], (DEPTH, D_MODEL), 0.1),
        "w_in": nrm(ks[6], (DEPTH, D_MODEL, IN_W), D_MODEL ** -0.5),
        "lambda_qk": nrm(ks[7], (DEPTH, 4, DH_A), 0.1),
        "subln_g": 1.0 + nrm(ks[8], (DEPTH, 2 * DH_A), 0.1),
        "q_norm_g": 1.0 + nrm(ks[9], (DEPTH, DH_B), 0.1),
        "k_norm_g": 1.0 + nrm(ks[10], (DEPTH, DH_B), 0.1),
        "na_rpb": nrm(ks[11], (DEPTH, H_C, 2 * NA_ROWS - 1, 2 * NA_COLS - 1), 0.2),
        "w_branch_a": nrm(ks[12], (DEPTH, W_A, D_MODEL), W_A ** -0.5),
        "w_branch_b": nrm(ks[13], (DEPTH, W_B, D_MODEL), W_B ** -0.5),
        "w_branch_c": nrm(ks[14], (DEPTH, W_C, D_MODEL), W_C ** -0.5),
        "w_out": nrm(ks[15], (DEPTH, D_MODEL, D_MODEL), D_MODEL ** -0.5),
        "post_norm_g": 1.0 + nrm(ks[16], (DEPTH, D_MODEL), 0.1),
        "w_ple_proj": nrm(ks[17], (DEPTH, D_PLE, D_MODEL), D_PLE ** -0.5),
        "w_ple_gate": nrm(ks[18], (DEPTH, D_MODEL, D_MODEL), D_MODEL ** -0.5),
    }


def reference(x_prompt, x_sample, p_prompt, p_sample, t5_table, pre_norm_g, w_in, lambda_qk,
              subln_g, q_norm_g, k_norm_g, na_rpb, w_branch_a, w_branch_b, w_branch_c, w_out,
              post_norm_g, w_ple_proj, w_ple_gate):
    y_prompt = trunk(x_prompt, p_prompt, t5_table, pre_norm_g, w_in, lambda_qk, subln_g,
                     q_norm_g, k_norm_g, na_rpb, w_branch_a, w_branch_b, w_branch_c, w_out,
                     post_norm_g, w_ple_proj, w_ple_gate)
    y_sample = trunk(x_sample, p_sample, t5_table, pre_norm_g, w_in, lambda_qk, subln_g,
                     q_norm_g, k_norm_g, na_rpb, w_branch_a, w_branch_b, w_branch_c, w_out,
                     post_norm_g, w_ple_proj, w_ple_gate)
    return (y_prompt, y_sample)
```

```cpp
#include <hip/hip_runtime.h>
#include <hip/hip_cooperative_groups.h>
#include <stdint.h>
#include <stdio.h>
namespace cg = cooperative_groups;

typedef unsigned short bf16_t;
typedef short bf16x8 __attribute__((ext_vector_type(8)));
typedef short s16x4 __attribute__((ext_vector_type(4)));
typedef float f32x16 __attribute__((ext_vector_type(16)));
typedef float f32x4 __attribute__((ext_vector_type(4)));
typedef float f32x2 __attribute__((ext_vector_type(2)));
typedef __bf16 bf16x2_t __attribute__((ext_vector_type(2)));
typedef unsigned u32x4 __attribute__((ext_vector_type(4)));
typedef unsigned u32x2 __attribute__((ext_vector_type(2)));
#define DI __device__ __forceinline__
#define LDSAS __attribute__((address_space(3)))

constexpr int DM = 1024, SEQ = 4096, NL = 4, INW = 8448, DPLE = 256;
constexpr int G = 4;
constexpr int NG = 24 / G;
constexpr int TG = G * SEQ;
constexpr float EPS = 1e-6f;
constexpr float LOG2E = 1.4426950408889634f;
constexpr int C_AQ = 0, C_AK = 512, C_AV = 1024, C_AG = 1536, C_BQ = 2048, C_BK = 2560, C_BV = 2688, C_BG = 2816,
              C_CQ = 3328, C_CK = 3840, C_CV = 4352, C_CG = 4864, C_MG = 5376;
constexpr size_t WS_ROPE = 4096;
constexpr size_t WS_WIN = 16384;
constexpr size_t WS_WBR = WS_WIN + (size_t)NL * INW * DM * 2;
constexpr size_t WS_WOUT = WS_WBR + (size_t)NL * 3 * DM * 512 * 2;
constexpr size_t WS_WPG = WS_WOUT + (size_t)NL * DM * DM * 2;
constexpr size_t WS_WPE = WS_WPG + (size_t)NL * DM * DM * 2;
constexpr size_t WS_U = WS_WPE + (size_t)NL * DM * DPLE * 2;
constexpr size_t WS_H = WS_U + (size_t)TG * INW * 2;
constexpr size_t WS_OA = WS_H + (size_t)TG * DM * 2;
constexpr size_t WS_Y = WS_OA + (size_t)TG * DM * 2;
constexpr size_t WS_M = WS_Y + (size_t)TG * 1536 * 2;
constexpr size_t WS_Z = WS_M + (size_t)TG * DM * 2;
constexpr size_t WS_END = WS_Z + (size_t)TG * DM * 4;

struct Params {
  const float* in[19];
  float* out;
  unsigned char* ws;
  float lambda_init[4];
};

DI unsigned pk_bf16(float lo, float hi) { f32x2 v = {lo, hi}; bf16x2_t b = __builtin_convertvector(v, bf16x2_t); return __builtin_bit_cast(unsigned, b); }
DI float bf2f(unsigned short b) { return __uint_as_float(((unsigned)b) << 16); }
DI float bflo(unsigned w) { return __uint_as_float(w << 16); }
DI float bfhi(unsigned w) { return __uint_as_float(w & 0xffff0000u); }
DI unsigned short f2bf(float f) { return (unsigned short)(pk_bf16(f, 0.f) & 0xffffu); }
DI float wave_sum(float v) {
#pragma unroll
  for (int o = 32; o >= 1; o >>= 1) v += __shfl_xor(v, o);
  return v;
}
DI float sigmoidf_(float x) { return 1.0f / (1.0f + __expf(-x)); }
DI float siluf_(float x) { return x / (1.0f + __expf(-x)); }
DI int opaque_tid() { int t = threadIdx.x; asm volatile("" : "+v"(t)); return t; }
DI int crow(int i, int h) { return (i & 3) + 8 * (i >> 2) + 4 * h; }
#define MFMA32(a, b, c) __builtin_amdgcn_mfma_f32_32x32x16_bf16((a), (b), (c), 0, 0, 0)

DI void dma16(const void* gsrc, char* lds_wave_base) {
  __builtin_amdgcn_global_load_lds((const unsigned*)gsrc, (LDSAS unsigned*)lds_wave_base, 16, 0, 0);
}
template <bool A_F32>
DI void gemm_acc(f32x16 (&acc)[2][2], const void* Aptr, int lda, const bf16_t* Wt, int ldw, int K, char* smem) {
  const int tid = opaque_tid(), lane = tid & 63, wave = __builtin_amdgcn_readfirstlane(tid >> 6), wr = wave >> 1, wc = wave & 1, r32 = lane & 31, h = lane >> 5;
  const int drow = wave * 8 + (lane >> 3);
  const int dch = (lane & 7) ^ ((drow >> 1) & 7);
  const bf16_t* wsrc = Wt + (size_t)drow * ldw + dch * 8;
  const bf16_t* asrc = (const bf16_t*)Aptr + (size_t)drow * lda + dch * 8;
  const int lrow = tid >> 3, lch = tid & 7;
  u32x4 ra[4];
  auto gloadA = [&](int k0) {
#pragma unroll
    for (int j = 0; j < 4; ++j) {
      const int row = lrow + 32 * j;
      const float* pa = (const float*)Aptr + (size_t)row * lda + k0 + lch * 8;
      const f32x4 v0 = *(const f32x4*)pa, v1 = *(const f32x4*)(pa + 4);
      ra[j] = (u32x4){pk_bf16(v0[0], v0[1]), pk_bf16(v0[2], v0[3]), pk_bf16(v1[0], v1[1]), pk_bf16(v1[2], v1[3])};
    }
  };
  auto lstoreA = [&](int buf) {
    char* sa = smem + buf * 32768;
#pragma unroll
    for (int j = 0; j < 4; ++j) {
      const int row = lrow + 32 * j;
      *(u32x4*)(sa + row * 128 + ((lch ^ ((row >> 1) & 7)) << 4)) = ra[j];
    }
  };
  auto issue = [&](int kt, int buf) {
    char* sa = smem + buf * 32768 + wave * 1024;
    char* sb = sa + 16384;
#pragma unroll
    for (int j = 0; j < 4; ++j) {
      if (!A_F32) dma16(asrc + (size_t)(32 * j) * lda + kt * 64, sa + j * 4096);
      dma16(wsrc + (size_t)(32 * j) * ldw + kt * 64, sb + j * 4096);
    }
  };
  const int nk = K >> 6;
  const int xsw = (r32 >> 1) & 7;
  const int a_base = (64 * wr + r32) * 128, b_base = 16384 + (64 * wc + r32) * 128;
  __syncthreads();
  if (A_F32) { gloadA(0); lstoreA(0); }
  issue(0, 0);
  for (int kt = 0; kt < nk; ++kt) {
    __syncthreads();
    if (kt + 1 < nk) { issue(kt + 1, (kt + 1) & 1); if (A_F32) gloadA((kt + 1) << 6); }
    const char* st = smem + (kt & 1) * 32768;
#pragma unroll
    for (int s = 0; s < 4; ++s) {
      const int sw = ((2 * s + h) ^ xsw) << 4;
      bf16x8 af[2], bfr[2];
#pragma unroll
      for (int mi = 0; mi < 2; ++mi) af[mi] = *(const bf16x8*)(st + a_base + sw + mi * 4096);
#pragma unroll
      for (int ni = 0; ni < 2; ++ni) bfr[ni] = *(const bf16x8*)(st + b_base + sw + ni * 4096);
#pragma unroll
      for (int mi = 0; mi < 2; ++mi)
#pragma unroll
        for (int ni = 0; ni < 2; ++ni) acc[mi][ni] = MFMA32(af[mi], bfr[ni], acc[mi][ni]);
    }
    if (A_F32) { if (kt + 1 < nk) lstoreA((kt + 1) & 1); }
  }
}
DI void zero_acc(f32x16 (&acc)[2][2]) {
#pragma unroll
  for (int a = 0; a < 2; ++a)
#pragma unroll
    for (int b = 0; b < 2; ++b)
#pragma unroll
      for (int i = 0; i < 16; ++i) acc[a][b][i] = 0.f;
}
DI void tile_decode(int t, int ntn, int& mt, int& nt) {
  const int band = t / (8 * ntn), w = t - band * 8 * ntn;
  nt = w >> 3;
  mt = band * 8 + (w & 7);
}

template <int MODE>
DI void attn_unit(const bf16_t* __restrict__ U, bf16_t* __restrict__ OA, bf16_t* __restrict__ Y, int seq_l, int head, int qb,
                  const float* __restrict__ t5, const float* __restrict__ rpb, char* smem) {
  constexpr int DV = (MODE == 0) ? 128 : 64;
  constexpr int NDB = DV / 32;
  constexpr int KBYTES = 8192, VBYTES = 64 * DV * 2, STAGE = KBYTES + VBYTES;
  constexpr int NVJ = DV / 32;
  float* lut = (float*)(smem + 49152);
  const int tid = opaque_tid(), lane = tid & 63, wave = tid >> 6, r32 = lane & 31, h = lane >> 5;
  const size_t tok0 = (size_t)seq_l * SEQ;
  const int q0 = qb * 128;
  int qcol, kcol, vcol;
  if (MODE == 0) { qcol = C_AQ + head * 64; kcol = C_AK + head * 64; vcol = C_AV + (head >> 1) * 128; }
  else if (MODE == 1) { qcol = C_BQ + head * 64; kcol = C_BK + (head >> 2) * 64; vcol = C_BV + (head >> 2) * 64; }
  else { qcol = C_CQ + head * 64; kcol = C_CK + head * 64; vcol = C_CV + head * 64; }
  int kt0 = 0, NT = SEQ / 64;
  if (MODE == 2) { int b0 = 2 * qb - 4; b0 = b0 < 0 ? 0 : (b0 > 55 ? 55 : b0); kt0 = b0; NT = 9; }

  __syncthreads();
  if (MODE == 0) {
    for (int i = tid; i < 257; i += 256) {
      const int r = i - 128, n = r < 0 ? -r : r;
      int b;
      if (n < 8) b = n;
      else { b = 8 + (n >= 12) + (n >= 16) + (n >= 23) + (n >= 32) + (n >= 46) + (n >= 64) + (n >= 91); }
      if (r > 0) b += 16;
      lut[i] = t5[b * 8 + head] * LOG2E;
    }
  } else if (MODE == 2) {
    for (int i = tid; i < 465; i += 256) lut[i] = rpb[head * 465 + i] * LOG2E;
  }

  const int qi = q0 + wave * 32 + r32;
  bf16x8 qf[4];
  {
    const bf16_t* qp = U + (tok0 + qi) * INW + qcol + 8 * h;
#pragma unroll
    for (int s = 0; s < 4; ++s) {
      const u32x4 raw = *(const u32x4*)(qp + 16 * s);
      u32x4 o;
#pragma unroll
      for (int e = 0; e < 4; ++e) o[e] = pk_bf16(bflo(raw[e]) * 0.125f, bfhi(raw[e]) * 0.125f);
      qf[s] = __builtin_bit_cast(bf16x8, o);
    }
  }

  const int wv = __builtin_amdgcn_readfirstlane(wave);
  int koff[2], voff[NVJ];
#pragma unroll
  for (int j = 0; j < 2; ++j) {
    const int pp = (wv + 4 * j) * 64 + lane, row = pp >> 3, ch = (pp & 7) ^ ((row >> 1) & 7);
    koff[j] = row * INW + kcol + ch * 8;
  }
#pragma unroll
  for (int j = 0; j < NVJ; ++j) {
    const int pp = (wv + 4 * j) * 64 + lane;
    if (DV == 64) { const int row = pp >> 3, ch = (pp & 7) ^ (((row >> 1) & 1) << 2); voff[j] = row * INW + vcol + ch * 8; }
    else { const int row = pp >> 4, ch = (pp & 15) ^ ((row & 3) << 2); voff[j] = row * INW + vcol + ch * 8; }
  }
  auto issue = [&](int kt, int buf) {
    const bf16_t* base = U + (tok0 + (size_t)kt * 64) * INW;
    char* sk = smem + buf * STAGE + wv * 1024;
#pragma unroll
    for (int j = 0; j < 2; ++j) dma16(base + koff[j], sk + j * 4096);
#pragma unroll
    for (int j = 0; j < NVJ; ++j) dma16(base + voff[j], sk + KBYTES + j * 4096);
  };

  f32x16 o[NDB];
#pragma unroll
  for (int db = 0; db < NDB; ++db)
#pragma unroll
    for (int i = 0; i < 16; ++i) o[db][i] = 0.f;
  float m_run = -INFINITY, l_run = 0.f;

  const int q4 = (lane & 15) >> 2, p4 = lane & 3, blk = (lane >> 4) & 1;
  const int qr = 2 * qb + (wave >> 1), qc = (wave & 1) * 32 + r32;
  int sr = qr - 4; sr = sr < 0 ? 0 : (sr > 56 ? 56 : sr);
  int sc = qc - 8; sc = sc < 0 ? 0 : (sc > 48 ? 48 : sc);

  issue(kt0, 0);
  for (int it = 0; it < NT; ++it) {
    const int kt = kt0 + it;
    __syncthreads();
    if (it + 1 < NT) issue(kt + 1, (it + 1) & 1);
    const char* sk = smem + (it & 1) * STAGE;
    const char* sv = sk + KBYTES;
    bool active = true;
    if (MODE == 2) active = (kt >= sr) && (kt < sr + 8);
    if (active) {
      f32x16 st[2];
#pragma unroll
      for (int kb = 0; kb < 2; ++kb) {
#pragma unroll
        for (int i = 0; i < 16; ++i) st[kb][i] = 0.f;
        const int row = 32 * kb + r32;
#pragma unroll
        for (int s = 0; s < 4; ++s) {
          const bf16x8 kf = *(const bf16x8*)(sk + row * 128 + (((2 * s + h) ^ ((row >> 1) & 7)) << 4));
          st[kb] = MFMA32(kf, qf[s], st[kb]);
        }
      }
      if (MODE == 0) {
        const int rel_min = kt * 64 - (q0 + 127), rel_max = kt * 64 + 63 - q0;
        if (rel_min >= 128 || rel_max <= -128) {
          const float bl = (rel_min >= 128) ? lut[256] : lut[0];
#pragma unroll
          for (int kb = 0; kb < 2; ++kb)
#pragma unroll
            for (int i = 0; i < 16; ++i) st[kb][i] = __builtin_fmaf(st[kb][i], LOG2E, bl);
        } else {
#pragma unroll
          for (int kb = 0; kb < 2; ++kb)
#pragma unroll
            for (int i = 0; i < 16; ++i) {
              int rel = kt * 64 + 32 * kb + crow(i, h) - qi;
              rel = rel < -128 ? -128 : (rel > 128 ? 128 : rel);
              st[kb][i] = __builtin_fmaf(st[kb][i], LOG2E, lut[rel + 128]);
              if ((i & 7) == 7) __builtin_amdgcn_sched_barrier(0);
            }
        }
      } else if (MODE == 1) {
#pragma unroll
        for (int kb = 0; kb < 2; ++kb)
#pragma unroll
          for (int i = 0; i < 16; ++i) st[kb][i] *= LOG2E;
      } else {
        const int ri = kt - qr + 7;
#pragma unroll
        for (int kb = 0; kb < 2; ++kb)
#pragma unroll
          for (int i = 0; i < 16; ++i) {
            const int kc = 32 * kb + crow(i, h);
            const bool ok = (kc >= sc) && (kc < sc + 16);
            int ci = kc - qc + 15; ci = ci < 0 ? 0 : (ci > 30 ? 30 : ci);
            const float bl = lut[ri * 31 + ci];
            st[kb][i] = ok ? __builtin_fmaf(st[kb][i], LOG2E, bl) : -INFINITY;
            if ((i & 7) == 7) __builtin_amdgcn_sched_barrier(0);
          }
      }
      float mx = st[0][0];
#pragma unroll
      for (int kb = 0; kb < 2; ++kb)
#pragma unroll
        for (int i = 0; i < 16; ++i) mx = fmaxf(mx, st[kb][i]);
      mx = fmaxf(mx, __shfl_xor(mx, 32));
      const float m_new = fmaxf(m_run, mx);
      const float alpha = __builtin_amdgcn_exp2f(m_run - m_new);
      m_run = m_new;
      float psum = 0.f;
#pragma unroll
      for (int kb = 0; kb < 2; ++kb)
#pragma unroll
        for (int i = 0; i < 16; ++i) { const float pv = __builtin_amdgcn_exp2f(st[kb][i] - m_new); st[kb][i] = pv; psum += pv; }
      l_run = l_run * alpha + psum;
#pragma unroll
      for (int db = 0; db < NDB; ++db)
#pragma unroll
        for (int i = 0; i < 16; ++i) o[db][i] *= alpha;
      bf16x8 pf[2][2];
#pragma unroll
      for (int kb = 0; kb < 2; ++kb)
#pragma unroll
        for (int s2 = 0; s2 < 2; ++s2) {
          u32x4 w;
#pragma unroll
          for (int e = 0; e < 4; ++e) w[e] = pk_bf16(st[kb][8 * s2 + 2 * e], st[kb][8 * s2 + 2 * e + 1]);
          pf[kb][s2] = __builtin_bit_cast(bf16x8, w);
        }
#pragma unroll
      for (int db = 0; db < NDB; ++db)
#pragma unroll
        for (int kb = 0; kb < 2; ++kb)
#pragma unroll
          for (int s2 = 0; s2 < 2; ++s2) {
            s16x4 part[2];
#pragma unroll
            for (int hf = 0; hf < 2; ++hf) {
              const int row = 32 * kb + 16 * s2 + 8 * hf + 4 * h + q4;
              const int chunk = 4 * db + 2 * blk + (p4 >> 1);
              int off;
              if (DV == 64) off = row * 128 + ((chunk ^ (((q4 >> 1) & 1) << 2)) << 4) + (p4 & 1) * 8;
              else off = row * 256 + ((chunk ^ (q4 << 2)) << 4) + (p4 & 1) * 8;
              part[hf] = __builtin_bit_cast(s16x4, __builtin_amdgcn_ds_read_tr16_b64_v4i16((LDSAS s16x4*)(sv + off)));
            }
            const bf16x8 vf = __builtin_shufflevector(part[0], part[1], 0, 1, 2, 3, 4, 5, 6, 7);
            o[db] = MFMA32(vf, pf[kb][s2], o[db]);
          }
    }
  }
  const float l_tot = l_run + __shfl_xor(l_run, 32);
  const float inv = 1.0f / l_tot;
  const size_t tok = tok0 + qi;
#pragma unroll
  for (int db = 0; db < NDB; ++db)
#pragma unroll
    for (int g4 = 0; g4 < 4; ++g4) {
      const int d = 32 * db + 8 * g4 + 4 * h;
      float v0 = o[db][4 * g4] * inv, v1 = o[db][4 * g4 + 1] * inv, v2 = o[db][4 * g4 + 2] * inv, v3 = o[db][4 * g4 + 3] * inv;
      if (MODE == 0) {
        *(u32x2*)(OA + tok * DM + head * 128 + d) = (u32x2){pk_bf16(v0, v1), pk_bf16(v2, v3)};
      } else {
        const int gcol = (MODE == 1 ? C_BG : C_CG) + head * 64 + d;
        const u32x2 gw = *(const u32x2*)(U + tok * INW + gcol);
        v0 *= siluf_(bflo(gw[0])); v1 *= siluf_(bfhi(gw[0])); v2 *= siluf_(bflo(gw[1])); v3 *= siluf_(bfhi(gw[1]));
        *(u32x2*)(Y + tok * 1536 + (MODE == 1 ? 512 : 1024) + head * 64 + d) = (u32x2){pk_bf16(v0, v1), pk_bf16(v2, v3)};
      }
    }
}

DI void transpose_tile(const float* __restrict__ src, bf16_t* __restrict__ dst, int R, int C, int tr, int tc, char* smem) {
  float* tl = (float*)smem;
  const int tid = opaque_tid();
  const int r0 = tr * 64, c0 = tc * 64;
  __syncthreads();
#pragma unroll
  for (int i = 0; i < 16; ++i) {
    const int r = i * 4 + (tid >> 6), c = tid & 63;
    tl[r * 65 + c] = src[(size_t)(r0 + r) * C + c0 + c];
  }
  __syncthreads();
  const int n = tid >> 2, kb = (tid & 3) * 16;
  unsigned w[8];
#pragma unroll
  for (int e = 0; e < 8; ++e) w[e] = pk_bf16(tl[(kb + 2 * e) * 65 + n], tl[(kb + 2 * e + 1) * 65 + n]);
  bf16_t* dp = dst + (size_t)(c0 + n) * R + r0 + kb;
  *(u32x4*)dp = (u32x4){w[0], w[1], w[2], w[3]};
  *(u32x4*)(dp + 8) = (u32x4){w[4], w[5], w[6], w[7]};
}

__global__ void __launch_bounds__(256, 2) fwd_kernel(Params p) {
  __shared__ __attribute__((aligned(16))) char smem[65536];
  cg::grid_group grid = cg::this_grid();
  const int nb = gridDim.x, bid = blockIdx.x;
  const int vb = (bid & 7) * (nb >> 3) + (bid >> 3);
  const int nw = nb * 4;
#define PHASE_IDS const int tid = opaque_tid(), lane = tid & 63, wave = tid >> 6, gw = vb * 4 + wave; (void)lane; (void)gw;
  unsigned char* ws = p.ws;
  bf16_t* WIN = (bf16_t*)(ws + WS_WIN);
  bf16_t* WBR = (bf16_t*)(ws + WS_WBR);
  bf16_t* WOUT = (bf16_t*)(ws + WS_WOUT);
  bf16_t* WPG = (bf16_t*)(ws + WS_WPG);
  bf16_t* WPE = (bf16_t*)(ws + WS_WPE);
  float* ROPE = (float*)(ws + WS_ROPE);
  bf16_t* U = (bf16_t*)(ws + WS_U);
  bf16_t* H = (bf16_t*)(ws + WS_H);
  bf16_t* OA = (bf16_t*)(ws + WS_OA);
  bf16_t* Y = (bf16_t*)(ws + WS_Y);
  bf16_t* M = (bf16_t*)(ws + WS_M);
  float* Z = (float*)(ws + WS_Z);

  {
        PHASE_IDS
    for (int t = bid; t < 4 * 3072; t += nb) {
      const int layer = t / 3072;
      int r = t - layer * 3072;
      if (r < 2112) {
        transpose_tile(p.in[6] + (size_t)layer * DM * INW, WIN + (size_t)layer * INW * DM, DM, INW, r / 132, r % 132, smem);
      } else if (r < 2112 + 384) {
        r -= 2112;
        const int j = r / 128; r -= j * 128;
        transpose_tile(p.in[12 + j] + (size_t)layer * 512 * DM, WBR + ((size_t)layer * 3 + j) * DM * 512, 512, DM, r / 16, r % 16, smem);
      } else if (r < 2112 + 384 + 256) {
        r -= 2112 + 384;
        transpose_tile(p.in[15] + (size_t)layer * DM * DM, WOUT + (size_t)layer * DM * DM, DM, DM, r / 16, r % 16, smem);
      } else if (r < 2112 + 384 + 512) {
        r -= 2112 + 384 + 256;
        transpose_tile(p.in[18] + (size_t)layer * DM * DM, WPG + (size_t)layer * DM * DM, DM, DM, r / 16, r % 16, smem);
      } else {
        r -= 2112 + 384 + 512;
        transpose_tile(p.in[17] + (size_t)layer * DPLE * DM, WPE + (size_t)layer * DM * DPLE, DPLE, DM, r / 16, r % 16, smem);
      }
    }
    if (bid < 4) {
      const int i = bid * 256 + tid;
      const int pos = i >> 4, f = i & 15;
      const float inv = powf(10000.0f, -(float)f / 16.0f);
      const float ang = (float)pos * inv;
      ROPE[i] = cosf(ang);
      ROPE[1024 + i] = sinf(ang);
    }
  }
  grid.sync();

  for (int gi = 0; gi < NG; ++gi) {
    const int seq0 = gi * G;
    const bool is_prompt = seq0 < 16;
    const float* xin = is_prompt ? p.in[0] + (size_t)seq0 * SEQ * DM : p.in[1] + (size_t)(seq0 - 16) * SEQ * DM;
    float* xout = p.out + (size_t)seq0 * SEQ * DM;
    for (int layer = 0; layer < NL; ++layer) {
      const float* xres = (layer == 0) ? xin : (const float*)xout;
      const float* pin = is_prompt ? p.in[2] + ((size_t)layer * 16 + seq0) * SEQ * DPLE : p.in[3] + ((size_t)layer * 8 + (seq0 - 16)) * SEQ * DPLE;
      const bf16_t* win = WIN + (size_t)layer * INW * DM;
      const bf16_t* wbr = WBR + (size_t)layer * 3 * DM * 512;
      const bf16_t* wout = WOUT + (size_t)layer * DM * DM;
      const bf16_t* wpg = WPG + (size_t)layer * DM * DM;
      const bf16_t* wpe = WPE + (size_t)layer * DM * DPLE;

      {
        PHASE_IDS
        const float* g = p.in[5] + layer * DM;
        for (int row = gw; row < TG; row += nw) {
          const float* xr = xres + (size_t)row * DM;
          f32x4 v[4];
          float ss = 0.f;
#pragma unroll
          for (int j = 0; j < 4; ++j) { v[j] = *(const f32x4*)(xr + 4 * (lane + 64 * j)); ss += v[j][0] * v[j][0] + v[j][1] * v[j][1] + v[j][2] * v[j][2] + v[j][3] * v[j][3]; }
          ss = wave_sum(ss);
          const float rstd = rsqrtf(ss * (1.0f / DM) + EPS);
#pragma unroll
          for (int j = 0; j < 4; ++j) {
            const f32x4 gv = *(const f32x4*)(g + 4 * (lane + 64 * j));
            *(u32x2*)(H + (size_t)row * DM + 4 * (lane + 64 * j)) =
                (u32x2){pk_bf16(v[j][0] * rstd * gv[0], v[j][1] * rstd * gv[1]), pk_bf16(v[j][2] * rstd * gv[2], v[j][3] * rstd * gv[3])};
          }
        }
      }
      grid.sync();
      for (int t = vb; t < (TG / 128) * (INW / 128); t += nb) {
        PHASE_IDS
        int mt, nt; tile_decode(t, INW / 128, mt, nt);
        f32x16 acc[2][2]; zero_acc(acc);
        gemm_acc<false>(acc, H + (size_t)mt * 128 * DM, DM, win + (size_t)nt * 128 * DM, DM, DM, smem);
        const int wr = wave >> 1, wc = wave & 1, r32 = lane & 31, h = lane >> 5;
#pragma unroll
        for (int mi = 0; mi < 2; ++mi)
#pragma unroll
          for (int ni = 0; ni < 2; ++ni)
#pragma unroll
            for (int i = 0; i < 16; ++i) {
              const int row = mt * 128 + 64 * wr + 32 * mi + crow(i, h), col = nt * 128 + 64 * wc + 32 * ni + r32;
              U[(size_t)row * INW + col] = f2bf(acc[mi][ni][i]);
            }
      }
      grid.sync();
      {
        PHASE_IDS
        const float* qg = p.in[9] + layer * 64;
        const float* kg = p.in[10] + layer * 64;
        const float gq = qg[lane], gk = kg[lane];
        const int axis = lane >> 5, f = lane & 15, half = (lane >> 4) & 1;
        for (int row = gw; row < TG; row += nw) {
          const int tt = row & (SEQ - 1);
          const int pos = axis ? (tt & 63) : (tt >> 6);
          const float c = ROPE[pos * 16 + f], s = ROPE[1024 + pos * 16 + f];
          bf16_t* ur = U + (size_t)row * INW;
#pragma unroll
          for (int hd = 0; hd < 10; ++hd) {
            const int col = (hd < 8) ? (C_BQ + hd * 64) : (C_BK + (hd - 8) * 64);
            const float x = bf2f(ur[col + lane]);
            const float ss = wave_sum(x * x);
            const float y = x * rsqrtf(ss * (1.0f / 64.0f) + EPS) * (hd < 8 ? gq : gk);
            const float pt = __shfl_xor(y, 16);
            const float o = half ? (y * c + pt * s) : (y * c - pt * s);
            ur[col + lane] = f2bf(o);
          }
        }
      }
      grid.sync();
      {
        PHASE_IDS
        const float* rpb = p.in[11] + (size_t)layer * 8 * 465;
        const int nu = G * 8 * 32;
        int t = vb;
        for (; t < nu; t += nb) attn_unit<0>(U, OA, Y, t >> 8, (t >> 5) & 7, t & 31, p.in[4], rpb, smem);
        for (; t < 2 * nu; t += nb) { const int r = t - nu; attn_unit<1>(U, OA, Y, r >> 8, (r >> 5) & 7, r & 31, p.in[4], rpb, smem); }
        for (; t < 3 * nu; t += nb) { const int r = t - 2 * nu; attn_unit<2>(U, OA, Y, r >> 8, (r >> 5) & 7, r & 31, p.in[4], rpb, smem); }
      }
      grid.sync();
      {
        PHASE_IDS
        const float* lp = p.in[7] + layer * 256;
        const float li = p.lambda_init[layer];
        const float s1 = wave_sum(lp[lane] * lp[64 + lane]), s2 = wave_sum(lp[128 + lane] * lp[192 + lane]);
        const float lam = __expf(s1) - __expf(s2) + li;
        const float* sg = p.in[8] + layer * 128 + (lane & 15) * 8;
        float sgv[8];
#pragma unroll
        for (int e = 0; e < 8; ++e) sgv[e] = sg[e] * (1.0f - li);
        const int hh = lane >> 4, dd = (lane & 15) * 8;
        for (int row = gw; row < TG; row += nw) {
          const u32x4 a0 = *(const u32x4*)(OA + (size_t)row * DM + hh * 256 + dd);
          const u32x4 a1 = *(const u32x4*)(OA + (size_t)row * DM + hh * 256 + 128 + dd);
          const u32x4 gt = *(const u32x4*)(U + (size_t)row * INW + C_AG + lane * 8);
          float dv[8];
          float ss = 0.f;
#pragma unroll
          for (int e = 0; e < 4; ++e) {
            dv[2 * e] = bflo(a0[e]) - lam * bflo(a1[e]);
            dv[2 * e + 1] = bfhi(a0[e]) - lam * bfhi(a1[e]);
            ss += dv[2 * e] * dv[2 * e] + dv[2 * e + 1] * dv[2 * e + 1];
          }
          ss += __shfl_xor(ss, 1); ss += __shfl_xor(ss, 2); ss += __shfl_xor(ss, 4); ss += __shfl_xor(ss, 8);
          const float rstd = rsqrtf(ss * (1.0f / 128.0f) + EPS);
          u32x4 ow;
#pragma unroll
          for (int e = 0; e < 4; ++e)
            ow[e] = pk_bf16(dv[2 * e] * rstd * sgv[2 * e] * siluf_(bflo(gt[e])), dv[2 * e + 1] * rstd * sgv[2 * e + 1] * siluf_(bfhi(gt[e])));
          *(u32x4*)(Y + (size_t)row * 1536 + lane * 8) = ow;
        }
      }
      grid.sync();
      for (int t = vb; t < (TG / 128) * 8; t += nb) {
        PHASE_IDS
        int mt, nt; tile_decode(t, 8, mt, nt);
        const int wr = wave >> 1, wc = wave & 1, r32 = lane & 31, h = lane >> 5;
        f32x16 tot[2][2]; zero_acc(tot);
        for (int j = 0; j < 3; ++j) {
          f32x16 acc[2][2]; zero_acc(acc);
          gemm_acc<false>(acc, Y + (size_t)mt * 128 * 1536 + 512 * j, 1536, wbr + ((size_t)j * DM + nt * 128) * 512, 512, 512, smem);
#pragma unroll
          for (int mi = 0; mi < 2; ++mi)
#pragma unroll
            for (int ni = 0; ni < 2; ++ni)
#pragma unroll
              for (int i = 0; i < 16; ++i) {
                const int row = mt * 128 + 64 * wr + 32 * mi + crow(i, h), col = nt * 128 + 64 * wc + 32 * ni + r32;
                const float gt = bf2f(U[(size_t)row * INW + C_MG + j * DM + col]);
                tot[mi][ni][i] += sigmoidf_(gt) * acc[mi][ni][i];
              }
        }
#pragma unroll
        for (int mi = 0; mi < 2; ++mi)
#pragma unroll
          for (int ni = 0; ni < 2; ++ni)
#pragma unroll
            for (int i = 0; i < 16; ++i) {
              const int row = mt * 128 + 64 * wr + 32 * mi + crow(i, h), col = nt * 128 + 64 * wc + 32 * ni + r32;
              M[(size_t)row * DM + col] = f2bf(tot[mi][ni][i]);
            }
      }
      grid.sync();
      for (int t = vb; t < (TG / 128) * 8; t += nb) {
        PHASE_IDS
        int mt, nt; tile_decode(t, 8, mt, nt);
        const int wr = wave >> 1, wc = wave & 1, r32 = lane & 31, h = lane >> 5;
        f32x16 acc[2][2]; zero_acc(acc);
        gemm_acc<false>(acc, M + (size_t)mt * 128 * DM, DM, wout + (size_t)nt * 128 * DM, DM, DM, smem);
#pragma unroll
        for (int mi = 0; mi < 2; ++mi)
#pragma unroll
          for (int ni = 0; ni < 2; ++ni)
#pragma unroll
            for (int i = 0; i < 16; ++i) {
              const int row = mt * 128 + 64 * wr + 32 * mi + crow(i, h), col = nt * 128 + 64 * wc + 32 * ni + r32;
              Z[(size_t)row * DM + col] = acc[mi][ni][i];
            }
      }
      grid.sync();
      {
        PHASE_IDS
        const float* g = p.in[16] + layer * DM;
        for (int row = gw; row < TG; row += nw) {
          const float* zr = Z + (size_t)row * DM;
          const float* xr = xres + (size_t)row * DM;
          f32x4 v[4];
          float ss = 0.f;
#pragma unroll
          for (int j = 0; j < 4; ++j) { v[j] = *(const f32x4*)(zr + 4 * (lane + 64 * j)); ss += v[j][0] * v[j][0] + v[j][1] * v[j][1] + v[j][2] * v[j][2] + v[j][3] * v[j][3]; }
          ss = wave_sum(ss);
          const float rstd = rsqrtf(ss * (1.0f / DM) + EPS);
#pragma unroll
          for (int j = 0; j < 4; ++j) {
            const int c = 4 * (lane + 64 * j);
            const f32x4 gv = *(const f32x4*)(g + c);
            const f32x4 xv = *(const f32x4*)(xr + c);
            f32x4 o;
#pragma unroll
            for (int e = 0; e < 4; ++e) o[e] = xv[e] + v[j][e] * rstd * gv[e];
            *(f32x4*)(xout + (size_t)row * DM + c) = o;
            *(u32x2*)(H + (size_t)row * DM + c) = (u32x2){pk_bf16(o[0], o[1]), pk_bf16(o[2], o[3])};
          }
        }
      }
      grid.sync();
      for (int t = vb; t < (TG / 128) * 8; t += nb) {
        PHASE_IDS
        int mt, nt; tile_decode(t, 8, mt, nt);
        const int wr = wave >> 1, wc = wave & 1, r32 = lane & 31, h = lane >> 5;
        f32x16 acc[2][2]; zero_acc(acc);
        gemm_acc<false>(acc, H + (size_t)mt * 128 * DM, DM, wpg + (size_t)nt * 128 * DM, DM, DM, smem);
        f32x16 acc2[2][2]; zero_acc(acc2);
        gemm_acc<true>(acc2, pin + (size_t)mt * 128 * DPLE, DPLE, wpe + (size_t)nt * 128 * DPLE, DPLE, DPLE, smem);
#pragma unroll
        for (int mi = 0; mi < 2; ++mi)
#pragma unroll
          for (int ni = 0; ni < 2; ++ni)
#pragma unroll
            for (int i = 0; i < 16; ++i) {
              const int row = mt * 128 + 64 * wr + 32 * mi + crow(i, h), col = nt * 128 + 64 * wc + 32 * ni + r32;
              float* xp = xout + (size_t)row * DM + col;
              *xp = *xp + sigmoidf_(acc[mi][ni][i]) * acc2[mi][ni][i];
            }
      }
      grid.sync();
    }
  }
}

extern "C" void kernel_launch(void* const* d_in, const int* in_sizes, int n_in, void* d_out, int out_size, void* d_ws, size_t ws_size, hipStream_t stream) {
  static int grid_blocks = 0;
  if (!grid_blocks) {
    int dev = 0, cus = 0, per_cu = 0;
    hipGetDevice(&dev);
    hipDeviceGetAttribute(&cus, hipDeviceAttributeMultiprocessorCount, dev);
    hipOccupancyMaxActiveBlocksPerMultiprocessor(&per_cu, fwd_kernel, 256, 0);
    if (per_cu < 1) per_cu = 1;
    if (per_cu > 2) per_cu = 2;
    grid_blocks = cus * per_cu;
    grid_blocks -= grid_blocks % 8;
    if (ws_size < WS_END) fprintf(stderr, "kernel_launch: workspace too small: %zu < %zu\n", ws_size, (size_t)WS_END);
  }
  Params p{};
  for (int i = 0; i < 19; ++i) p.in[i] = (const float*)d_in[i];
  p.out = (float*)d_out;
  p.ws = (unsigned char*)d_ws;
  const float li[4] = {0.2f, 0.35550906759096926f, 0.47071301834358413f, 0.5560582041556852f};
  for (int i = 0; i < 4; ++i) p.lambda_init[i] = li[i];
  void* args[] = {&p};
  hipError_t e = hipLaunchCooperativeKernel((void*)fwd_kernel, dim3(grid_blocks), dim3(256), args, 0, stream);
  if (e != hipSuccess) fprintf(stderr, "cooperative launch failed: %s (grid %d)\n", hipGetErrorString(e), grid_blocks);
}
```

```cpp
#include <hip/hip_runtime.h>
#include <hip/hip_cooperative_groups.h>
#include <stdint.h>
#include <stdio.h>
namespace cg = cooperative_groups;

typedef unsigned short bf16_t;
typedef short bf16x8 __attribute__((ext_vector_type(8)));
typedef short s16x4 __attribute__((ext_vector_type(4)));
typedef float f32x16 __attribute__((ext_vector_type(16)));
typedef float f32x4 __attribute__((ext_vector_type(4)));
typedef float f32x2 __attribute__((ext_vector_type(2)));
typedef __bf16 bf16x2_t __attribute__((ext_vector_type(2)));
typedef unsigned u32x4 __attribute__((ext_vector_type(4)));
typedef unsigned u32x2 __attribute__((ext_vector_type(2)));
#define DI __device__ __forceinline__
#define LDSAS __attribute__((address_space(3)))

constexpr int DM = 1024, SEQ = 4096, NL = 4, INW = 8448, DPLE = 256;
constexpr int G = 4;
constexpr int NG = 24 / G;
constexpr int TG = G * SEQ;
constexpr float EPS = 1e-6f;
constexpr float LOG2E = 1.4426950408889634f;
constexpr int C_AQ = 0, C_AK = 512, C_AV = 1024, C_AG = 1536, C_BQ = 2048, C_BK = 2560, C_BV = 2688, C_BG = 2816,
              C_CQ = 3328, C_CK = 3840, C_CV = 4352, C_CG = 4864, C_MG = 5376;
constexpr size_t WS_ROPE = 4096;
constexpr size_t WS_WIN = 16384;
constexpr size_t WS_WBR = WS_WIN + (size_t)NL * INW * DM * 2;
constexpr size_t WS_WOUT = WS_WBR + (size_t)NL * 3 * DM * 512 * 2;
constexpr size_t WS_WPG = WS_WOUT + (size_t)NL * DM * DM * 2;
constexpr size_t WS_WPE = WS_WPG + (size_t)NL * DM * DM * 2;
constexpr size_t WS_U = WS_WPE + (size_t)NL * DM * DPLE * 2;
constexpr size_t WS_H = WS_U + (size_t)TG * INW * 2;
constexpr size_t WS_OA = WS_H + (size_t)TG * DM * 2;
constexpr size_t WS_Y = WS_OA + (size_t)TG * DM * 2;
constexpr size_t WS_M = WS_Y + (size_t)TG * 1536 * 2;
constexpr size_t WS_Z = WS_M + (size_t)TG * DM * 2;
constexpr size_t WS_END = WS_Z + (size_t)TG * DM * 4;

struct Params {
  const float* in[19];
  float* out;
  unsigned char* ws;
  float lambda_init[4];
};

DI unsigned pk_bf16(float lo, float hi) { f32x2 v = {lo, hi}; bf16x2_t b = __builtin_convertvector(v, bf16x2_t); return __builtin_bit_cast(unsigned, b); }
DI float bf2f(unsigned short b) { return __uint_as_float(((unsigned)b) << 16); }
DI float bflo(unsigned w) { return __uint_as_float(w << 16); }
DI float bfhi(unsigned w) { return __uint_as_float(w & 0xffff0000u); }
DI unsigned short f2bf(float f) { return (unsigned short)(pk_bf16(f, 0.f) & 0xffffu); }
DI float wave_sum(float v) {
#pragma unroll
  for (int o = 32; o >= 1; o >>= 1) v += __shfl_xor(v, o);
  return v;
}
DI float sigmoidf_(float x) { return 1.0f / (1.0f + __expf(-x)); }
DI float siluf_(float x) { return x / (1.0f + __expf(-x)); }
DI int opaque_tid() { int t = threadIdx.x; asm volatile("" : "+v"(t)); return t; }
DI int crow(int i, int h) { return (i & 3) + 8 * (i >> 2) + 4 * h; }
#define MFMA32(a, b, c) __builtin_amdgcn_mfma_f32_32x32x16_bf16((a), (b), (c), 0, 0, 0)

DI void dma16(const void* gsrc, char* lds_wave_base) {
  __builtin_amdgcn_global_load_lds((const unsigned*)gsrc, (LDSAS unsigned*)lds_wave_base, 16, 0, 0);
}
DI void dma_sync() { asm volatile("s_waitcnt vmcnt(0)" ::: "memory"); __syncthreads(); }
template <int NI, bool A_F32>
DI void gemm_acc(f32x16 (&acc)[4][NI], const void* Aptr, int lda, const bf16_t* Wt, int ldw, int K, char* smem) {
  constexpr int A_BYTES = 32768, STG = A_BYTES + 16384 * NI;
  const int tid = opaque_tid(), lane = tid & 63, wave = __builtin_amdgcn_readfirstlane(tid >> 6), wr = wave >> 2, wc = wave & 3, r32 = lane & 31, h = lane >> 5;
  const int drow = wave * 8 + (lane >> 3);
  const int dch = (lane & 7) ^ ((drow >> 1) & 7);
  const bf16_t* wsrc = Wt + (size_t)drow * ldw + dch * 8;
  const bf16_t* asrc = (const bf16_t*)Aptr + (size_t)drow * lda + dch * 8;
  const int lrow = tid >> 3, lch = tid & 7;
  u32x4 ra[4];
  auto gloadA = [&](int k0) {
#pragma unroll
    for (int j = 0; j < 4; ++j) {
      const float* pa = (const float*)Aptr + (size_t)(lrow + 64 * j) * lda + k0 + lch * 8;
      const f32x4 v0 = *(const f32x4*)pa, v1 = *(const f32x4*)(pa + 4);
      ra[j] = (u32x4){pk_bf16(v0[0], v0[1]), pk_bf16(v0[2], v0[3]), pk_bf16(v1[0], v1[1]), pk_bf16(v1[2], v1[3])};
    }
  };
  auto lstoreA = [&](int buf) {
    char* sa = smem + buf * STG;
#pragma unroll
    for (int j = 0; j < 4; ++j) {
      const int row = lrow + 64 * j;
      *(u32x4*)(sa + row * 128 + ((lch ^ ((row >> 1) & 7)) << 4)) = ra[j];
    }
  };
  auto issue = [&](int kt, int buf) {
    char* sa = smem + buf * STG + wave * 1024;
    char* sb = sa + A_BYTES;
    if (!A_F32) {
#pragma unroll
      for (int j = 0; j < 4; ++j) dma16(asrc + (size_t)(64 * j) * lda + kt * 64, sa + j * 8192);
    }
#pragma unroll
    for (int j = 0; j < 2 * NI; ++j) dma16(wsrc + (size_t)(64 * j) * ldw + kt * 64, sb + j * 8192);
  };
  const int nk = K >> 6;
  const int xsw = (r32 >> 1) & 7;
  const int a_base = (128 * wr + r32) * 128, b_base = A_BYTES + (32 * NI * wc + r32) * 128;
  __syncthreads();
  if (A_F32) { gloadA(0); lstoreA(0); }
  issue(0, 0);
  for (int kt = 0; kt < nk; ++kt) {
    dma_sync();
    if (kt + 1 < nk) { issue(kt + 1, (kt + 1) & 1); if (A_F32) gloadA((kt + 1) << 6); }
    const char* st = smem + (kt & 1) * STG;
#pragma unroll
    for (int s = 0; s < 4; ++s) {
      const int sw = ((2 * s + h) ^ xsw) << 4;
      bf16x8 af[4], bfr[NI];
#pragma unroll
      for (int mi = 0; mi < 4; ++mi) af[mi] = *(const bf16x8*)(st + a_base + sw + mi * 4096);
#pragma unroll
      for (int ni = 0; ni < NI; ++ni) bfr[ni] = *(const bf16x8*)(st + b_base + sw + ni * 4096);
#pragma unroll
      for (int mi = 0; mi < 4; ++mi)
#pragma unroll
        for (int ni = 0; ni < NI; ++ni) acc[mi][ni] = MFMA32(af[mi], bfr[ni], acc[mi][ni]);
    }
    if (A_F32) { if (kt + 1 < nk) lstoreA((kt + 1) & 1); }
  }
}
template <int NI>
DI void zero_acc(f32x16 (&acc)[4][NI]) {
#pragma unroll
  for (int a = 0; a < 4; ++a)
#pragma unroll
    for (int b = 0; b < NI; ++b)
#pragma unroll
      for (int i = 0; i < 16; ++i) acc[a][b][i] = 0.f;
}
#define EPI_LOOP(NI_) _Pragma("unroll") for (int mi = 0; mi < 4; ++mi) _Pragma("unroll") for (int ni = 0; ni < NI_; ++ni) _Pragma("unroll") for (int i = 0; i < 16; ++i)
#define EPI_OFF0(mt, nt, NI_, ld) ((unsigned)((mt) * 256 + 128 * (wave >> 2) + 4 * (lane >> 5)) * (unsigned)(ld) + (unsigned)((nt) * 128 * NI_ + 32 * NI_ * (wave & 3) + (lane & 31)))
#define EPI_OFF(off0, ld) ((off0) + (unsigned)((32 * mi + (i & 3) + 8 * (i >> 2)) * (ld) + 32 * ni))
#define EPI_FENCE
DI void tile_decode(int t, int ntn, int& mt, int& nt) {
  const int band = t / (8 * ntn), w = t - band * 8 * ntn;
  nt = w >> 3;
  mt = band * 8 + (w & 7);
}

template <int MODE>
DI void attn_unit(const bf16_t* __restrict__ U, bf16_t* __restrict__ OA, bf16_t* __restrict__ Y, int seq_l, int head, int qb,
                  const float* __restrict__ t5, const float* __restrict__ rpb, char* smem) {
  constexpr int DV = (MODE == 0) ? 128 : 64;
  constexpr int NDB = DV / 32;
  constexpr int KBYTES = 8192, VBYTES = 64 * DV * 2, STAGE = KBYTES + VBYTES;
  constexpr int NVJ = DV / 64;
  float* lut = (float*)(smem + 49152);
  const int tid = opaque_tid(), lane = tid & 63, wave = tid >> 6, r32 = lane & 31, h = lane >> 5;
  const size_t tok0 = (size_t)seq_l * SEQ;
  const int q0 = qb * 256;
  int qcol, kcol, vcol;
  if (MODE == 0) { qcol = C_AQ + head * 64; kcol = C_AK + head * 64; vcol = C_AV + (head >> 1) * 128; }
  else if (MODE == 1) { qcol = C_BQ + head * 64; kcol = C_BK + (head >> 2) * 64; vcol = C_BV + (head >> 2) * 64; }
  else { qcol = C_CQ + head * 64; kcol = C_CK + head * 64; vcol = C_CV + head * 64; }
  int kt0 = 0, NT = SEQ / 64;
  if (MODE == 2) { int b0 = 4 * qb - 4; b0 = b0 < 0 ? 0 : (b0 > 53 ? 53 : b0); kt0 = b0; NT = 11; }

  __syncthreads();
  if (MODE == 0) {
    for (int i = tid; i < 257; i += 512) {
      const int r = i - 128, n = r < 0 ? -r : r;
      int b;
      if (n < 8) b = n;
      else { b = 8 + (n >= 12) + (n >= 16) + (n >= 23) + (n >= 32) + (n >= 46) + (n >= 64) + (n >= 91); }
      if (r > 0) b += 16;
      lut[i] = t5[b * 8 + head] * LOG2E;
    }
  } else if (MODE == 2) {
    for (int i = tid; i < 465; i += 512) lut[i] = rpb[head * 465 + i] * LOG2E;
  }

  const int qi = q0 + wave * 32 + r32;
  bf16x8 qf[4];
  {
    const bf16_t* qp = U + (tok0 + qi) * INW + qcol + 8 * h;
#pragma unroll
    for (int s = 0; s < 4; ++s) {
      const u32x4 raw = *(const u32x4*)(qp + 16 * s);
      u32x4 o;
#pragma unroll
      for (int e = 0; e < 4; ++e) o[e] = pk_bf16(bflo(raw[e]) * 0.125f, bfhi(raw[e]) * 0.125f);
      qf[s] = __builtin_bit_cast(bf16x8, o);
    }
  }

  const int wv = __builtin_amdgcn_readfirstlane(wave);
  int koff, voff[NVJ];
  {
    const int row = wv * 8 + (lane >> 3), ch = (lane & 7) ^ ((row >> 1) & 7);
    koff = row * INW + kcol + ch * 8;
  }
#pragma unroll
  for (int j = 0; j < NVJ; ++j) {
    if (DV == 64) { const int row = wv * 8 + (lane >> 3), ch = (lane & 7) ^ (((row >> 1) & 1) << 2); voff[j] = row * INW + vcol + ch * 8; }
    else { const int row = (wv + 8 * j) * 4 + (lane >> 4), ch = (lane & 15) ^ ((row & 3) << 2); voff[j] = row * INW + vcol + ch * 8; }
  }
  auto issue = [&](int kt, int buf) {
    const bf16_t* base = U + (tok0 + (size_t)kt * 64) * INW;
    char* sk = smem + buf * STAGE + wv * 1024;
    dma16(base + koff, sk);
#pragma unroll
    for (int j = 0; j < NVJ; ++j) dma16(base + voff[j], sk + KBYTES + j * 8192);
  };

  f32x16 o[NDB];
#pragma unroll
  for (int db = 0; db < NDB; ++db)
#pragma unroll
    for (int i = 0; i < 16; ++i) o[db][i] = 0.f;
  float m_run = -INFINITY, l_run = 0.f;

  const int q4 = (lane & 15) >> 2, p4 = lane & 3, blk = (lane >> 4) & 1;
  const int qr = 4 * qb + (wave >> 1), qc = (wave & 1) * 32 + r32;
  int sr = qr - 4; sr = sr < 0 ? 0 : (sr > 56 ? 56 : sr);
  int sc = qc - 8; sc = sc < 0 ? 0 : (sc > 48 ? 48 : sc);

  issue(kt0, 0);
  for (int it = 0; it < NT; ++it) {
    const int kt = kt0 + it;
    dma_sync();
    if (it + 1 < NT) issue(kt + 1, (it + 1) & 1);
    const char* sk = smem + (it & 1) * STAGE;
    const char* sv = sk + KBYTES;
    bool active = true;
    if (MODE == 2) active = (kt >= sr) && (kt < sr + 8);
    if (active) {
      f32x16 st[2];
#pragma unroll
      for (int kb = 0; kb < 2; ++kb) {
#pragma unroll
        for (int i = 0; i < 16; ++i) st[kb][i] = 0.f;
        const int row = 32 * kb + r32;
#pragma unroll
        for (int s = 0; s < 4; ++s) {
          const bf16x8 kf = *(const bf16x8*)(sk + row * 128 + (((2 * s + h) ^ ((row >> 1) & 7)) << 4));
          st[kb] = MFMA32(kf, qf[s], st[kb]);
        }
      }
      if (MODE == 0) {
        const int rel_min = kt * 64 - (q0 + 255), rel_max = kt * 64 + 63 - q0;
        if (rel_min >= 128 || rel_max <= -128) {
          const float bl = (rel_min >= 128) ? lut[256] : lut[0];
#pragma unroll
          for (int kb = 0; kb < 2; ++kb)
#pragma unroll
            for (int i = 0; i < 16; ++i) st[kb][i] = __builtin_fmaf(st[kb][i], LOG2E, bl);
        } else {
#pragma unroll
          for (int kb = 0; kb < 2; ++kb)
#pragma unroll
            for (int i = 0; i < 16; ++i) {
              int rel = kt * 64 + 32 * kb + crow(i, h) - qi;
              rel = rel < -128 ? -128 : (rel > 128 ? 128 : rel);
              st[kb][i] = __builtin_fmaf(st[kb][i], LOG2E, lut[rel + 128]);
              if ((i & 7) == 7) __builtin_amdgcn_sched_barrier(0);
            }
        }
      } else if (MODE == 1) {
#pragma unroll
        for (int kb = 0; kb < 2; ++kb)
#pragma unroll
          for (int i = 0; i < 16; ++i) st[kb][i] *= LOG2E;
      } else {
        const int ri = kt - qr + 7;
#pragma unroll
        for (int kb = 0; kb < 2; ++kb)
#pragma unroll
          for (int i = 0; i < 16; ++i) {
            const int kc = 32 * kb + crow(i, h);
            const bool ok = (kc >= sc) && (kc < sc + 16);
            int ci = kc - qc + 15; ci = ci < 0 ? 0 : (ci > 30 ? 30 : ci);
            const float bl = lut[ri * 31 + ci];
            st[kb][i] = ok ? __builtin_fmaf(st[kb][i], LOG2E, bl) : -INFINITY;
            if ((i & 7) == 7) __builtin_amdgcn_sched_barrier(0);
          }
      }
      float mx = st[0][0];
#pragma unroll
      for (int kb = 0; kb < 2; ++kb)
#pragma unroll
        for (int i = 0; i < 16; ++i) mx = fmaxf(mx, st[kb][i]);
      mx = fmaxf(mx, __shfl_xor(mx, 32));
      const float m_new = fmaxf(m_run, mx);
      const float alpha = __builtin_amdgcn_exp2f(m_run - m_new);
      m_run = m_new;
      float psum = 0.f;
#pragma unroll
      for (int kb = 0; kb < 2; ++kb)
#pragma unroll
        for (int i = 0; i < 16; ++i) { const float pv = __builtin_amdgcn_exp2f(st[kb][i] - m_new); st[kb][i] = pv; psum += pv; }
      l_run = l_run * alpha + psum;
#pragma unroll
      for (int db = 0; db < NDB; ++db)
#pragma unroll
        for (int i = 0; i < 16; ++i) o[db][i] *= alpha;
      bf16x8 pf[2][2];
#pragma unroll
      for (int kb = 0; kb < 2; ++kb)
#pragma unroll
        for (int s2 = 0; s2 < 2; ++s2) {
          u32x4 w;
#pragma unroll
          for (int e = 0; e < 4; ++e) w[e] = pk_bf16(st[kb][8 * s2 + 2 * e], st[kb][8 * s2 + 2 * e + 1]);
          pf[kb][s2] = __builtin_bit_cast(bf16x8, w);
        }
#pragma unroll
      for (int db = 0; db < NDB; ++db)
#pragma unroll
        for (int kb = 0; kb < 2; ++kb)
#pragma unroll
          for (int s2 = 0; s2 < 2; ++s2) {
            s16x4 part[2];
#pragma unroll
            for (int hf = 0; hf < 2; ++hf) {
              const int row = 32 * kb + 16 * s2 + 8 * hf + 4 * h + q4;
              const int chunk = 4 * db + 2 * blk + (p4 >> 1);
              int off;
              if (DV == 64) off = row * 128 + ((chunk ^ (((q4 >> 1) & 1) << 2)) << 4) + (p4 & 1) * 8;
              else off = row * 256 + ((chunk ^ (q4 << 2)) << 4) + (p4 & 1) * 8;
              part[hf] = __builtin_bit_cast(s16x4, __builtin_amdgcn_ds_read_tr16_b64_v4i16((LDSAS s16x4*)(sv + off)));
            }
            const bf16x8 vf = __builtin_shufflevector(part[0], part[1], 0, 1, 2, 3, 4, 5, 6, 7);
            o[db] = MFMA32(vf, pf[kb][s2], o[db]);
          }
    }
  }
  const float l_tot = l_run + __shfl_xor(l_run, 32);
  const float inv = 1.0f / l_tot;
  const size_t tok = tok0 + qi;
#pragma unroll
  for (int db = 0; db < NDB; ++db)
#pragma unroll
    for (int g4 = 0; g4 < 4; ++g4) {
      const int d = 32 * db + 8 * g4 + 4 * h;
      float v0 = o[db][4 * g4] * inv, v1 = o[db][4 * g4 + 1] * inv, v2 = o[db][4 * g4 + 2] * inv, v3 = o[db][4 * g4 + 3] * inv;
      if (MODE == 0) {
        *(u32x2*)(OA + tok * DM + head * 128 + d) = (u32x2){pk_bf16(v0, v1), pk_bf16(v2, v3)};
      } else {
        const int gcol = (MODE == 1 ? C_BG : C_CG) + head * 64 + d;
        const u32x2 gw = *(const u32x2*)(U + tok * INW + gcol);
        v0 *= siluf_(bflo(gw[0])); v1 *= siluf_(bfhi(gw[0])); v2 *= siluf_(bflo(gw[1])); v3 *= siluf_(bfhi(gw[1]));
        *(u32x2*)(Y + tok * 1536 + (MODE == 1 ? 512 : 1024) + head * 64 + d) = (u32x2){pk_bf16(v0, v1), pk_bf16(v2, v3)};
      }
    }
}

DI void transpose_tile(const float* __restrict__ src, bf16_t* __restrict__ dst, int R, int C, int tr, int tc, char* smem) {
  float* tl = (float*)smem;
  const int tid = opaque_tid();
  const int r0 = tr * 64, c0 = tc * 64;
  __syncthreads();
#pragma unroll
  for (int i = 0; i < 8; ++i) {
    const int r = i * 8 + (tid >> 6), c = tid & 63;
    tl[r * 65 + c] = src[(size_t)(r0 + r) * C + c0 + c];
  }
  __syncthreads();
  const int n = tid >> 3, kb = (tid & 7) * 8;
  unsigned w[4];
#pragma unroll
  for (int e = 0; e < 4; ++e) w[e] = pk_bf16(tl[(kb + 2 * e) * 65 + n], tl[(kb + 2 * e + 1) * 65 + n]);
  *(u32x4*)(dst + (size_t)(c0 + n) * R + r0 + kb) = (u32x4){w[0], w[1], w[2], w[3]};
}

constexpr int LDS_BYTES = 131072;
__global__ void __launch_bounds__(512, 2) fwd_kernel(Params p) {
  extern __shared__ __attribute__((aligned(16))) char smem[];
  cg::grid_group grid = cg::this_grid();
  const int nb = gridDim.x, bid = blockIdx.x;
  const int vb = (bid & 7) * (nb >> 3) + (bid >> 3);
  const int nw = nb * 8;
#define PHASE_IDS const int tid = opaque_tid(), lane = tid & 63, wave = tid >> 6, gw = vb * 8 + wave; (void)lane; (void)gw;
  unsigned char* ws = p.ws;
  bf16_t* WIN = (bf16_t*)(ws + WS_WIN);
  bf16_t* WBR = (bf16_t*)(ws + WS_WBR);
  bf16_t* WOUT = (bf16_t*)(ws + WS_WOUT);
  bf16_t* WPG = (bf16_t*)(ws + WS_WPG);
  bf16_t* WPE = (bf16_t*)(ws + WS_WPE);
  float* ROPE = (float*)(ws + WS_ROPE);
  bf16_t* U = (bf16_t*)(ws + WS_U);
  bf16_t* H = (bf16_t*)(ws + WS_H);
  bf16_t* OA = (bf16_t*)(ws + WS_OA);
  bf16_t* Y = (bf16_t*)(ws + WS_Y);
  bf16_t* M = (bf16_t*)(ws + WS_M);
  float* Z = (float*)(ws + WS_Z);

  {
        PHASE_IDS
    for (int t = bid; t < 4 * 3072; t += nb) {
      const int layer = t / 3072;
      int r = t - layer * 3072;
      if (r < 2112) {
        transpose_tile(p.in[6] + (size_t)layer * DM * INW, WIN + (size_t)layer * INW * DM, DM, INW, r / 132, r % 132, smem);
      } else if (r < 2112 + 384) {
        r -= 2112;
        const int j = r / 128; r -= j * 128;
        transpose_tile(p.in[12 + j] + (size_t)layer * 512 * DM, WBR + ((size_t)layer * 3 + j) * DM * 512, 512, DM, r / 16, r % 16, smem);
      } else if (r < 2112 + 384 + 256) {
        r -= 2112 + 384;
        transpose_tile(p.in[15] + (size_t)layer * DM * DM, WOUT + (size_t)layer * DM * DM, DM, DM, r / 16, r % 16, smem);
      } else if (r < 2112 + 384 + 512) {
        r -= 2112 + 384 + 256;
        transpose_tile(p.in[18] + (size_t)layer * DM * DM, WPG + (size_t)layer * DM * DM, DM, DM, r / 16, r % 16, smem);
      } else {
        r -= 2112 + 384 + 512;
        transpose_tile(p.in[17] + (size_t)layer * DPLE * DM, WPE + (size_t)layer * DM * DPLE, DPLE, DM, r / 16, r % 16, smem);
      }
    }
    if (bid < 2) {
      const int i = bid * 512 + tid;
      const int pos = i >> 4, f = i & 15;
      const float inv = powf(10000.0f, -(float)f / 16.0f);
      const float ang = (float)pos * inv;
      ROPE[i] = cosf(ang);
      ROPE[1024 + i] = sinf(ang);
    }
  }
  grid.sync();

  for (int gi = 0; gi < NG; ++gi) {
    const int seq0 = gi * G;
    const bool is_prompt = seq0 < 16;
    const float* xin = is_prompt ? p.in[0] + (size_t)seq0 * SEQ * DM : p.in[1] + (size_t)(seq0 - 16) * SEQ * DM;
    float* xout = p.out + (size_t)seq0 * SEQ * DM;
    for (int layer = 0; layer < NL; ++layer) {
      const float* xres = (layer == 0) ? xin : (const float*)xout;
      const float* pin = is_prompt ? p.in[2] + ((size_t)layer * 16 + seq0) * SEQ * DPLE : p.in[3] + ((size_t)layer * 8 + (seq0 - 16)) * SEQ * DPLE;
      const bf16_t* win = WIN + (size_t)layer * INW * DM;
      const bf16_t* wbr = WBR + (size_t)layer * 3 * DM * 512;
      const bf16_t* wout = WOUT + (size_t)layer * DM * DM;
      const bf16_t* wpg = WPG + (size_t)layer * DM * DM;
      const bf16_t* wpe = WPE + (size_t)layer * DM * DPLE;

      {
        PHASE_IDS
        const float* g = p.in[5] + layer * DM;
        for (int row = gw; row < TG; row += nw) {
          const float* xr = xres + (size_t)row * DM;
          f32x4 v[4];
          float ss = 0.f;
#pragma unroll
          for (int j = 0; j < 4; ++j) { v[j] = *(const f32x4*)(xr + 4 * (lane + 64 * j)); ss += v[j][0] * v[j][0] + v[j][1] * v[j][1] + v[j][2] * v[j][2] + v[j][3] * v[j][3]; }
          ss = wave_sum(ss);
          const float rstd = rsqrtf(ss * (1.0f / DM) + EPS);
#pragma unroll
          for (int j = 0; j < 4; ++j) {
            const f32x4 gv = *(const f32x4*)(g + 4 * (lane + 64 * j));
            *(u32x2*)(H + (size_t)row * DM + 4 * (lane + 64 * j)) =
                (u32x2){pk_bf16(v[j][0] * rstd * gv[0], v[j][1] * rstd * gv[1]), pk_bf16(v[j][2] * rstd * gv[2], v[j][3] * rstd * gv[3])};
          }
        }
      }
      grid.sync();
      for (int t = vb; t < (TG / 256) * (INW / 256); t += nb) {
        PHASE_IDS
        int mt, nt; tile_decode(t, INW / 256, mt, nt);
        f32x16 acc[4][2]; zero_acc<2>(acc);
        gemm_acc<2, false>(acc, H + (size_t)mt * 256 * DM, DM, win + (size_t)nt * 256 * DM, DM, DM, smem);
        const unsigned o0 = EPI_OFF0(mt, nt, 2, INW);
        EPI_LOOP(2) { U[EPI_OFF(o0, INW)] = f2bf(acc[mi][ni][i]); }
      }
      grid.sync();
      {
        PHASE_IDS
        const float* qg = p.in[9] + layer * 64;
        const float* kg = p.in[10] + layer * 64;
        const float gq = qg[lane], gk = kg[lane];
        const int axis = lane >> 5, f = lane & 15, half = (lane >> 4) & 1;
        for (int row = gw; row < TG; row += nw) {
          const int tt = row & (SEQ - 1);
          const int pos = axis ? (tt & 63) : (tt >> 6);
          const float c = ROPE[pos * 16 + f], s = ROPE[1024 + pos * 16 + f];
          bf16_t* ur = U + (size_t)row * INW;
#pragma unroll
          for (int hd = 0; hd < 10; ++hd) {
            const int col = (hd < 8) ? (C_BQ + hd * 64) : (C_BK + (hd - 8) * 64);
            const float x = bf2f(ur[col + lane]);
            const float ss = wave_sum(x * x);
            const float y = x * rsqrtf(ss * (1.0f / 64.0f) + EPS) * (hd < 8 ? gq : gk);
            const float pt = __shfl_xor(y, 16);
            const float o = half ? (y * c + pt * s) : (y * c - pt * s);
            ur[col + lane] = f2bf(o);
          }
        }
      }
      grid.sync();
      {
        PHASE_IDS
        const float* rpb = p.in[11] + (size_t)layer * 8 * 465;
        const int nu = G * 8 * 16;
        int t = vb;
        for (; t < nu; t += nb) attn_unit<0>(U, OA, Y, t >> 7, (t >> 4) & 7, t & 15, p.in[4], rpb, smem);
        for (; t < 2 * nu; t += nb) { const int r = t - nu; attn_unit<1>(U, OA, Y, r >> 7, (r >> 4) & 7, r & 15, p.in[4], rpb, smem); }
        for (; t < 3 * nu; t += nb) { const int r = t - 2 * nu; attn_unit<2>(U, OA, Y, r >> 7, (r >> 4) & 7, r & 15, p.in[4], rpb, smem); }
      }
      grid.sync();
      {
        PHASE_IDS
        const float* lp = p.in[7] + layer * 256;
        const float li = p.lambda_init[layer];
        const float s1 = wave_sum(lp[lane] * lp[64 + lane]), s2 = wave_sum(lp[128 + lane] * lp[192 + lane]);
        const float lam = __expf(s1) - __expf(s2) + li;
        const float* sg = p.in[8] + layer * 128 + (lane & 15) * 8;
        float sgv[8];
#pragma unroll
        for (int e = 0; e < 8; ++e) sgv[e] = sg[e] * (1.0f - li);
        const int hh = lane >> 4, dd = (lane & 15) * 8;
        for (int row = gw; row < TG; row += nw) {
          const u32x4 a0 = *(const u32x4*)(OA + (size_t)row * DM + hh * 256 + dd);
          const u32x4 a1 = *(const u32x4*)(OA + (size_t)row * DM + hh * 256 + 128 + dd);
          const u32x4 gt = *(const u32x4*)(U + (size_t)row * INW + C_AG + lane * 8);
          float dv[8];
          float ss = 0.f;
#pragma unroll
          for (int e = 0; e < 4; ++e) {
            dv[2 * e] = bflo(a0[e]) - lam * bflo(a1[e]);
            dv[2 * e + 1] = bfhi(a0[e]) - lam * bfhi(a1[e]);
            ss += dv[2 * e] * dv[2 * e] + dv[2 * e + 1] * dv[2 * e + 1];
          }
          ss += __shfl_xor(ss, 1); ss += __shfl_xor(ss, 2); ss += __shfl_xor(ss, 4); ss += __shfl_xor(ss, 8);
          const float rstd = rsqrtf(ss * (1.0f / 128.0f) + EPS);
          u32x4 ow;
#pragma unroll
          for (int e = 0; e < 4; ++e)
            ow[e] = pk_bf16(dv[2 * e] * rstd * sgv[2 * e] * siluf_(bflo(gt[e])), dv[2 * e + 1] * rstd * sgv[2 * e + 1] * siluf_(bfhi(gt[e])));
          *(u32x4*)(Y + (size_t)row * 1536 + lane * 8) = ow;
        }
      }
      grid.sync();
      for (int t = vb; t < (TG / 256) * 4; t += nb) {
        PHASE_IDS
        int mt, nt; tile_decode(t, 4, mt, nt);
        f32x16 acc[4][2]; zero_acc<2>(acc);
        for (int j = 0; j < 3; ++j) {
          gemm_acc<2, false>(acc, Y + (size_t)mt * 256 * 1536 + 512 * j, 1536, wbr + ((size_t)j * DM + nt * 256) * 512, 512, 512, smem);
          const bf16_t* gp = U + C_MG + j * DM;
          const float fl = (j < 2) ? 1.0f : 0.0f;
          unsigned g0;
          { const int tid = opaque_tid(), lane = tid & 63, wave = tid >> 6; g0 = EPI_OFF0(mt, nt, 2, INW); }
#pragma unroll
          for (int mi = 0; mi < 4; ++mi)
#pragma unroll
            for (int ni = 0; ni < 2; ++ni) {
#pragma unroll
              for (int i = 0; i < 16; ++i) {
                const unsigned o = EPI_OFF(g0, INW);
                const float ea = __expf(-bf2f(gp[o]));
                const float eb = __expf(-bf2f(gp[o + DM])) * fl;
                acc[mi][ni][i] *= (1.0f + eb) * __builtin_amdgcn_rcpf(1.0f + ea);
              }
              asm volatile("" : "+v"(acc[mi][ni]) : : "memory");
            }
        }
        const unsigned o0 = EPI_OFF0(mt, nt, 2, DM);
        EPI_LOOP(2) { M[EPI_OFF(o0, DM)] = f2bf(acc[mi][ni][i]); }
      }
      grid.sync();
      for (int t = vb; t < (TG / 256) * 4; t += nb) {
        PHASE_IDS
        int mt, nt; tile_decode(t, 4, mt, nt);
        f32x16 acc[4][2]; zero_acc<2>(acc);
        gemm_acc<2, false>(acc, M + (size_t)mt * 256 * DM, DM, wout + (size_t)nt * 256 * DM, DM, DM, smem);
        const unsigned o0 = EPI_OFF0(mt, nt, 2, DM);
        EPI_LOOP(2) { Z[EPI_OFF(o0, DM)] = acc[mi][ni][i]; }
      }
      grid.sync();
      {
        PHASE_IDS
        const float* g = p.in[16] + layer * DM;
        for (int row = gw; row < TG; row += nw) {
          const float* zr = Z + (size_t)row * DM;
          const float* xr = xres + (size_t)row * DM;
          f32x4 v[4];
          float ss = 0.f;
#pragma unroll
          for (int j = 0; j < 4; ++j) { v[j] = *(const f32x4*)(zr + 4 * (lane + 64 * j)); ss += v[j][0] * v[j][0] + v[j][1] * v[j][1] + v[j][2] * v[j][2] + v[j][3] * v[j][3]; }
          ss = wave_sum(ss);
          const float rstd = rsqrtf(ss * (1.0f / DM) + EPS);
#pragma unroll
          for (int j = 0; j < 4; ++j) {
            const int c = 4 * (lane + 64 * j);
            const f32x4 gv = *(const f32x4*)(g + c);
            const f32x4 xv = *(const f32x4*)(xr + c);
            f32x4 o;
#pragma unroll
            for (int e = 0; e < 4; ++e) o[e] = xv[e] + v[j][e] * rstd * gv[e];
            *(f32x4*)(xout + (size_t)row * DM + c) = o;
            *(u32x2*)(H + (size_t)row * DM + c) = (u32x2){pk_bf16(o[0], o[1]), pk_bf16(o[2], o[3])};
          }
        }
      }
      grid.sync();
      for (int t = vb; t < (TG / 256) * 8; t += nb) {
        PHASE_IDS
        int mt, nt; tile_decode(t, 8, mt, nt);
        unsigned pe[4][8];
        {
          f32x16 acc2[4][1]; zero_acc<1>(acc2);
          gemm_acc<1, true>(acc2, pin + (size_t)mt * 256 * DPLE, DPLE, wpe + (size_t)nt * 128 * DPLE, DPLE, DPLE, smem);
#pragma unroll
          for (int mi = 0; mi < 4; ++mi)
#pragma unroll
            for (int e = 0; e < 8; ++e) pe[mi][e] = pk_bf16(acc2[mi][0][2 * e], acc2[mi][0][2 * e + 1]);
        }
        f32x16 acc[4][1]; zero_acc<1>(acc);
        gemm_acc<1, false>(acc, H + (size_t)mt * 256 * DM, DM, wpg + (size_t)nt * 128 * DM, DM, DM, smem);
        const unsigned o0 = EPI_OFF0(mt, nt, 1, DM);
        EPI_LOOP(1) {
          float* xp = xout + EPI_OFF(o0, DM);
          const float pv = (i & 1) ? bfhi(pe[mi][i >> 1]) : bflo(pe[mi][i >> 1]);
          *xp = *xp + sigmoidf_(acc[mi][ni][i]) * pv;
        }
      }
      grid.sync();
    }
  }
}

extern "C" void kernel_launch(void* const* d_in, const int* in_sizes, int n_in, void* d_out, int out_size, void* d_ws, size_t ws_size, hipStream_t stream) {
  static int grid_blocks = 0;
  if (!grid_blocks) {
    int dev = 0, cus = 0, per_cu = 0;
    (void)hipGetDevice(&dev);
    (void)hipDeviceGetAttribute(&cus, hipDeviceAttributeMultiprocessorCount, dev);
    (void)hipFuncSetAttribute((const void*)fwd_kernel, hipFuncAttributeMaxDynamicSharedMemorySize, LDS_BYTES);
    (void)hipOccupancyMaxActiveBlocksPerMultiprocessor(&per_cu, fwd_kernel, 512, LDS_BYTES);
    if (per_cu < 1) per_cu = 1;
    if (per_cu > 1) per_cu = 1;
    grid_blocks = cus * per_cu;
    grid_blocks -= grid_blocks % 8;
    if (ws_size < WS_END) fprintf(stderr, "kernel_launch: workspace too small: %zu < %zu\n", ws_size, (size_t)WS_END);
  }
  Params p{};
  for (int i = 0; i < 19; ++i) p.in[i] = (const float*)d_in[i];
  p.out = (float*)d_out;
  p.ws = (unsigned char*)d_ws;
  const float li[4] = {0.2f, 0.35550906759096926f, 0.47071301834358413f, 0.5560582041556852f};
  for (int i = 0; i < 4; ++i) p.lambda_init[i] = li[i];
  void* args[] = {&p};
  hipError_t e = hipLaunchCooperativeKernel((void*)fwd_kernel, dim3(grid_blocks), dim3(512), args, LDS_BYTES, stream);
  if (e != hipSuccess) fprintf(stderr, "cooperative launch failed: %s (grid %d)\n", hipGetErrorString(e), grid_blocks);
}
```

```cpp
#include <hip/hip_runtime.h>
#include <hip/hip_cooperative_groups.h>
#include <stdint.h>
#include <stdio.h>
namespace cg = cooperative_groups;

typedef unsigned short bf16_t;
typedef short bf16x8 __attribute__((ext_vector_type(8)));
typedef short s16x4 __attribute__((ext_vector_type(4)));
typedef float f32x16 __attribute__((ext_vector_type(16)));
typedef float f32x4 __attribute__((ext_vector_type(4)));
typedef float f32x2 __attribute__((ext_vector_type(2)));
typedef __bf16 bf16x2_t __attribute__((ext_vector_type(2)));
typedef unsigned u32x4 __attribute__((ext_vector_type(4)));
typedef unsigned u32x2 __attribute__((ext_vector_type(2)));
#define DI __device__ __forceinline__
#define LDSAS __attribute__((address_space(3)))

constexpr int DM = 1024, SEQ = 4096, NL = 4, INW = 8448, DPLE = 256;
constexpr int G = 4;
constexpr int NG = 24 / G;
constexpr int TG = G * SEQ;
constexpr float EPS = 1e-6f;
constexpr float LOG2E = 1.4426950408889634f;
constexpr int C_AQ = 0, C_AK = 512, C_AV = 1024, C_AG = 1536, C_BQ = 2048, C_BK = 2560, C_BV = 2688, C_BG = 2816,
              C_CQ = 3328, C_CK = 3840, C_CV = 4352, C_CG = 4864, C_MG = 5376;
constexpr size_t WS_BAR = 0;
constexpr size_t WS_ROPE = 16384;
constexpr size_t WS_WIN = 32768;
constexpr size_t WS_WBR = WS_WIN + (size_t)NL * INW * DM * 2;
constexpr size_t WS_WOUT = WS_WBR + (size_t)NL * 3 * DM * 512 * 2;
constexpr size_t WS_WPG = WS_WOUT + (size_t)NL * DM * DM * 2;
constexpr size_t WS_WPE = WS_WPG + (size_t)NL * DM * DM * 2;
constexpr size_t WS_U = WS_WPE + (size_t)NL * DM * DPLE * 2;
constexpr size_t WS_H = WS_U + (size_t)TG * INW * 2;
constexpr size_t WS_OA = WS_H + (size_t)TG * DM * 2;
constexpr size_t WS_Y = WS_OA + (size_t)TG * DM * 2;
constexpr size_t WS_M = WS_Y + (size_t)TG * 1536 * 2;
constexpr size_t WS_Z = WS_M + (size_t)TG * DM * 2;
constexpr size_t WS_END = WS_Z + (size_t)TG * DM * 4;

struct Params {
  const float* in[19];
  float* out;
  unsigned char* ws;
  float lambda_init[4];
};

DI unsigned pk_bf16(float lo, float hi) { f32x2 v = {lo, hi}; bf16x2_t b = __builtin_convertvector(v, bf16x2_t); return __builtin_bit_cast(unsigned, b); }
DI float bf2f(unsigned short b) { return __uint_as_float(((unsigned)b) << 16); }
DI float bflo(unsigned w) { return __uint_as_float(w << 16); }
DI float bfhi(unsigned w) { return __uint_as_float(w & 0xffff0000u); }
DI unsigned short f2bf(float f) { return (unsigned short)(pk_bf16(f, 0.f) & 0xffffu); }
DI float wave_sum(float v) {
#pragma unroll
  for (int o = 32; o >= 1; o >>= 1) v += __shfl_xor(v, o);
  return v;
}
DI float sigmoidf_(float x) { return 1.0f / (1.0f + __expf(-x)); }
DI float siluf_(float x) { return x / (1.0f + __expf(-x)); }
DI int opaque_tid() { int t = threadIdx.x; asm volatile("" : "+v"(t)); return t; }
DI int crow(int i, int h) { return (i & 3) + 8 * (i >> 2) + 4 * h; }
#define MFMA32(a, b, c) __builtin_amdgcn_mfma_f32_32x32x16_bf16((a), (b), (c), 0, 0, 0)

DI void dma16(const void* gsrc, char* lds_wave_base) {
  __builtin_amdgcn_global_load_lds((const unsigned*)gsrc, (LDSAS unsigned*)lds_wave_base, 16, 0, 0);
}
DI void dma_sync() { asm volatile("s_waitcnt vmcnt(0)" ::: "memory"); __syncthreads(); }
template <int NI, bool A_F32>
DI void gemm_acc(f32x16 (&acc)[4][NI], const void* Aptr, int lda, const bf16_t* Wt, int ldw, int K, char* smem) {
  constexpr int A_BYTES = 32768, STG = A_BYTES + 16384 * NI;
  const int tid = opaque_tid(), lane = tid & 63, wave = __builtin_amdgcn_readfirstlane(tid >> 6), wr = wave >> 2, wc = wave & 3, r32 = lane & 31, h = lane >> 5;
  const int drow = wave * 8 + (lane >> 3);
  const int dch = (lane & 7) ^ ((drow >> 1) & 7);
  const bf16_t* wsrc = Wt + (size_t)drow * ldw + dch * 8;
  const bf16_t* asrc = (const bf16_t*)Aptr + (size_t)drow * lda + dch * 8;
  const int lrow = tid >> 3, lch = tid & 7;
  u32x4 ra[4];
  auto gloadA = [&](int k0) {
#pragma unroll
    for (int j = 0; j < 4; ++j) {
      const float* pa = (const float*)Aptr + (size_t)(lrow + 64 * j) * lda + k0 + lch * 8;
      const f32x4 v0 = *(const f32x4*)pa, v1 = *(const f32x4*)(pa + 4);
      ra[j] = (u32x4){pk_bf16(v0[0], v0[1]), pk_bf16(v0[2], v0[3]), pk_bf16(v1[0], v1[1]), pk_bf16(v1[2], v1[3])};
    }
  };
  auto lstoreA = [&](int buf) {
    char* sa = smem + buf * STG;
#pragma unroll
    for (int j = 0; j < 4; ++j) {
      const int row = lrow + 64 * j;
      *(u32x4*)(sa + row * 128 + ((lch ^ ((row >> 1) & 7)) << 4)) = ra[j];
    }
  };
  auto issue = [&](int kt, int buf) {
    char* sa = smem + buf * STG + wave * 1024;
    char* sb = sa + A_BYTES;
    if (!A_F32) {
#pragma unroll
      for (int j = 0; j < 4; ++j) dma16(asrc + (size_t)(64 * j) * lda + kt * 64, sa + j * 8192);
    }
#pragma unroll
    for (int j = 0; j < 2 * NI; ++j) dma16(wsrc + (size_t)(64 * j) * ldw + kt * 64, sb + j * 8192);
  };
  const int nk = K >> 6;
  const int xsw = (r32 >> 1) & 7;
  const int a_base = (128 * wr + r32) * 128, b_base = A_BYTES + (32 * NI * wc + r32) * 128;
  __syncthreads();
  if (A_F32) { gloadA(0); lstoreA(0); }
  issue(0, 0);
  for (int kt = 0; kt < nk; ++kt) {
    dma_sync();
    if (kt + 1 < nk) { issue(kt + 1, (kt + 1) & 1); if (A_F32) gloadA((kt + 1) << 6); }
    const char* st = smem + (kt & 1) * STG;
#pragma unroll
    for (int s = 0; s < 4; ++s) {
      const int sw = ((2 * s + h) ^ xsw) << 4;
      bf16x8 af[4], bfr[NI];
#pragma unroll
      for (int mi = 0; mi < 4; ++mi) af[mi] = *(const bf16x8*)(st + a_base + sw + mi * 4096);
#pragma unroll
      for (int ni = 0; ni < NI; ++ni) bfr[ni] = *(const bf16x8*)(st + b_base + sw + ni * 4096);
#pragma unroll
      for (int mi = 0; mi < 4; ++mi)
#pragma unroll
        for (int ni = 0; ni < NI; ++ni) acc[mi][ni] = MFMA32(af[mi], bfr[ni], acc[mi][ni]);
    }
    if (A_F32) { if (kt + 1 < nk) lstoreA((kt + 1) & 1); }
  }
}
template <int NI>
DI void zero_acc(f32x16 (&acc)[4][NI]) {
#pragma unroll
  for (int a = 0; a < 4; ++a)
#pragma unroll
    for (int b = 0; b < NI; ++b)
#pragma unroll
      for (int i = 0; i < 16; ++i) acc[a][b][i] = 0.f;
}
#define EPI_LOOP(NI_) _Pragma("unroll") for (int mi = 0; mi < 4; ++mi) _Pragma("unroll") for (int ni = 0; ni < NI_; ++ni) _Pragma("unroll") for (int i = 0; i < 16; ++i)
#define EPI_OFF0(mt, nt, NI_, ld) ((unsigned)((mt) * 256 + 128 * (wave >> 2) + 4 * (lane >> 5)) * (unsigned)(ld) + (unsigned)((nt) * 128 * NI_ + 32 * NI_ * (wave & 3) + (lane & 31)))
#define EPI_OFF(off0, ld) ((off0) + (unsigned)((32 * mi + (i & 3) + 8 * (i >> 2)) * (ld) + 32 * ni))
#define EPI_FENCE
DI void tile_decode(int t, int ntn, int& mt, int& nt) {
  const int band = t / (8 * ntn), w = t - band * 8 * ntn;
  nt = w >> 3;
  mt = band * 8 + (w & 7);
}

template <int MODE>
DI void attn_unit(const bf16_t* __restrict__ U, bf16_t* __restrict__ OA, bf16_t* __restrict__ Y, int seq_l, int head, int qb,
                  const float* __restrict__ t5, const float* __restrict__ rpb, char* smem) {
  constexpr int DV = (MODE == 0) ? 128 : 64;
  constexpr int NDB = DV / 32;
  constexpr int KBYTES = 8192, VBYTES = 64 * DV * 2, STAGE = KBYTES + VBYTES;
  constexpr int NVJ = DV / 64;
  float* lut = (float*)(smem + 49152);
  const int tid = opaque_tid(), lane = tid & 63, wave = tid >> 6, r32 = lane & 31, h = lane >> 5;
  const size_t tok0 = (size_t)seq_l * SEQ;
  const int q0 = qb * 256;
  int qcol, kcol, vcol;
  if (MODE == 0) { qcol = C_AQ + head * 64; kcol = C_AK + head * 64; vcol = C_AV + (head >> 1) * 128; }
  else if (MODE == 1) { qcol = C_BQ + head * 64; kcol = C_BK + (head >> 2) * 64; vcol = C_BV + (head >> 2) * 64; }
  else { qcol = C_CQ + head * 64; kcol = C_CK + head * 64; vcol = C_CV + head * 64; }
  int kt0 = 0, NT = SEQ / 64;
  if (MODE == 2) { int b0 = 4 * qb - 4; b0 = b0 < 0 ? 0 : (b0 > 53 ? 53 : b0); kt0 = b0; NT = 11; }

  __syncthreads();
  if (MODE == 0) {
    for (int i = tid; i < 257; i += 512) {
      const int r = i - 128, n = r < 0 ? -r : r;
      int b;
      if (n < 8) b = n;
      else { b = 8 + (n >= 12) + (n >= 16) + (n >= 23) + (n >= 32) + (n >= 46) + (n >= 64) + (n >= 91); }
      if (r > 0) b += 16;
      lut[i] = t5[b * 8 + head] * LOG2E;
    }
  } else if (MODE == 2) {
    for (int i = tid; i < 465; i += 512) lut[i] = rpb[head * 465 + i] * LOG2E;
  }

  const int qi = q0 + wave * 32 + r32;
  bf16x8 qf[4];
  {
    const bf16_t* qp = U + (tok0 + qi) * INW + qcol + 8 * h;
#pragma unroll
    for (int s = 0; s < 4; ++s) {
      const u32x4 raw = *(const u32x4*)(qp + 16 * s);
      u32x4 o;
#pragma unroll
      for (int e = 0; e < 4; ++e) o[e] = pk_bf16(bflo(raw[e]) * 0.125f, bfhi(raw[e]) * 0.125f);
      qf[s] = __builtin_bit_cast(bf16x8, o);
    }
  }

  const int wv = __builtin_amdgcn_readfirstlane(wave);
  int koff, voff[NVJ];
  {
    const int row = wv * 8 + (lane >> 3), ch = (lane & 7) ^ ((row >> 1) & 7);
    koff = row * INW + kcol + ch * 8;
  }
#pragma unroll
  for (int j = 0; j < NVJ; ++j) {
    if (DV == 64) { const int row = wv * 8 + (lane >> 3), ch = (lane & 7) ^ (((row >> 1) & 1) << 2); voff[j] = row * INW + vcol + ch * 8; }
    else { const int row = (wv + 8 * j) * 4 + (lane >> 4), ch = (lane & 15) ^ ((row & 3) << 2); voff[j] = row * INW + vcol + ch * 8; }
  }
  auto issue = [&](int kt, int buf) {
    const bf16_t* base = U + (tok0 + (size_t)kt * 64) * INW;
    char* sk = smem + buf * STAGE + wv * 1024;
    dma16(base + koff, sk);
#pragma unroll
    for (int j = 0; j < NVJ; ++j) dma16(base + voff[j], sk + KBYTES + j * 8192);
  };

  f32x16 o[NDB];
#pragma unroll
  for (int db = 0; db < NDB; ++db)
#pragma unroll
    for (int i = 0; i < 16; ++i) o[db][i] = 0.f;
  float m_run = -INFINITY, l_run = 0.f;

  const int q4 = (lane & 15) >> 2, p4 = lane & 3, blk = (lane >> 4) & 1;
  const int qr = 4 * qb + (wave >> 1), qc = (wave & 1) * 32 + r32;
  int sr = qr - 4; sr = sr < 0 ? 0 : (sr > 56 ? 56 : sr);
  int sc = qc - 8; sc = sc < 0 ? 0 : (sc > 48 ? 48 : sc);

  issue(kt0, 0);
  for (int it = 0; it < NT; ++it) {
    const int kt = kt0 + it;
    dma_sync();
    if (it + 1 < NT) issue(kt + 1, (it + 1) & 1);
    const char* sk = smem + (it & 1) * STAGE;
    const char* sv = sk + KBYTES;
    bool active = true;
    if (MODE == 2) active = (kt >= sr) && (kt < sr + 8);
    if (active) {
      f32x16 st[2];
#pragma unroll
      for (int kb = 0; kb < 2; ++kb) {
#pragma unroll
        for (int i = 0; i < 16; ++i) st[kb][i] = 0.f;
        const int row = 32 * kb + r32;
#pragma unroll
        for (int s = 0; s < 4; ++s) {
          const bf16x8 kf = *(const bf16x8*)(sk + row * 128 + (((2 * s + h) ^ ((row >> 1) & 7)) << 4));
          st[kb] = MFMA32(kf, qf[s], st[kb]);
        }
      }
      if (MODE == 0) {
        const int rel_min = kt * 64 - (q0 + 255), rel_max = kt * 64 + 63 - q0;
        if (rel_min >= 128 || rel_max <= -128) {
          const float bl = (rel_min >= 128) ? lut[256] : lut[0];
#pragma unroll
          for (int kb = 0; kb < 2; ++kb)
#pragma unroll
            for (int i = 0; i < 16; ++i) st[kb][i] = __builtin_fmaf(st[kb][i], LOG2E, bl);
        } else {
#pragma unroll
          for (int kb = 0; kb < 2; ++kb)
#pragma unroll
            for (int i = 0; i < 16; ++i) {
              int rel = kt * 64 + 32 * kb + crow(i, h) - qi;
              rel = rel < -128 ? -128 : (rel > 128 ? 128 : rel);
              st[kb][i] = __builtin_fmaf(st[kb][i], LOG2E, lut[rel + 128]);
              if ((i & 7) == 7) __builtin_amdgcn_sched_barrier(0);
            }
        }
      } else if (MODE == 1) {
#pragma unroll
        for (int kb = 0; kb < 2; ++kb)
#pragma unroll
          for (int i = 0; i < 16; ++i) st[kb][i] *= LOG2E;
      } else {
        const int ri = kt - qr + 7;
#pragma unroll
        for (int kb = 0; kb < 2; ++kb)
#pragma unroll
          for (int i = 0; i < 16; ++i) {
            const int kc = 32 * kb + crow(i, h);
            const bool ok = (kc >= sc) && (kc < sc + 16);
            int ci = kc - qc + 15; ci = ci < 0 ? 0 : (ci > 30 ? 30 : ci);
            const float bl = lut[ri * 31 + ci];
            st[kb][i] = ok ? __builtin_fmaf(st[kb][i], LOG2E, bl) : -INFINITY;
            if ((i & 7) == 7) __builtin_amdgcn_sched_barrier(0);
          }
      }
      float mx = st[0][0];
#pragma unroll
      for (int kb = 0; kb < 2; ++kb)
#pragma unroll
        for (int i = 0; i < 16; ++i) mx = fmaxf(mx, st[kb][i]);
      mx = fmaxf(mx, __shfl_xor(mx, 32));
      const float m_new = fmaxf(m_run, mx);
      const float alpha = __builtin_amdgcn_exp2f(m_run - m_new);
      m_run = m_new;
      float psum = 0.f;
#pragma unroll
      for (int kb = 0; kb < 2; ++kb)
#pragma unroll
        for (int i = 0; i < 16; ++i) { const float pv = __builtin_amdgcn_exp2f(st[kb][i] - m_new); st[kb][i] = pv; psum += pv; }
      l_run = l_run * alpha + psum;
#pragma unroll
      for (int db = 0; db < NDB; ++db)
#pragma unroll
        for (int i = 0; i < 16; ++i) o[db][i] *= alpha;
      bf16x8 pf[2][2];
#pragma unroll
      for (int kb = 0; kb < 2; ++kb)
#pragma unroll
        for (int s2 = 0; s2 < 2; ++s2) {
          u32x4 w;
#pragma unroll
          for (int e = 0; e < 4; ++e) w[e] = pk_bf16(st[kb][8 * s2 + 2 * e], st[kb][8 * s2 + 2 * e + 1]);
          pf[kb][s2] = __builtin_bit_cast(bf16x8, w);
        }
#pragma unroll
      for (int db = 0; db < NDB; ++db)
#pragma unroll
        for (int kb = 0; kb < 2; ++kb)
#pragma unroll
          for (int s2 = 0; s2 < 2; ++s2) {
            s16x4 part[2];
#pragma unroll
            for (int hf = 0; hf < 2; ++hf) {
              const int row = 32 * kb + 16 * s2 + 8 * hf + 4 * h + q4;
              const int chunk = 4 * db + 2 * blk + (p4 >> 1);
              int off;
              if (DV == 64) off = row * 128 + ((chunk ^ (((q4 >> 1) & 1) << 2)) << 4) + (p4 & 1) * 8;
              else off = row * 256 + ((chunk ^ (q4 << 2)) << 4) + (p4 & 1) * 8;
              part[hf] = __builtin_bit_cast(s16x4, __builtin_amdgcn_ds_read_tr16_b64_v4i16((LDSAS s16x4*)(sv + off)));
            }
            const bf16x8 vf = __builtin_shufflevector(part[0], part[1], 0, 1, 2, 3, 4, 5, 6, 7);
            o[db] = MFMA32(vf, pf[kb][s2], o[db]);
          }
    }
  }
  const float l_tot = l_run + __shfl_xor(l_run, 32);
  const float inv = 1.0f / l_tot;
  const size_t tok = tok0 + qi;
#pragma unroll
  for (int db = 0; db < NDB; ++db)
#pragma unroll
    for (int g4 = 0; g4 < 4; ++g4) {
      const int d = 32 * db + 8 * g4 + 4 * h;
      float v0 = o[db][4 * g4] * inv, v1 = o[db][4 * g4 + 1] * inv, v2 = o[db][4 * g4 + 2] * inv, v3 = o[db][4 * g4 + 3] * inv;
      if (MODE == 0) {
        *(u32x2*)(OA + tok * DM + head * 128 + d) = (u32x2){pk_bf16(v0, v1), pk_bf16(v2, v3)};
      } else {
        const int gcol = (MODE == 1 ? C_BG : C_CG) + head * 64 + d;
        const u32x2 gw = *(const u32x2*)(U + tok * INW + gcol);
        v0 *= siluf_(bflo(gw[0])); v1 *= siluf_(bfhi(gw[0])); v2 *= siluf_(bflo(gw[1])); v3 *= siluf_(bfhi(gw[1]));
        *(u32x2*)(Y + tok * 1536 + (MODE == 1 ? 512 : 1024) + head * 64 + d) = (u32x2){pk_bf16(v0, v1), pk_bf16(v2, v3)};
      }
    }
}

DI void transpose_tile(const float* __restrict__ src, bf16_t* __restrict__ dst, int R, int C, int tr, int tc, char* smem) {
  float* tl = (float*)smem;
  const int tid = opaque_tid();
  const int r0 = tr * 64, c0 = tc * 64;
  __syncthreads();
#pragma unroll
  for (int i = 0; i < 8; ++i) {
    const int r = i * 8 + (tid >> 6), c = tid & 63;
    tl[r * 65 + c] = src[(size_t)(r0 + r) * C + c0 + c];
  }
  __syncthreads();
  const int n = tid >> 3, kb = (tid & 7) * 8;
  unsigned w[4];
#pragma unroll
  for (int e = 0; e < 4; ++e) w[e] = pk_bf16(tl[(kb + 2 * e) * 65 + n], tl[(kb + 2 * e + 1) * 65 + n]);
  *(u32x4*)(dst + (size_t)(c0 + n) * R + r0 + kb) = (u32x4){w[0], w[1], w[2], w[3]};
}

#define XB_TMO      128
#define XB_XCNT(j)  (256  + 64 * (j))
#define XB_XSUB(j)  (1280 + 64 * (j))
#define XB_XGEN(j)  (2304 + 64 * (j))
#define XB_TOP      3328
#define XB_TOPGEN   3392
#define XCD_BAR_WORDS 3456
#define XB_SPIN_CAP (1u << 20)
DI unsigned xb_ld(unsigned* p) { return __hip_atomic_load(p, __ATOMIC_RELAXED, __HIP_MEMORY_SCOPE_AGENT); }
DI unsigned xb_add(unsigned* p, unsigned v) { return __hip_atomic_fetch_add(p, v, __ATOMIC_RELAXED, __HIP_MEMORY_SCOPE_AGENT); }
DI unsigned xb_xcc_id() { return (unsigned)__builtin_amdgcn_s_getreg((3 << 11) | 20) & 0xFu; }
#define XB_SPIN(cond, bar) do { unsigned _sp = 0; while (cond) { __builtin_amdgcn_s_sleep(1); \
    if ((++_sp & 255u) == 0u) { if (xb_ld(&(bar)[XB_TMO])) break; if (_sp > XB_SPIN_CAP) { atomicAdd(&(bar)[XB_TMO], 1u); break; } } } } while (0)
struct XcdBarrier { unsigned* bar; unsigned x; volatile LDSAS unsigned* st; };
DI XcdBarrier xcd_barrier_post(unsigned* bar, volatile LDSAS unsigned* st) {
  XcdBarrier b; b.bar = bar; b.x = xb_xcc_id(); b.st = st;
  if (threadIdx.x == 0) (void)xb_add(&bar[XB_XCNT(b.x)], 1u);
  return b;
}
DI void xcd_barrier_complete(unsigned* bar, unsigned x, unsigned& nloc, unsigned& nx) {
  const unsigned Gn = gridDim.x * gridDim.y * gridDim.z;
  unsigned sum, cnt, mine, sp = 0u;
  for (;;) {
    sum = 0u; cnt = 0u; mine = 0u;
#pragma unroll
    for (unsigned j = 0; j < 16; ++j) { const unsigned c = xb_ld(&bar[XB_XCNT(j)]); sum += c; cnt += (c > 0u) ? 1u : 0u; mine = (j == x) ? c : mine; }
    if (sum == Gn) break;
    __builtin_amdgcn_s_sleep(1);
    if ((++sp & 255u) == 0u) { if (xb_ld(&bar[XB_TMO])) break; if (sp > XB_SPIN_CAP) { atomicAdd(&bar[XB_TMO], 1u); break; } }
  }
  nloc = mine > 0u ? mine : 1u; nx = cnt > 0u ? cnt : 1u;
}
DI void xcd_barrier(const XcdBarrier& b) {
  asm volatile("s_waitcnt vmcnt(0)" ::: "memory");
  __syncthreads();
  if (threadIdx.x == 0) {
    unsigned* bar = b.bar;
    __builtin_amdgcn_s_waitcnt(0);
    unsigned nloc = b.st[0], nx = b.st[1];
    if (nloc == 0u) { xcd_barrier_complete(bar, b.x, nloc, nx); b.st[0] = nloc; b.st[1] = nx; }
    const unsigned old = xb_add(&bar[XB_XSUB(b.x)], 1u);
    const unsigned gen = old / nloc;
    if (old + 1u == (gen + 1u) * nloc) {
      __builtin_amdgcn_fence(__ATOMIC_RELEASE, "agent");
      asm volatile("s_waitcnt vmcnt(0)" ::: "memory");
      const unsigned og = xb_add(&bar[XB_TOP], 1u);
      const unsigned tg = og / nx;
      if (og + 1u == (tg + 1u) * nx) xb_add(&bar[XB_TOPGEN], 1u);
      else XB_SPIN(xb_ld(&bar[XB_TOPGEN]) == tg, bar);
      __builtin_amdgcn_fence(__ATOMIC_ACQUIRE, "agent");
      xb_add(&bar[XB_XGEN(b.x)], 1u);
      asm volatile("s_waitcnt vmcnt(0)" ::: "memory");
    } else {
      XB_SPIN(xb_ld(&bar[XB_XGEN(b.x)]) == gen, bar);
      __builtin_amdgcn_fence(__ATOMIC_ACQUIRE, "agent");
      asm volatile("s_waitcnt vmcnt(0)" ::: "memory");
    }
  }
  __syncthreads();
}

constexpr int LDS_BYTES = 131072 + 16;
__global__ void __launch_bounds__(512, 2) fwd_kernel(Params p) {
  extern __shared__ __attribute__((aligned(16))) char smem[];
  cg::grid_group grid = cg::this_grid();
  const int nb = gridDim.x, bid = blockIdx.x;
  volatile LDSAS unsigned* xb_st = (volatile LDSAS unsigned*)(smem + 131072);
  if (threadIdx.x == 0) { xb_st[0] = 0u; xb_st[1] = 0u; xb_st[2] = 0u; xb_st[3] = 0u; }
  __syncthreads();
  const XcdBarrier xb = xcd_barrier_post((unsigned*)(p.ws + WS_BAR), xb_st);
#define GSYNC() xcd_barrier(xb)
  const int vb = (bid & 7) * (nb >> 3) + (bid >> 3);
  const int nw = nb * 8;
#define PHASE_IDS const int tid = opaque_tid(), lane = tid & 63, wave = tid >> 6, gw = vb * 8 + wave; (void)lane; (void)gw;
  unsigned char* ws = p.ws;
  bf16_t* WIN = (bf16_t*)(ws + WS_WIN);
  bf16_t* WBR = (bf16_t*)(ws + WS_WBR);
  bf16_t* WOUT = (bf16_t*)(ws + WS_WOUT);
  bf16_t* WPG = (bf16_t*)(ws + WS_WPG);
  bf16_t* WPE = (bf16_t*)(ws + WS_WPE);
  float* ROPE = (float*)(ws + WS_ROPE);
  bf16_t* U = (bf16_t*)(ws + WS_U);
  bf16_t* H = (bf16_t*)(ws + WS_H);
  bf16_t* OA = (bf16_t*)(ws + WS_OA);
  bf16_t* Y = (bf16_t*)(ws + WS_Y);
  bf16_t* M = (bf16_t*)(ws + WS_M);
  float* Z = (float*)(ws + WS_Z);

  {
        PHASE_IDS
    for (int t = bid; t < 4 * 3072; t += nb) {
      const int layer = t / 3072;
      int r = t - layer * 3072;
      if (r < 2112) {
        transpose_tile(p.in[6] + (size_t)layer * DM * INW, WIN + (size_t)layer * INW * DM, DM, INW, r / 132, r % 132, smem);
      } else if (r < 2112 + 384) {
        r -= 2112;
        const int j = r / 128; r -= j * 128;
        transpose_tile(p.in[12 + j] + (size_t)layer * 512 * DM, WBR + ((size_t)layer * 3 + j) * DM * 512, 512, DM, r / 16, r % 16, smem);
      } else if (r < 2112 + 384 + 256) {
        r -= 2112 + 384;
        transpose_tile(p.in[15] + (size_t)layer * DM * DM, WOUT + (size_t)layer * DM * DM, DM, DM, r / 16, r % 16, smem);
      } else if (r < 2112 + 384 + 512) {
        r -= 2112 + 384 + 256;
        transpose_tile(p.in[18] + (size_t)layer * DM * DM, WPG + (size_t)layer * DM * DM, DM, DM, r / 16, r % 16, smem);
      } else {
        r -= 2112 + 384 + 512;
        transpose_tile(p.in[17] + (size_t)layer * DPLE * DM, WPE + (size_t)layer * DM * DPLE, DPLE, DM, r / 16, r % 16, smem);
      }
    }
    if (bid < 2) {
      const int i = bid * 512 + tid;
      const int pos = i >> 4, f = i & 15;
      const float inv = powf(10000.0f, -(float)f / 16.0f);
      const float ang = (float)pos * inv;
      ROPE[i] = cosf(ang);
      ROPE[1024 + i] = sinf(ang);
    }
  }
  grid.sync();

  for (int gi = 0; gi < NG; ++gi) {
    const int seq0 = gi * G;
    const bool is_prompt = seq0 < 16;
    const float* xin = is_prompt ? p.in[0] + (size_t)seq0 * SEQ * DM : p.in[1] + (size_t)(seq0 - 16) * SEQ * DM;
    float* xout = p.out + (size_t)seq0 * SEQ * DM;
    for (int layer = 0; layer < NL; ++layer) {
      const float* xres = (layer == 0) ? xin : (const float*)xout;
      const float* pin = is_prompt ? p.in[2] + ((size_t)layer * 16 + seq0) * SEQ * DPLE : p.in[3] + ((size_t)layer * 8 + (seq0 - 16)) * SEQ * DPLE;
      const bf16_t* win = WIN + (size_t)layer * INW * DM;
      const bf16_t* wbr = WBR + (size_t)layer * 3 * DM * 512;
      const bf16_t* wout = WOUT + (size_t)layer * DM * DM;
      const bf16_t* wpg = WPG + (size_t)layer * DM * DM;
      const bf16_t* wpe = WPE + (size_t)layer * DM * DPLE;

      {
        PHASE_IDS
        const float* g = p.in[5] + layer * DM;
        for (int row = gw; row < TG; row += nw) {
          const float* xr = xres + (size_t)row * DM;
          f32x4 v[4];
          float ss = 0.f;
#pragma unroll
          for (int j = 0; j < 4; ++j) { v[j] = *(const f32x4*)(xr + 4 * (lane + 64 * j)); ss += v[j][0] * v[j][0] + v[j][1] * v[j][1] + v[j][2] * v[j][2] + v[j][3] * v[j][3]; }
          ss = wave_sum(ss);
          const float rstd = rsqrtf(ss * (1.0f / DM) + EPS);
#pragma unroll
          for (int j = 0; j < 4; ++j) {
            const f32x4 gv = *(const f32x4*)(g + 4 * (lane + 64 * j));
            *(u32x2*)(H + (size_t)row * DM + 4 * (lane + 64 * j)) =
                (u32x2){pk_bf16(v[j][0] * rstd * gv[0], v[j][1] * rstd * gv[1]), pk_bf16(v[j][2] * rstd * gv[2], v[j][3] * rstd * gv[3])};
          }
        }
      }
      GSYNC();
      for (int t = vb; t < (TG / 256) * (INW / 256); t += nb) {
        PHASE_IDS
        int mt, nt; tile_decode(t, INW / 256, mt, nt);
        f32x16 acc[4][2]; zero_acc<2>(acc);
        gemm_acc<2, false>(acc, H + (size_t)mt * 256 * DM, DM, win + (size_t)nt * 256 * DM, DM, DM, smem);
        const unsigned o0 = EPI_OFF0(mt, nt, 2, INW);
        EPI_LOOP(2) { U[EPI_OFF(o0, INW)] = f2bf(acc[mi][ni][i]); }
      }
      GSYNC();
      {
        PHASE_IDS
        const float* qg = p.in[9] + layer * 64;
        const float* kg = p.in[10] + layer * 64;
        const float gq = qg[lane], gk = kg[lane];
        const int axis = lane >> 5, f = lane & 15, half = (lane >> 4) & 1;
        for (int row = gw; row < TG; row += nw) {
          const int tt = row & (SEQ - 1);
          const int pos = axis ? (tt & 63) : (tt >> 6);
          const float c = ROPE[pos * 16 + f], s = ROPE[1024 + pos * 16 + f];
          bf16_t* ur = U + (size_t)row * INW;
#pragma unroll
          for (int hd = 0; hd < 10; ++hd) {
            const int col = (hd < 8) ? (C_BQ + hd * 64) : (C_BK + (hd - 8) * 64);
            const float x = bf2f(ur[col + lane]);
            const float ss = wave_sum(x * x);
            const float y = x * rsqrtf(ss * (1.0f / 64.0f) + EPS) * (hd < 8 ? gq : gk);
            const float pt = __shfl_xor(y, 16);
            const float o = half ? (y * c + pt * s) : (y * c - pt * s);
            ur[col + lane] = f2bf(o);
          }
        }
      }
      GSYNC();
      {
        PHASE_IDS
        const float* rpb = p.in[11] + (size_t)layer * 8 * 465;
        const int nu = G * 8 * 16;
        int t = vb;
        for (; t < nu; t += nb) attn_unit<0>(U, OA, Y, t >> 7, (t >> 4) & 7, t & 15, p.in[4], rpb, smem);
        for (; t < 2 * nu; t += nb) { const int r = t - nu; attn_unit<1>(U, OA, Y, r >> 7, (r >> 4) & 7, r & 15, p.in[4], rpb, smem); }
        for (; t < 3 * nu; t += nb) { const int r = t - 2 * nu; attn_unit<2>(U, OA, Y, r >> 7, (r >> 4) & 7, r & 15, p.in[4], rpb, smem); }
      }
      GSYNC();
      {
        PHASE_IDS
        const float* lp = p.in[7] + layer * 256;
        const float li = p.lambda_init[layer];
        const float s1 = wave_sum(lp[lane] * lp[64 + lane]), s2 = wave_sum(lp[128 + lane] * lp[192 + lane]);
        const float lam = __expf(s1) - __expf(s2) + li;
        const float* sg = p.in[8] + layer * 128 + (lane & 15) * 8;
        float sgv[8];
#pragma unroll
        for (int e = 0; e < 8; ++e) sgv[e] = sg[e] * (1.0f - li);
        const int hh = lane >> 4, dd = (lane & 15) * 8;
        for (int row = gw; row < TG; row += nw) {
          const u32x4 a0 = *(const u32x4*)(OA + (size_t)row * DM + hh * 256 + dd);
          const u32x4 a1 = *(const u32x4*)(OA + (size_t)row * DM + hh * 256 + 128 + dd);
          const u32x4 gt = *(const u32x4*)(U + (size_t)row * INW + C_AG + lane * 8);
          float dv[8];
          float ss = 0.f;
#pragma unroll
          for (int e = 0; e < 4; ++e) {
            dv[2 * e] = bflo(a0[e]) - lam * bflo(a1[e]);
            dv[2 * e + 1] = bfhi(a0[e]) - lam * bfhi(a1[e]);
            ss += dv[2 * e] * dv[2 * e] + dv[2 * e + 1] * dv[2 * e + 1];
          }
          ss += __shfl_xor(ss, 1); ss += __shfl_xor(ss, 2); ss += __shfl_xor(ss, 4); ss += __shfl_xor(ss, 8);
          const float rstd = rsqrtf(ss * (1.0f / 128.0f) + EPS);
          u32x4 ow;
#pragma unroll
          for (int e = 0; e < 4; ++e)
            ow[e] = pk_bf16(dv[2 * e] * rstd * sgv[2 * e] * siluf_(bflo(gt[e])), dv[2 * e + 1] * rstd * sgv[2 * e + 1] * siluf_(bfhi(gt[e])));
          *(u32x4*)(Y + (size_t)row * 1536 + lane * 8) = ow;
        }
      }
      GSYNC();
      for (int t = vb; t < (TG / 256) * 4; t += nb) {
        PHASE_IDS
        int mt, nt; tile_decode(t, 4, mt, nt);
        f32x16 acc[4][2]; zero_acc<2>(acc);
        for (int j = 0; j < 3; ++j) {
          gemm_acc<2, false>(acc, Y + (size_t)mt * 256 * 1536 + 512 * j, 1536, wbr + ((size_t)j * DM + nt * 256) * 512, 512, 512, smem);
          const bf16_t* gp = U + C_MG + j * DM;
          const float fl = (j < 2) ? 1.0f : 0.0f;
          unsigned g0;
          { const int tid = opaque_tid(), lane = tid & 63, wave = tid >> 6; g0 = EPI_OFF0(mt, nt, 2, INW); }
#pragma unroll
          for (int mi = 0; mi < 4; ++mi)
#pragma unroll
            for (int ni = 0; ni < 2; ++ni) {
#pragma unroll
              for (int i = 0; i < 16; ++i) {
                const unsigned o = EPI_OFF(g0, INW);
                const float ea = __expf(-bf2f(gp[o]));
                const float eb = __expf(-bf2f(gp[o + DM])) * fl;
                acc[mi][ni][i] *= (1.0f + eb) * __builtin_amdgcn_rcpf(1.0f + ea);
              }
              asm volatile("" : "+v"(acc[mi][ni]) : : "memory");
            }
        }
        const unsigned o0 = EPI_OFF0(mt, nt, 2, DM);
        EPI_LOOP(2) { M[EPI_OFF(o0, DM)] = f2bf(acc[mi][ni][i]); }
      }
      GSYNC();
      for (int t = vb; t < (TG / 256) * 4; t += nb) {
        PHASE_IDS
        int mt, nt; tile_decode(t, 4, mt, nt);
        f32x16 acc[4][2]; zero_acc<2>(acc);
        gemm_acc<2, false>(acc, M + (size_t)mt * 256 * DM, DM, wout + (size_t)nt * 256 * DM, DM, DM, smem);
        const unsigned o0 = EPI_OFF0(mt, nt, 2, DM);
        EPI_LOOP(2) { Z[EPI_OFF(o0, DM)] = acc[mi][ni][i]; }
      }
      GSYNC();
      {
        PHASE_IDS
        const float* g = p.in[16] + layer * DM;
        for (int row = gw; row < TG; row += nw) {
          const float* zr = Z + (size_t)row * DM;
          const float* xr = xres + (size_t)row * DM;
          f32x4 v[4];
          float ss = 0.f;
#pragma unroll
          for (int j = 0; j < 4; ++j) { v[j] = *(const f32x4*)(zr + 4 * (lane + 64 * j)); ss += v[j][0] * v[j][0] + v[j][1] * v[j][1] + v[j][2] * v[j][2] + v[j][3] * v[j][3]; }
          ss = wave_sum(ss);
          const float rstd = rsqrtf(ss * (1.0f / DM) + EPS);
#pragma unroll
          for (int j = 0; j < 4; ++j) {
            const int c = 4 * (lane + 64 * j);
            const f32x4 gv = *(const f32x4*)(g + c);
            const f32x4 xv = *(const f32x4*)(xr + c);
            f32x4 o;
#pragma unroll
            for (int e = 0; e < 4; ++e) o[e] = xv[e] + v[j][e] * rstd * gv[e];
            *(f32x4*)(xout + (size_t)row * DM + c) = o;
            *(u32x2*)(H + (size_t)row * DM + c) = (u32x2){pk_bf16(o[0], o[1]), pk_bf16(o[2], o[3])};
          }
        }
      }
      GSYNC();
      for (int t = vb; t < (TG / 256) * 8; t += nb) {
        PHASE_IDS
        int mt, nt; tile_decode(t, 8, mt, nt);
        unsigned pe[4][8];
        {
          f32x16 acc2[4][1]; zero_acc<1>(acc2);
          gemm_acc<1, true>(acc2, pin + (size_t)mt * 256 * DPLE, DPLE, wpe + (size_t)nt * 128 * DPLE, DPLE, DPLE, smem);
#pragma unroll
          for (int mi = 0; mi < 4; ++mi)
#pragma unroll
            for (int e = 0; e < 8; ++e) pe[mi][e] = pk_bf16(acc2[mi][0][2 * e], acc2[mi][0][2 * e + 1]);
        }
        f32x16 acc[4][1]; zero_acc<1>(acc);
        gemm_acc<1, false>(acc, H + (size_t)mt * 256 * DM, DM, wpg + (size_t)nt * 128 * DM, DM, DM, smem);
        const unsigned o0 = EPI_OFF0(mt, nt, 1, DM);
        EPI_LOOP(1) {
          float* xp = xout + EPI_OFF(o0, DM);
          const float pv = (i & 1) ? bfhi(pe[mi][i >> 1]) : bflo(pe[mi][i >> 1]);
          *xp = *xp + sigmoidf_(acc[mi][ni][i]) * pv;
        }
      }
      GSYNC();
    }
  }
}

extern "C" void kernel_launch(void* const* d_in, const int* in_sizes, int n_in, void* d_out, int out_size, void* d_ws, size_t ws_size, hipStream_t stream) {
  static int grid_blocks = 0;
  if (!grid_blocks) {
    int dev = 0, cus = 0, per_cu = 0;
    (void)hipGetDevice(&dev);
    (void)hipDeviceGetAttribute(&cus, hipDeviceAttributeMultiprocessorCount, dev);
    (void)hipFuncSetAttribute((const void*)fwd_kernel, hipFuncAttributeMaxDynamicSharedMemorySize, LDS_BYTES);
    (void)hipOccupancyMaxActiveBlocksPerMultiprocessor(&per_cu, fwd_kernel, 512, LDS_BYTES);
    if (per_cu < 1) per_cu = 1;
    if (per_cu > 1) per_cu = 1;
    grid_blocks = cus * per_cu;
    grid_blocks -= grid_blocks % 8;
    if (ws_size < WS_END) fprintf(stderr, "kernel_launch: workspace too small: %zu < %zu\n", ws_size, (size_t)WS_END);
  }
  Params p{};
  for (int i = 0; i < 19; ++i) p.in[i] = (const float*)d_in[i];
  p.out = (float*)d_out;
  p.ws = (unsigned char*)d_ws;
  const float li[4] = {0.2f, 0.35550906759096926f, 0.47071301834358413f, 0.5560582041556852f};
  for (int i = 0; i < 4; ++i) p.lambda_init[i] = li[i];
  (void)hipMemsetAsync((char*)d_ws + WS_BAR, 0, 16384, stream);
  void* args[] = {&p};
  hipError_t e = hipLaunchCooperativeKernel((void*)fwd_kernel, dim3(grid_blocks), dim3(512), args, LDS_BYTES, stream);
  if (e != hipSuccess) fprintf(stderr, "cooperative launch failed: %s (grid %d)\n", hipGetErrorString(e), grid_blocks);
}
```

```cpp
#include <hip/hip_runtime.h>
#include <hip/hip_cooperative_groups.h>
#include <stdint.h>
#include <stdio.h>
namespace cg = cooperative_groups;

typedef unsigned short bf16_t;
typedef short bf16x8 __attribute__((ext_vector_type(8)));
typedef short s16x4 __attribute__((ext_vector_type(4)));
typedef float f32x16 __attribute__((ext_vector_type(16)));
typedef float f32x4 __attribute__((ext_vector_type(4)));
typedef float f32x2 __attribute__((ext_vector_type(2)));
typedef __bf16 bf16x2_t __attribute__((ext_vector_type(2)));
typedef unsigned u32x4 __attribute__((ext_vector_type(4)));
typedef unsigned u32x2 __attribute__((ext_vector_type(2)));
#define DI __device__ __forceinline__
#define LDSAS __attribute__((address_space(3)))

constexpr int DM = 1024, SEQ = 4096, NL = 4, INW = 8448, DPLE = 256;
constexpr int G = 4;
constexpr int NG = 24 / G;
constexpr int TG = G * SEQ;
constexpr float EPS = 1e-6f;
constexpr float LOG2E = 1.4426950408889634f;
constexpr int C_AQ = 0, C_AK = 512, C_AV = 1024, C_AG = 1536, C_BQ = 2048, C_BK = 2560, C_BV = 2688, C_BG = 2816,
              C_CQ = 3328, C_CK = 3840, C_CV = 4352, C_CG = 4864, C_MG = 5376;
constexpr size_t WS_BAR = 0;
constexpr size_t WS_ROPE = 16384;
constexpr size_t WS_WIN = 32768;
constexpr size_t WS_WBR = WS_WIN + (size_t)NL * INW * DM * 2;
constexpr size_t WS_WOUT = WS_WBR + (size_t)NL * 3 * DM * 512 * 2;
constexpr size_t WS_WPG = WS_WOUT + (size_t)NL * DM * DM * 2;
constexpr size_t WS_WPE = WS_WPG + (size_t)NL * DM * DM * 2;
constexpr size_t WS_U = WS_WPE + (size_t)NL * DM * DPLE * 2;
constexpr size_t WS_H = WS_U + (size_t)TG * INW * 2;
constexpr size_t WS_OA = WS_H + (size_t)TG * DM * 2;
constexpr size_t WS_Y = WS_OA + (size_t)TG * DM * 2;
constexpr size_t WS_M = WS_Y + (size_t)TG * 1536 * 2;
constexpr size_t WS_Z = WS_M + (size_t)TG * DM * 2;
constexpr size_t WS_GP = WS_Z + (size_t)TG * DM * 4;
constexpr size_t WS_END = WS_GP + (size_t)TG * 3072 * 2;

struct Params {
  const float* in[19];
  float* out;
  unsigned char* ws;
  float lambda_init[4];
};

DI unsigned pk_bf16(float lo, float hi) { f32x2 v = {lo, hi}; bf16x2_t b = __builtin_convertvector(v, bf16x2_t); return __builtin_bit_cast(unsigned, b); }
DI float bf2f(unsigned short b) { return __uint_as_float(((unsigned)b) << 16); }
DI float bflo(unsigned w) { return __uint_as_float(w << 16); }
DI float bfhi(unsigned w) { return __uint_as_float(w & 0xffff0000u); }
DI unsigned short f2bf(float f) { return (unsigned short)(pk_bf16(f, 0.f) & 0xffffu); }
DI float wave_sum(float v) {
#pragma unroll
  for (int o = 32; o >= 1; o >>= 1) v += __shfl_xor(v, o);
  return v;
}
DI float sigmoidf_(float x) { return 1.0f / (1.0f + __expf(-x)); }
DI float siluf_(float x) { return x / (1.0f + __expf(-x)); }
DI int opaque_tid() { int t = threadIdx.x; asm volatile("" : "+v"(t)); return t; }
DI int crow(int i, int h) { return (i & 3) + 8 * (i >> 2) + 4 * h; }
#define MFMA32(a, b, c) __builtin_amdgcn_mfma_f32_32x32x16_bf16((a), (b), (c), 0, 0, 0)

DI void dma16(const void* gsrc, char* lds_wave_base) {
  __builtin_amdgcn_global_load_lds((const unsigned*)gsrc, (LDSAS unsigned*)lds_wave_base, 16, 0, 0);
}
DI void dma_sync() { asm volatile("s_waitcnt vmcnt(0)" ::: "memory"); __syncthreads(); }
template <int NI, bool A_F32>
DI void gemm_acc(f32x16 (&acc)[4][NI], const void* Aptr, int lda, const bf16_t* Wt, int ldw, int K, char* smem) {
  constexpr int A_BYTES = 32768, STG = A_BYTES + 16384 * NI;
  const int tid = opaque_tid(), lane = tid & 63, wave = __builtin_amdgcn_readfirstlane(tid >> 6), wr = wave >> 2, wc = wave & 3, r32 = lane & 31, h = lane >> 5;
  const int drow = wave * 8 + (lane >> 3);
  const int dch = (lane & 7) ^ ((drow >> 1) & 7);
  const bf16_t* wsrc = Wt + (size_t)drow * ldw + dch * 8;
  const bf16_t* asrc = (const bf16_t*)Aptr + (size_t)drow * lda + dch * 8;
  const int lrow = tid >> 3, lch = tid & 7;
  u32x4 ra[4];
  auto gloadA = [&](int k0) {
#pragma unroll
    for (int j = 0; j < 4; ++j) {
      const float* pa = (const float*)Aptr + (size_t)(lrow + 64 * j) * lda + k0 + lch * 8;
      const f32x4 v0 = *(const f32x4*)pa, v1 = *(const f32x4*)(pa + 4);
      ra[j] = (u32x4){pk_bf16(v0[0], v0[1]), pk_bf16(v0[2], v0[3]), pk_bf16(v1[0], v1[1]), pk_bf16(v1[2], v1[3])};
    }
  };
  auto lstoreA = [&](int buf) {
    char* sa = smem + buf * STG;
#pragma unroll
    for (int j = 0; j < 4; ++j) {
      const int row = lrow + 64 * j;
      *(u32x4*)(sa + row * 128 + ((lch ^ ((row >> 1) & 7)) << 4)) = ra[j];
    }
  };
  auto issue = [&](int kt, int buf) {
    char* sa = smem + buf * STG + wave * 1024;
    char* sb = sa + A_BYTES;
    if (!A_F32) {
#pragma unroll
      for (int j = 0; j < 4; ++j) dma16(asrc + (size_t)(64 * j) * lda + kt * 64, sa + j * 8192);
    }
#pragma unroll
    for (int j = 0; j < 2 * NI; ++j) dma16(wsrc + (size_t)(64 * j) * ldw + kt * 64, sb + j * 8192);
  };
  const int nk = K >> 6;
  const int xsw = (r32 >> 1) & 7;
  const int a_base = (128 * wr + r32) * 128, b_base = A_BYTES + (32 * NI * wc + r32) * 128;
  __syncthreads();
  if (A_F32) { gloadA(0); lstoreA(0); }
  issue(0, 0);
  for (int kt = 0; kt < nk; ++kt) {
    dma_sync();
    if (kt + 1 < nk) { issue(kt + 1, (kt + 1) & 1); if (A_F32) gloadA((kt + 1) << 6); }
    const char* st = smem + (kt & 1) * STG;
#pragma unroll
    for (int s = 0; s < 4; ++s) {
      const int sw = ((2 * s + h) ^ xsw) << 4;
      bf16x8 af[4], bfr[NI];
#pragma unroll
      for (int mi = 0; mi < 4; ++mi) af[mi] = *(const bf16x8*)(st + a_base + sw + mi * 4096);
#pragma unroll
      for (int ni = 0; ni < NI; ++ni) bfr[ni] = *(const bf16x8*)(st + b_base + sw + ni * 4096);
#pragma unroll
      for (int mi = 0; mi < 4; ++mi)
#pragma unroll
        for (int ni = 0; ni < NI; ++ni) acc[mi][ni] = MFMA32(af[mi], bfr[ni], acc[mi][ni]);
    }
    if (A_F32) { if (kt + 1 < nk) lstoreA((kt + 1) & 1); }
  }
}
template <int NI>
DI void zero_acc(f32x16 (&acc)[4][NI]) {
#pragma unroll
  for (int a = 0; a < 4; ++a)
#pragma unroll
    for (int b = 0; b < NI; ++b)
#pragma unroll
      for (int i = 0; i < 16; ++i) acc[a][b][i] = 0.f;
}
#define EPI_LOOP(NI_) _Pragma("unroll") for (int mi = 0; mi < 4; ++mi) _Pragma("unroll") for (int ni = 0; ni < NI_; ++ni) _Pragma("unroll") for (int i = 0; i < 16; ++i)
#define EPI_OFF0(mt, nt, NI_, ld) ((unsigned)((mt) * 256 + 128 * (wave >> 2) + 4 * (lane >> 5)) * (unsigned)(ld) + (unsigned)((nt) * 128 * NI_ + 32 * NI_ * (wave & 3) + (lane & 31)))
#define EPI_OFF(off0, ld) ((off0) + (unsigned)((32 * mi + (i & 3) + 8 * (i >> 2)) * (ld) + 32 * ni))
#define EPI_FENCE
DI void stage_tile_bf16(const f32x16 (&acc)[4][2], char* wl, int lane) {
  const int r32 = lane & 31, h = lane >> 5;
#pragma unroll
  for (int mi = 0; mi < 4; ++mi)
#pragma unroll
    for (int ni = 0; ni < 2; ++ni)
#pragma unroll
      for (int i = 0; i < 16; ++i) *(bf16_t*)(wl + (32 * mi + crow(i, h)) * 128 + (32 * ni + r32) * 2) = f2bf(acc[mi][ni][i]);
}
DI void tile_decode(int t, int ntn, int& mt, int& nt) {
  const int band = t / (8 * ntn), w = t - band * 8 * ntn;
  nt = w >> 3;
  mt = band * 8 + (w & 7);
}

template <int MODE>
DI void attn_unit(const bf16_t* __restrict__ U, bf16_t* __restrict__ OA, bf16_t* __restrict__ Y, int seq_l, int head, int qb,
                  const float* __restrict__ t5, const float* __restrict__ rpb, char* smem) {
  constexpr int DV = (MODE == 0) ? 128 : 64;
  constexpr int NDB = DV / 32;
  constexpr int KBYTES = 8192, VBYTES = 64 * DV * 2, STAGE = KBYTES + VBYTES;
  constexpr int NVJ = DV / 64;
  float* lut = (float*)(smem + 49152);
  const int tid = opaque_tid(), lane = tid & 63, wave = tid >> 6, r32 = lane & 31, h = lane >> 5;
  const size_t tok0 = (size_t)seq_l * SEQ;
  const int q0 = qb * 256;
  int qcol, kcol, vcol;
  if (MODE == 0) { qcol = C_AQ + head * 64; kcol = C_AK + head * 64; vcol = C_AV + (head >> 1) * 128; }
  else if (MODE == 1) { qcol = C_BQ + head * 64; kcol = C_BK + (head >> 2) * 64; vcol = C_BV + (head >> 2) * 64; }
  else { qcol = C_CQ + head * 64; kcol = C_CK + head * 64; vcol = C_CV + head * 64; }
  int kt0 = 0, NT = SEQ / 64;
  if (MODE == 2) { int b0 = 4 * qb - 4; b0 = b0 < 0 ? 0 : (b0 > 53 ? 53 : b0); kt0 = b0; NT = 11; }

  __syncthreads();
  if (MODE == 0) {
    for (int i = tid; i < 257; i += 512) {
      const int r = i - 128, n = r < 0 ? -r : r;
      int b;
      if (n < 8) b = n;
      else { b = 8 + (n >= 12) + (n >= 16) + (n >= 23) + (n >= 32) + (n >= 46) + (n >= 64) + (n >= 91); }
      if (r > 0) b += 16;
      lut[i] = t5[b * 8 + head] * LOG2E;
    }
  } else if (MODE == 2) {
    for (int i = tid; i < 465; i += 512) lut[i] = rpb[head * 465 + i] * LOG2E;
  }

  const int qi = q0 + wave * 32 + r32;
  bf16x8 qf[4];
  {
    const bf16_t* qp = U + (tok0 + qi) * INW + qcol + 8 * h;
#pragma unroll
    for (int s = 0; s < 4; ++s) {
      const u32x4 raw = *(const u32x4*)(qp + 16 * s);
      u32x4 o;
#pragma unroll
      for (int e = 0; e < 4; ++e) o[e] = pk_bf16(bflo(raw[e]) * 0.125f, bfhi(raw[e]) * 0.125f);
      qf[s] = __builtin_bit_cast(bf16x8, o);
    }
  }

  const int wv = __builtin_amdgcn_readfirstlane(wave);
  int koff, voff[NVJ];
  {
    const int row = wv * 8 + (lane >> 3), ch = (lane & 7) ^ ((row >> 1) & 7);
    koff = row * INW + kcol + ch * 8;
  }
#pragma unroll
  for (int j = 0; j < NVJ; ++j) {
    if (DV == 64) { const int row = wv * 8 + (lane >> 3), ch = (lane & 7) ^ (((row >> 1) & 1) << 2); voff[j] = row * INW + vcol + ch * 8; }
    else { const int row = (wv + 8 * j) * 4 + (lane >> 4), ch = (lane & 15) ^ ((row & 3) << 2); voff[j] = row * INW + vcol + ch * 8; }
  }
  auto issueK = [&](int kt, int buf) {
    const bf16_t* base = U + (tok0 + (size_t)kt * 64) * INW;
    dma16(base + koff, smem + buf * KBYTES + wv * 1024);
  };
  auto issueV = [&](int kt, int buf) {
    const bf16_t* base = U + (tok0 + (size_t)kt * 64) * INW;
#pragma unroll
    for (int j = 0; j < NVJ; ++j) dma16(base + voff[j], smem + 16384 + buf * VBYTES + wv * 1024 + j * 8192);
  };
  auto qk_tile = [&](const char* sk, f32x16 (&s_)[2]) {
#pragma unroll
    for (int kb = 0; kb < 2; ++kb) {
#pragma unroll
      for (int i = 0; i < 16; ++i) s_[kb][i] = 0.f;
      const int row = 32 * kb + r32;
#pragma unroll
      for (int s = 0; s < 4; ++s) {
        const bf16x8 kf = *(const bf16x8*)(sk + row * 128 + (((2 * s + h) ^ ((row >> 1) & 7)) << 4));
        s_[kb] = MFMA32(kf, qf[s], s_[kb]);
      }
    }
  };

  f32x16 o[NDB];
#pragma unroll
  for (int db = 0; db < NDB; ++db)
#pragma unroll
    for (int i = 0; i < 16; ++i) o[db][i] = 0.f;
  float m_run = -INFINITY, l_run = 0.f;

  const int q4 = (lane & 15) >> 2, p4 = lane & 3, blk = (lane >> 4) & 1;
  const int qr = 4 * qb + (wave >> 1), qc = (wave & 1) * 32 + r32;
  int sr = qr - 4; sr = sr < 0 ? 0 : (sr > 56 ? 56 : sr);
  int sc = qc - 8; sc = sc < 0 ? 0 : (sc > 48 ? 48 : sc);

  f32x16 st[2], sn[2];
  issueK(kt0, 0);
  dma_sync();
  qk_tile(smem, st);
  if (NT > 1) issueK(kt0 + 1, 1);
  issueV(kt0, 0);
  for (int it = 0; it < NT; ++it) {
    const int kt = kt0 + it;
    dma_sync();
    if (it + 2 < NT) issueK(kt + 2, it & 1);
    if (it + 1 < NT) issueV(kt + 1, (it + 1) & 1);
    const char* sknext = smem + ((it + 1) & 1) * KBYTES;
    const char* sv = smem + 16384 + (it & 1) * VBYTES;
    bool active = true;
    if (MODE == 2) active = (kt >= sr) && (kt < sr + 8);
    if (!active) { qk_tile(sknext, sn); }
    else {
      bool uni = (MODE == 1);
      float bl = 0.f;
      if (MODE == 0) {
        const int rel_min = kt * 64 - (q0 + 255), rel_max = kt * 64 + 63 - q0;
        uni = (rel_min >= 128) || (rel_max <= -128);
        bl = (rel_min >= 128) ? lut[256] : lut[0];
      }
      if (!uni) {
        if (MODE == 0) {
#pragma unroll
          for (int kb = 0; kb < 2; ++kb)
#pragma unroll
            for (int i = 0; i < 16; ++i) {
              int rel = kt * 64 + 32 * kb + crow(i, h) - qi;
              rel = rel < -128 ? -128 : (rel > 128 ? 128 : rel);
              st[kb][i] = __builtin_fmaf(st[kb][i], LOG2E, lut[rel + 128]);
            }
        } else if (MODE == 2) {
          const int ri = kt - qr + 7;
#pragma unroll
          for (int kb = 0; kb < 2; ++kb)
#pragma unroll
            for (int i = 0; i < 16; ++i) {
              const int kc = 32 * kb + crow(i, h);
              const bool ok = (kc >= sc) && (kc < sc + 16);
              int ci = kc - qc + 15; ci = ci < 0 ? 0 : (ci > 30 ? 30 : ci);
              const float bb = lut[ri * 31 + ci];
              st[kb][i] = ok ? __builtin_fmaf(st[kb][i], LOG2E, bb) : -INFINITY;
            }
        }
      }
      float mx;
      {
        float m0 = fmaxf(fmaxf(st[0][0], st[0][1]), st[0][2]), m1 = fmaxf(fmaxf(st[1][0], st[1][1]), st[1][2]);
#pragma unroll
        for (int i = 3; i < 15; i += 2) { m0 = fmaxf(fmaxf(m0, st[0][i]), st[0][i + 1]); m1 = fmaxf(fmaxf(m1, st[1][i]), st[1][i + 1]); }
        mx = fmaxf(fmaxf(m0, m1), fmaxf(st[0][15], st[1][15]));
      }
      mx = fmaxf(mx, __shfl_xor(mx, 32));
      const float mt = uni ? __builtin_fmaf(mx, LOG2E, bl) : mx;
      if (__any(mt > m_run)) {
        const float m_new = fmaxf(m_run, mt);
        const float alpha = __builtin_amdgcn_exp2f(m_run - m_new);
        m_run = m_new;
        l_run *= alpha;
#pragma unroll
        for (int db = 0; db < NDB; ++db) o[db] = o[db] * alpha;
      }
      qk_tile(sknext, sn);
      {
        const float mul = uni ? LOG2E : 1.0f, cc = uni ? (bl - m_run) : -m_run;
#pragma unroll
        for (int kb = 0; kb < 2; ++kb) {
          st[kb] = st[kb] * mul + cc;
#pragma unroll
          for (int i = 0; i < 16; ++i) st[kb][i] = __builtin_amdgcn_exp2f(st[kb][i]);
        }
        const f32x16 ssum = st[0] + st[1];
        const float s0 = (ssum[0] + ssum[1]) + (ssum[2] + ssum[3]), s1 = (ssum[4] + ssum[5]) + (ssum[6] + ssum[7]);
        const float s2 = (ssum[8] + ssum[9]) + (ssum[10] + ssum[11]), s3 = (ssum[12] + ssum[13]) + (ssum[14] + ssum[15]);
        l_run += (s0 + s1) + (s2 + s3);
      }
      bf16x8 pf[2][2];
#pragma unroll
      for (int kb = 0; kb < 2; ++kb)
#pragma unroll
        for (int s2 = 0; s2 < 2; ++s2) {
          u32x4 w;
#pragma unroll
          for (int e = 0; e < 4; ++e) w[e] = pk_bf16(st[kb][8 * s2 + 2 * e], st[kb][8 * s2 + 2 * e + 1]);
          pf[kb][s2] = __builtin_bit_cast(bf16x8, w);
        }
#pragma unroll
      for (int db = 0; db < NDB; ++db)
#pragma unroll
        for (int kb = 0; kb < 2; ++kb)
#pragma unroll
          for (int s2 = 0; s2 < 2; ++s2) {
            s16x4 part[2];
#pragma unroll
            for (int hf = 0; hf < 2; ++hf) {
              const int row = 32 * kb + 16 * s2 + 8 * hf + 4 * h + q4;
              const int chunk = 4 * db + 2 * blk + (p4 >> 1);
              int off;
              if (DV == 64) off = row * 128 + ((chunk ^ (((q4 >> 1) & 1) << 2)) << 4) + (p4 & 1) * 8;
              else off = row * 256 + ((chunk ^ (q4 << 2)) << 4) + (p4 & 1) * 8;
              part[hf] = __builtin_bit_cast(s16x4, __builtin_amdgcn_ds_read_tr16_b64_v4i16((LDSAS s16x4*)(sv + off)));
            }
            const bf16x8 vf = __builtin_shufflevector(part[0], part[1], 0, 1, 2, 3, 4, 5, 6, 7);
            o[db] = MFMA32(vf, pf[kb][s2], o[db]);
          }
    }
    st[0] = sn[0]; st[1] = sn[1];
  }
  const float l_tot = l_run + __shfl_xor(l_run, 32);
  const float inv = 1.0f / l_tot;
  const size_t tok = tok0 + qi;
#pragma unroll
  for (int db = 0; db < NDB; ++db)
#pragma unroll
    for (int g4 = 0; g4 < 4; ++g4) {
      const int d = 32 * db + 8 * g4 + 4 * h;
      float v0 = o[db][4 * g4] * inv, v1 = o[db][4 * g4 + 1] * inv, v2 = o[db][4 * g4 + 2] * inv, v3 = o[db][4 * g4 + 3] * inv;
      if (MODE == 0) {
        *(u32x2*)(OA + tok * DM + head * 128 + d) = (u32x2){pk_bf16(v0, v1), pk_bf16(v2, v3)};
      } else {
        const int gcol = (MODE == 1 ? C_BG : C_CG) + head * 64 + d;
        const u32x2 gw = *(const u32x2*)(U + tok * INW + gcol);
        v0 *= siluf_(bflo(gw[0])); v1 *= siluf_(bfhi(gw[0])); v2 *= siluf_(bflo(gw[1])); v3 *= siluf_(bfhi(gw[1]));
        *(u32x2*)(Y + tok * 1536 + (MODE == 1 ? 512 : 1024) + head * 64 + d) = (u32x2){pk_bf16(v0, v1), pk_bf16(v2, v3)};
      }
    }
}

DI void transpose_tile(const float* __restrict__ src, bf16_t* __restrict__ dst, int R, int C, int tr, int tc, char* smem) {
  float* tl = (float*)smem;
  const int tid = opaque_tid();
  const int r0 = tr * 64, c0 = tc * 64;
  __syncthreads();
#pragma unroll
  for (int i = 0; i < 8; ++i) {
    const int r = i * 8 + (tid >> 6), c = tid & 63;
    tl[r * 65 + c] = src[(size_t)(r0 + r) * C + c0 + c];
  }
  __syncthreads();
  const int n = tid >> 3, kb = (tid & 7) * 8;
  unsigned w[4];
#pragma unroll
  for (int e = 0; e < 4; ++e) w[e] = pk_bf16(tl[(kb + 2 * e) * 65 + n], tl[(kb + 2 * e + 1) * 65 + n]);
  *(u32x4*)(dst + (size_t)(c0 + n) * R + r0 + kb) = (u32x4){w[0], w[1], w[2], w[3]};
}

#define XB_TMO      128
#define XB_XCNT(j)  (256  + 64 * (j))
#define XB_XSUB(j)  (1280 + 64 * (j))
#define XB_XGEN(j)  (2304 + 64 * (j))
#define XB_TOP      3328
#define XB_TOPGEN   3392
#define XCD_BAR_WORDS 3456
#define XB_SPIN_CAP (1u << 20)
DI unsigned xb_ld(unsigned* p) { return __hip_atomic_load(p, __ATOMIC_RELAXED, __HIP_MEMORY_SCOPE_AGENT); }
DI unsigned xb_add(unsigned* p, unsigned v) { return __hip_atomic_fetch_add(p, v, __ATOMIC_RELAXED, __HIP_MEMORY_SCOPE_AGENT); }
DI unsigned xb_xcc_id() { return (unsigned)__builtin_amdgcn_s_getreg((3 << 11) | 20) & 0xFu; }
#define XB_SPIN(cond, bar) do { unsigned _sp = 0; while (cond) { __builtin_amdgcn_s_sleep(1); \
    if ((++_sp & 255u) == 0u) { if (xb_ld(&(bar)[XB_TMO])) break; if (_sp > XB_SPIN_CAP) { atomicAdd(&(bar)[XB_TMO], 1u); break; } } } } while (0)
struct XcdBarrier { unsigned* bar; unsigned x; volatile LDSAS unsigned* st; };
DI XcdBarrier xcd_barrier_post(unsigned* bar, volatile LDSAS unsigned* st) {
  XcdBarrier b; b.bar = bar; b.x = xb_xcc_id(); b.st = st;
  if (threadIdx.x == 0) (void)xb_add(&bar[XB_XCNT(b.x)], 1u);
  return b;
}
DI void xcd_barrier_complete(unsigned* bar, unsigned x, unsigned& nloc, unsigned& nx) {
  const unsigned Gn = gridDim.x * gridDim.y * gridDim.z;
  unsigned sum, cnt, mine, sp = 0u;
  for (;;) {
    sum = 0u; cnt = 0u; mine = 0u;
#pragma unroll
    for (unsigned j = 0; j < 16; ++j) { const unsigned c = xb_ld(&bar[XB_XCNT(j)]); sum += c; cnt += (c > 0u) ? 1u : 0u; mine = (j == x) ? c : mine; }
    if (sum == Gn) break;
    __builtin_amdgcn_s_sleep(1);
    if ((++sp & 255u) == 0u) { if (xb_ld(&bar[XB_TMO])) break; if (sp > XB_SPIN_CAP) { atomicAdd(&bar[XB_TMO], 1u); break; } }
  }
  nloc = mine > 0u ? mine : 1u; nx = cnt > 0u ? cnt : 1u;
}
DI void xcd_barrier(const XcdBarrier& b) {
  asm volatile("s_waitcnt vmcnt(0)" ::: "memory");
  __syncthreads();
  if (threadIdx.x == 0) {
    unsigned* bar = b.bar;
    __builtin_amdgcn_s_waitcnt(0);
    unsigned nloc = b.st[0], nx = b.st[1];
    if (nloc == 0u) { xcd_barrier_complete(bar, b.x, nloc, nx); b.st[0] = nloc; b.st[1] = nx; }
    const unsigned old = xb_add(&bar[XB_XSUB(b.x)], 1u);
    const unsigned gen = old / nloc;
    if (old + 1u == (gen + 1u) * nloc) {
      __builtin_amdgcn_fence(__ATOMIC_RELEASE, "agent");
      asm volatile("s_waitcnt vmcnt(0)" ::: "memory");
      const unsigned og = xb_add(&bar[XB_TOP], 1u);
      const unsigned tg = og / nx;
      if (og + 1u == (tg + 1u) * nx) xb_add(&bar[XB_TOPGEN], 1u);
      else XB_SPIN(xb_ld(&bar[XB_TOPGEN]) == tg, bar);
      __builtin_amdgcn_fence(__ATOMIC_ACQUIRE, "agent");
      xb_add(&bar[XB_XGEN(b.x)], 1u);
      asm volatile("s_waitcnt vmcnt(0)" ::: "memory");
    } else {
      XB_SPIN(xb_ld(&bar[XB_XGEN(b.x)]) == gen, bar);
      __builtin_amdgcn_fence(__ATOMIC_ACQUIRE, "agent");
      asm volatile("s_waitcnt vmcnt(0)" ::: "memory");
    }
  }
  __syncthreads();
}

constexpr int LDS_BYTES = 131072 + 16;
__global__ void __launch_bounds__(512, 2) fwd_kernel(Params p) {
  extern __shared__ __attribute__((aligned(16))) char smem[];
  cg::grid_group grid = cg::this_grid();
  const int nb = gridDim.x, bid = blockIdx.x;
  volatile LDSAS unsigned* xb_st = (volatile LDSAS unsigned*)(smem + 131072);
  if (threadIdx.x == 0) { xb_st[0] = 0u; xb_st[1] = 0u; xb_st[2] = 0u; xb_st[3] = 0u; }
  __syncthreads();
  const XcdBarrier xb = xcd_barrier_post((unsigned*)(p.ws + WS_BAR), xb_st);
#define GSYNC() xcd_barrier(xb)
  const int vb = (bid & 7) * (nb >> 3) + (bid >> 3);
  const int nw = nb * 8;
#define PHASE_IDS const int tid = opaque_tid(), lane = tid & 63, wave = tid >> 6, gw = vb * 8 + wave; (void)lane; (void)gw;
  unsigned char* ws = p.ws;
  bf16_t* WIN = (bf16_t*)(ws + WS_WIN);
  bf16_t* WBR = (bf16_t*)(ws + WS_WBR);
  bf16_t* WOUT = (bf16_t*)(ws + WS_WOUT);
  bf16_t* WPG = (bf16_t*)(ws + WS_WPG);
  bf16_t* WPE = (bf16_t*)(ws + WS_WPE);
  float* ROPE = (float*)(ws + WS_ROPE);
  bf16_t* U = (bf16_t*)(ws + WS_U);
  bf16_t* H = (bf16_t*)(ws + WS_H);
  bf16_t* OA = (bf16_t*)(ws + WS_OA);
  bf16_t* Y = (bf16_t*)(ws + WS_Y);
  bf16_t* M = (bf16_t*)(ws + WS_M);
  float* Z = (float*)(ws + WS_Z);
  bf16_t* GP = (bf16_t*)(ws + WS_GP);

  {
        PHASE_IDS
    for (int t = bid; t < 4 * 3072; t += nb) {
      const int layer = t / 3072;
      int r = t - layer * 3072;
      if (r < 2112) {
        transpose_tile(p.in[6] + (size_t)layer * DM * INW, WIN + (size_t)layer * INW * DM, DM, INW, r / 132, r % 132, smem);
      } else if (r < 2112 + 384) {
        r -= 2112;
        const int j = r / 128; r -= j * 128;
        transpose_tile(p.in[12 + j] + (size_t)layer * 512 * DM, WBR + ((size_t)layer * 3 + j) * DM * 512, 512, DM, r / 16, r % 16, smem);
      } else if (r < 2112 + 384 + 256) {
        r -= 2112 + 384;
        transpose_tile(p.in[15] + (size_t)layer * DM * DM, WOUT + (size_t)layer * DM * DM, DM, DM, r / 16, r % 16, smem);
      } else if (r < 2112 + 384 + 512) {
        r -= 2112 + 384 + 256;
        transpose_tile(p.in[18] + (size_t)layer * DM * DM, WPG + (size_t)layer * DM * DM, DM, DM, r / 16, r % 16, smem);
      } else {
        r -= 2112 + 384 + 512;
        transpose_tile(p.in[17] + (size_t)layer * DPLE * DM, WPE + (size_t)layer * DM * DPLE, DPLE, DM, r / 16, r % 16, smem);
      }
    }
    if (bid < 2) {
      const int i = bid * 512 + tid;
      const int pos = i >> 4, f = i & 15;
      const float inv = powf(10000.0f, -(float)f / 16.0f);
      const float ang = (float)pos * inv;
      ROPE[i] = cosf(ang);
      ROPE[1024 + i] = sinf(ang);
    }
  }
  grid.sync();

  for (int gi = 0; gi < NG; ++gi) {
    const int seq0 = gi * G;
    const bool is_prompt = seq0 < 16;
    const float* xin = is_prompt ? p.in[0] + (size_t)seq0 * SEQ * DM : p.in[1] + (size_t)(seq0 - 16) * SEQ * DM;
    float* xout = p.out + (size_t)seq0 * SEQ * DM;
    for (int layer = 0; layer < NL; ++layer) {
      const float* xres = (layer == 0) ? xin : (const float*)xout;
      const float* pin = is_prompt ? p.in[2] + ((size_t)layer * 16 + seq0) * SEQ * DPLE : p.in[3] + ((size_t)layer * 8 + (seq0 - 16)) * SEQ * DPLE;
      const bf16_t* win = WIN + (size_t)layer * INW * DM;
      const bf16_t* wbr = WBR + (size_t)layer * 3 * DM * 512;
      const bf16_t* wout = WOUT + (size_t)layer * DM * DM;
      const bf16_t* wpg = WPG + (size_t)layer * DM * DM;
      const bf16_t* wpe = WPE + (size_t)layer * DM * DPLE;

      {
        PHASE_IDS
        const float* g = p.in[5] + layer * DM;
        f32x4 gv[4];
#pragma unroll
        for (int j = 0; j < 4; ++j) gv[j] = *(const f32x4*)(g + 4 * (lane + 64 * j));
        for (int row0 = gw; row0 < TG; row0 += 4 * nw) {
          f32x4 v[4][4];
#pragma unroll
          for (int r = 0; r < 4; ++r) {
            const int row = min(row0 + r * nw, TG - 1);
#pragma unroll
            for (int j = 0; j < 4; ++j) v[r][j] = *(const f32x4*)(xres + (size_t)row * DM + 4 * (lane + 64 * j));
          }
#pragma unroll
          for (int r = 0; r < 4; ++r) {
            const int row = row0 + r * nw;
            float ss = 0.f;
#pragma unroll
            for (int j = 0; j < 4; ++j) ss += v[r][j][0] * v[r][j][0] + v[r][j][1] * v[r][j][1] + v[r][j][2] * v[r][j][2] + v[r][j][3] * v[r][j][3];
            ss = wave_sum(ss);
            const float rstd = rsqrtf(ss * (1.0f / DM) + EPS);
            if (row < TG) {
#pragma unroll
              for (int j = 0; j < 4; ++j)
                *(u32x2*)(H + (size_t)row * DM + 4 * (lane + 64 * j)) =
                    (u32x2){pk_bf16(v[r][j][0] * rstd * gv[j][0], v[r][j][1] * rstd * gv[j][1]), pk_bf16(v[r][j][2] * rstd * gv[j][2], v[r][j][3] * rstd * gv[j][3])};
            }
          }
        }
      }
      GSYNC();
      for (int t = vb; t < (TG / 256) * (INW / 256); t += nb) {
        PHASE_IDS
        int mt, nt; tile_decode(t, INW / 256, mt, nt);
        f32x16 acc[4][2]; zero_acc<2>(acc);
        gemm_acc<2, false>(acc, H + (size_t)mt * 256 * DM, DM, win + (size_t)nt * 256 * DM, DM, DM, smem);
        __syncthreads();
        if (nt >= 21) {
          bf16_t* gb = GP + ((size_t)((mt * 12 + (nt - 21)) * 8 + wave) * 16) * 512 + lane * 8;
#pragma unroll
          for (int k = 0; k < 16; ++k) {
            const f32x16& a = acc[k >> 2][(k >> 1) & 1];
            const int b8 = 8 * (k & 1);
            *(u32x4*)(gb + k * 512) = (u32x4){pk_bf16(a[b8], a[b8 + 1]), pk_bf16(a[b8 + 2], a[b8 + 3]), pk_bf16(a[b8 + 4], a[b8 + 5]), pk_bf16(a[b8 + 6], a[b8 + 7])};
          }
        } else {
          char* wl = smem + wave * 16384;
          stage_tile_bf16(acc, wl, lane);
          const bool rope = (nt == 8) || (nt == 9) || (nt == 10 && (wave & 3) < 2);
          const int ch = lane & 7;
          float gg[8];
          {
            const float* gsrc = (nt == 10 ? p.in[10] : p.in[9]) + layer * 64 + ch * 8;
#pragma unroll
            for (int e = 0; e < 8; ++e) gg[e] = rope ? gsrc[e] : 0.f;
          }
          const int rowb = mt * 256 + 128 * (wave >> 2);
          bf16_t* ub = U + (size_t)rowb * INW + nt * 256 + 64 * (wave & 3) + ch * 8;
#pragma unroll 4
          for (int it = 0; it < 16; ++it) {
            const int row = it * 8 + (lane >> 3);
            u32x4 v = *(const u32x4*)(wl + row * 128 + ch * 16);
            if (rope) {
              float x[8];
#pragma unroll
              for (int e = 0; e < 4; ++e) { x[2 * e] = bflo(v[e]); x[2 * e + 1] = bfhi(v[e]); }
              float ss = 0.f;
#pragma unroll
              for (int e = 0; e < 8; ++e) ss += x[e] * x[e];
              ss += __shfl_xor(ss, 1); ss += __shfl_xor(ss, 2); ss += __shfl_xor(ss, 4);
              const float rs = rsqrtf(ss * (1.0f / 64.0f) + EPS);
              const int tt = (rowb + row) & (SEQ - 1);
              const int pos = (ch >> 2) ? (tt & 63) : (tt >> 6);
              const float* ct = ROPE + pos * 16 + 8 * (ch & 1);
              const f32x4 c0 = *(const f32x4*)ct, c1 = *(const f32x4*)(ct + 4), s0 = *(const f32x4*)(ct + 1024), s1 = *(const f32x4*)(ct + 1028);
              const float sgn = ((ch >> 1) & 1) ? 1.0f : -1.0f;
              float o8[8];
#pragma unroll
              for (int e = 0; e < 8; ++e) {
                const float y = x[e] * rs * gg[e];
                const float pt = __shfl_xor(y, 2);
                const float cc = e < 4 ? c0[e & 3] : c1[e & 3], sn = e < 4 ? s0[e & 3] : s1[e & 3];
                o8[e] = y * cc + sgn * pt * sn;
              }
              v = (u32x4){pk_bf16(o8[0], o8[1]), pk_bf16(o8[2], o8[3]), pk_bf16(o8[4], o8[5]), pk_bf16(o8[6], o8[7])};
            }
            *(u32x4*)(ub + (size_t)row * INW) = v;
          }
        }
      }
      GSYNC();
      {
        PHASE_IDS
        const float* rpb = p.in[11] + (size_t)layer * 8 * 465;
        const int nu = G * 8 * 16;
        int t = vb;
        for (; t < nu; t += nb) attn_unit<0>(U, OA, Y, t >> 7, (t >> 4) & 7, t & 15, p.in[4], rpb, smem);
        for (; t < 2 * nu; t += nb) { const int r = t - nu; attn_unit<1>(U, OA, Y, r >> 7, (r >> 4) & 7, r & 15, p.in[4], rpb, smem); }
        for (; t < 3 * nu; t += nb) { const int r = t - 2 * nu; attn_unit<2>(U, OA, Y, r >> 7, (r >> 4) & 7, r & 15, p.in[4], rpb, smem); }
      }
      GSYNC();
      {
        PHASE_IDS
        const float* lp = p.in[7] + layer * 256;
        const float li = p.lambda_init[layer];
        const float s1 = wave_sum(lp[lane] * lp[64 + lane]), s2 = wave_sum(lp[128 + lane] * lp[192 + lane]);
        const float lam = __expf(s1) - __expf(s2) + li;
        const float* sg = p.in[8] + layer * 128 + (lane & 15) * 8;
        float sgv[8];
#pragma unroll
        for (int e = 0; e < 8; ++e) sgv[e] = sg[e] * (1.0f - li);
        const int hh = lane >> 4, dd = (lane & 15) * 8;
        for (int row0 = gw; row0 < TG; row0 += 4 * nw) {
          u32x4 a0[4], a1[4], gt[4];
#pragma unroll
          for (int r = 0; r < 4; ++r) {
            const int row = min(row0 + r * nw, TG - 1);
            a0[r] = *(const u32x4*)(OA + (size_t)row * DM + hh * 256 + dd);
            a1[r] = *(const u32x4*)(OA + (size_t)row * DM + hh * 256 + 128 + dd);
            gt[r] = *(const u32x4*)(U + (size_t)row * INW + C_AG + lane * 8);
          }
#pragma unroll
          for (int r = 0; r < 4; ++r) {
            const int row = row0 + r * nw;
            float dv[8];
            float ss = 0.f;
#pragma unroll
            for (int e = 0; e < 4; ++e) {
              dv[2 * e] = bflo(a0[r][e]) - lam * bflo(a1[r][e]);
              dv[2 * e + 1] = bfhi(a0[r][e]) - lam * bfhi(a1[r][e]);
              ss += dv[2 * e] * dv[2 * e] + dv[2 * e + 1] * dv[2 * e + 1];
            }
            ss += __shfl_xor(ss, 1); ss += __shfl_xor(ss, 2); ss += __shfl_xor(ss, 4); ss += __shfl_xor(ss, 8);
            const float rstd = rsqrtf(ss * (1.0f / 128.0f) + EPS);
            u32x4 ow;
#pragma unroll
            for (int e = 0; e < 4; ++e)
              ow[e] = pk_bf16(dv[2 * e] * rstd * sgv[2 * e] * siluf_(bflo(gt[r][e])), dv[2 * e + 1] * rstd * sgv[2 * e + 1] * siluf_(bfhi(gt[r][e])));
            if (row < TG) *(u32x4*)(Y + (size_t)row * 1536 + lane * 8) = ow;
          }
        }
      }
      GSYNC();
      for (int t = vb; t < (TG / 256) * 4; t += nb) {
        PHASE_IDS
        int mt, nt; tile_decode(t, 4, mt, nt);
        f32x16 acc[4][2]; zero_acc<2>(acc);
        for (int j = 0; j < 3; ++j) {
          gemm_acc<2, false>(acc, Y + (size_t)mt * 256 * 1536 + 512 * j, 1536, wbr + ((size_t)j * DM + nt * 256) * 512, 512, 512, smem);
          const float fl = (j < 2) ? 1.0f : 0.0f;
          const bf16_t *ga_, *gb_;
          { const int tid = opaque_tid(), lane = tid & 63, wave = tid >> 6;
            ga_ = GP + ((size_t)((mt * 12 + 4 * j + nt) * 8 + wave) * 16) * 512 + lane * 8;
            gb_ = (j < 2) ? ga_ + (size_t)4 * 8 * 16 * 512 : ga_; }
#pragma unroll
          for (int k = 0; k < 16; ++k) {
            const u32x4 wa = *(const u32x4*)(ga_ + k * 512), wb = *(const u32x4*)(gb_ + k * 512);
            f32x16& a = acc[k >> 2][(k >> 1) & 1];
            const int b8 = 8 * (k & 1);
#pragma unroll
            for (int q = 0; q < 8; ++q) {
              const float av = (q & 1) ? bfhi(wa[q >> 1]) : bflo(wa[q >> 1]), bv = (q & 1) ? bfhi(wb[q >> 1]) : bflo(wb[q >> 1]);
              const float ea = __expf(-av), eb = __expf(-bv) * fl;
              a[b8 + q] *= (1.0f + eb) * __builtin_amdgcn_rcpf(1.0f + ea);
            }
            if ((k & 3) == 3) asm volatile("" : "+v"(acc[k >> 2][0]), "+v"(acc[k >> 2][1]) : : "memory");
          }
        }
        __syncthreads();
        {
          char* wl = smem + wave * 16384;
          stage_tile_bf16(acc, wl, lane);
          const int ch = lane & 7;
          bf16_t* mb = M + (size_t)(mt * 256 + 128 * (wave >> 2)) * DM + nt * 256 + 64 * (wave & 3) + ch * 8;
#pragma unroll 4
          for (int it = 0; it < 16; ++it) {
            const int row = it * 8 + (lane >> 3);
            *(u32x4*)(mb + (size_t)row * DM) = *(const u32x4*)(wl + row * 128 + ch * 16);
          }
        }
      }
      GSYNC();
      for (int t = vb; t < (TG / 256) * 4; t += nb) {
        PHASE_IDS
        int mt, nt; tile_decode(t, 4, mt, nt);
        f32x16 acc[4][2]; zero_acc<2>(acc);
        gemm_acc<2, false>(acc, M + (size_t)mt * 256 * DM, DM, wout + (size_t)nt * 256 * DM, DM, DM, smem);
        const unsigned o0 = EPI_OFF0(mt, nt, 2, DM);
        EPI_LOOP(2) { Z[EPI_OFF(o0, DM)] = acc[mi][ni][i]; }
      }
      GSYNC();
      {
        PHASE_IDS
        const float* g = p.in[16] + layer * DM;
        f32x4 gv[4];
#pragma unroll
        for (int j = 0; j < 4; ++j) gv[j] = *(const f32x4*)(g + 4 * (lane + 64 * j));
        for (int row0 = gw; row0 < TG; row0 += 2 * nw) {
          f32x4 v[2][4], xv[2][4];
#pragma unroll
          for (int r = 0; r < 2; ++r) {
            const int row = min(row0 + r * nw, TG - 1);
#pragma unroll
            for (int j = 0; j < 4; ++j) {
              v[r][j] = *(const f32x4*)(Z + (size_t)row * DM + 4 * (lane + 64 * j));
              xv[r][j] = *(const f32x4*)(xres + (size_t)row * DM + 4 * (lane + 64 * j));
            }
          }
#pragma unroll
          for (int r = 0; r < 2; ++r) {
            const int row = row0 + r * nw;
            float ss = 0.f;
#pragma unroll
            for (int j = 0; j < 4; ++j) ss += v[r][j][0] * v[r][j][0] + v[r][j][1] * v[r][j][1] + v[r][j][2] * v[r][j][2] + v[r][j][3] * v[r][j][3];
            ss = wave_sum(ss);
            const float rstd = rsqrtf(ss * (1.0f / DM) + EPS);
            if (row < TG) {
#pragma unroll
              for (int j = 0; j < 4; ++j) {
                const int c = 4 * (lane + 64 * j);
                f32x4 o;
#pragma unroll
                for (int e = 0; e < 4; ++e) o[e] = xv[r][j][e] + v[r][j][e] * rstd * gv[j][e];
                *(f32x4*)(xout + (size_t)row * DM + c) = o;
                *(u32x2*)(H + (size_t)row * DM + c) = (u32x2){pk_bf16(o[0], o[1]), pk_bf16(o[2], o[3])};
              }
            }
          }
        }
      }
      GSYNC();
      for (int t = vb; t < (TG / 256) * 8; t += nb) {
        PHASE_IDS
        int mt, nt; tile_decode(t, 8, mt, nt);
        unsigned pe[4][8];
        {
          f32x16 acc2[4][1]; zero_acc<1>(acc2);
          gemm_acc<1, true>(acc2, pin + (size_t)mt * 256 * DPLE, DPLE, wpe + (size_t)nt * 128 * DPLE, DPLE, DPLE, smem);
#pragma unroll
          for (int mi = 0; mi < 4; ++mi)
#pragma unroll
            for (int e = 0; e < 8; ++e) pe[mi][e] = pk_bf16(acc2[mi][0][2 * e], acc2[mi][0][2 * e + 1]);
        }
        f32x16 acc[4][1]; zero_acc<1>(acc);
        gemm_acc<1, false>(acc, H + (size_t)mt * 256 * DM, DM, wpg + (size_t)nt * 128 * DM, DM, DM, smem);
        const unsigned o0 = EPI_OFF0(mt, nt, 1, DM);
        EPI_LOOP(1) {
          float* xp = xout + EPI_OFF(o0, DM);
          const float pv = (i & 1) ? bfhi(pe[mi][i >> 1]) : bflo(pe[mi][i >> 1]);
          *xp = *xp + sigmoidf_(acc[mi][ni][i]) * pv;
        }
      }
      GSYNC();
    }
  }
}

extern "C" void kernel_launch(void* const* d_in, const int* in_sizes, int n_in, void* d_out, int out_size, void* d_ws, size_t ws_size, hipStream_t stream) {
  static int grid_blocks = 0;
  if (!grid_blocks) {
    int dev = 0, cus = 0, per_cu = 0;
    (void)hipGetDevice(&dev);
    (void)hipDeviceGetAttribute(&cus, hipDeviceAttributeMultiprocessorCount, dev);
    (void)hipFuncSetAttribute((const void*)fwd_kernel, hipFuncAttributeMaxDynamicSharedMemorySize, LDS_BYTES);
    (void)hipOccupancyMaxActiveBlocksPerMultiprocessor(&per_cu, fwd_kernel, 512, LDS_BYTES);
    if (per_cu < 1) per_cu = 1;
    if (per_cu > 1) per_cu = 1;
    grid_blocks = cus * per_cu;
    grid_blocks -= grid_blocks % 8;
    if (ws_size < WS_END) fprintf(stderr, "kernel_launch: workspace too small: %zu < %zu\n", ws_size, (size_t)WS_END);
  }
  Params p{};
  for (int i = 0; i < 19; ++i) p.in[i] = (const float*)d_in[i];
  p.out = (float*)d_out;
  p.ws = (unsigned char*)d_ws;
  const float li[4] = {0.2f, 0.35550906759096926f, 0.47071301834358413f, 0.5560582041556852f};
  for (int i = 0; i < 4; ++i) p.lambda_init[i] = li[i];
  (void)hipMemsetAsync((char*)d_ws + WS_BAR, 0, 16384, stream);
  void* args[] = {&p};
  hipError_t e = hipLaunchCooperativeKernel((void*)fwd_kernel, dim3(grid_blocks), dim3(512), args, LDS_BYTES, stream);
  if (e != hipSuccess) fprintf(stderr, "cooperative launch failed: %s (grid %d)\n", hipGetErrorString(e), grid_blocks);
}
```

```cpp
#include <hip/hip_runtime.h>
#include <hip/hip_cooperative_groups.h>
#include <stdint.h>
#include <stdio.h>
namespace cg = cooperative_groups;

typedef unsigned short bf16_t;
typedef short bf16x8 __attribute__((ext_vector_type(8)));
typedef short s16x4 __attribute__((ext_vector_type(4)));
typedef float f32x16 __attribute__((ext_vector_type(16)));
typedef float f32x4 __attribute__((ext_vector_type(4)));
typedef float f32x2 __attribute__((ext_vector_type(2)));
typedef __bf16 bf16x2_t __attribute__((ext_vector_type(2)));
typedef unsigned u32x4 __attribute__((ext_vector_type(4)));
typedef unsigned u32x2 __attribute__((ext_vector_type(2)));
#define DI __device__ __forceinline__
#define LDSAS __attribute__((address_space(3)))

constexpr int DM = 1024, SEQ = 4096, NL = 4, INW = 8448, DPLE = 256;
constexpr int UP = 5376;
constexpr int G = 8;
constexpr int NG = 24 / G;
constexpr int TG = G * SEQ;
constexpr float EPS = 1e-6f;
constexpr float LOG2E = 1.4426950408889634f;
constexpr int C_AQ = 0, C_AK = 512, C_AV = 1024, C_AG = 1536, C_BQ = 2048, C_BK = 2560, C_BV = 2688, C_BG = 2816,
              C_CQ = 3328, C_CK = 3840, C_CV = 4352, C_CG = 4864, C_MG = 5376;
constexpr size_t WS_BAR = 0;
constexpr size_t WS_ROPE = 16384;
constexpr size_t WS_WIN = 32768;
constexpr size_t WS_WBR = WS_WIN + (size_t)NL * INW * DM * 2;
constexpr size_t WS_WOUT = WS_WBR + (size_t)NL * 3 * DM * 512 * 2;
constexpr size_t WS_WPG = WS_WOUT + (size_t)NL * DM * DM * 2;
constexpr size_t WS_WPE = WS_WPG + (size_t)NL * DM * DM * 2;
constexpr size_t WS_U = WS_WPE + (size_t)NL * DM * DPLE * 2;
constexpr size_t WS_H = WS_U + (size_t)TG * UP * 2;
constexpr size_t WS_OA = WS_H + (size_t)TG * DM * 2;
constexpr size_t WS_Y = WS_OA + (size_t)TG * DM * 2;
constexpr size_t WS_M = WS_OA;
constexpr size_t WS_Z = WS_Y;
constexpr size_t WS_GP = WS_Y + (size_t)TG * 1536 * 2;
constexpr size_t WS_END = WS_GP + (size_t)TG * 3072 * 2;

struct Params {
  const float* in[19];
  float* out;
  unsigned char* ws;
  float lambda_init[4];
};

DI unsigned pk_bf16(float lo, float hi) { f32x2 v = {lo, hi}; bf16x2_t b = __builtin_convertvector(v, bf16x2_t); return __builtin_bit_cast(unsigned, b); }
DI float bf2f(unsigned short b) { return __uint_as_float(((unsigned)b) << 16); }
DI float bflo(unsigned w) { return __uint_as_float(w << 16); }
DI float bfhi(unsigned w) { return __uint_as_float(w & 0xffff0000u); }
DI unsigned short f2bf(float f) { return (unsigned short)(pk_bf16(f, 0.f) & 0xffffu); }
DI float wave_sum(float v) {
#pragma unroll
  for (int o = 32; o >= 1; o >>= 1) v += __shfl_xor(v, o);
  return v;
}
DI float sigmoidf_(float x) { return 1.0f / (1.0f + __expf(-x)); }
DI float siluf_(float x) { return x / (1.0f + __expf(-x)); }
DI int opaque_tid() { int t = threadIdx.x; asm volatile("" : "+v"(t)); return t; }
DI int crow(int i, int h) { return (i & 3) + 8 * (i >> 2) + 4 * h; }
#define MFMA32(a, b, c) __builtin_amdgcn_mfma_f32_32x32x16_bf16((a), (b), (c), 0, 0, 0)

DI void dma16(const void* gsrc, char* lds_wave_base) {
  __builtin_amdgcn_global_load_lds((const unsigned*)gsrc, (LDSAS unsigned*)lds_wave_base, 16, 0, 0);
}
DI void dma_sync() { asm volatile("s_waitcnt vmcnt(0)" ::: "memory"); __syncthreads(); }
template <int NI, bool A_F32>
DI void gemm_acc(f32x16 (&acc)[4][NI], const void* Aptr, int lda, const bf16_t* Wt, int ldw, int K, char* smem) {
  constexpr int A_BYTES = 32768, STG = A_BYTES + 16384 * NI;
  const int tid = opaque_tid(), lane = tid & 63, wave = __builtin_amdgcn_readfirstlane(tid >> 6), wr = wave >> 2, wc = wave & 3, r32 = lane & 31, h = lane >> 5;
  const int drow = wave * 8 + (lane >> 3);
  const int dch = (lane & 7) ^ ((drow >> 1) & 7);
  const bf16_t* wsrc = Wt + (size_t)drow * ldw + dch * 8;
  const bf16_t* asrc = (const bf16_t*)Aptr + (size_t)drow * lda + dch * 8;
  const int lrow = tid >> 3, lch = tid & 7;
  u32x4 ra[4];
  auto gloadA = [&](int k0) {
#pragma unroll
    for (int j = 0; j < 4; ++j) {
      const float* pa = (const float*)Aptr + (size_t)(lrow + 64 * j) * lda + k0 + lch * 8;
      const f32x4 v0 = *(const f32x4*)pa, v1 = *(const f32x4*)(pa + 4);
      ra[j] = (u32x4){pk_bf16(v0[0], v0[1]), pk_bf16(v0[2], v0[3]), pk_bf16(v1[0], v1[1]), pk_bf16(v1[2], v1[3])};
    }
  };
  auto lstoreA = [&](int buf) {
    char* sa = smem + buf * STG;
#pragma unroll
    for (int j = 0; j < 4; ++j) {
      const int row = lrow + 64 * j;
      *(u32x4*)(sa + row * 128 + ((lch ^ ((row >> 1) & 7)) << 4)) = ra[j];
    }
  };
  auto issue = [&](int kt, int buf) {
    char* sa = smem + buf * STG + wave * 1024;
    char* sb = sa + A_BYTES;
    if (!A_F32) {
#pragma unroll
      for (int j = 0; j < 4; ++j) dma16(asrc + (size_t)(64 * j) * lda + kt * 64, sa + j * 8192);
    }
#pragma unroll
    for (int j = 0; j < 2 * NI; ++j) dma16(wsrc + (size_t)(64 * j) * ldw + kt * 64, sb + j * 8192);
  };
  const int nk = K >> 6;
  const int xsw = (r32 >> 1) & 7;
  const int a_base = (128 * wr + r32) * 128, b_base = A_BYTES + (32 * NI * wc + r32) * 128;
  __syncthreads();
  if (A_F32) { gloadA(0); lstoreA(0); }
  issue(0, 0);
  for (int kt = 0; kt < nk; ++kt) {
    dma_sync();
    if (kt + 1 < nk) { issue(kt + 1, (kt + 1) & 1); if (A_F32) gloadA((kt + 1) << 6); }
    const char* st = smem + (kt & 1) * STG;
#pragma unroll
    for (int s = 0; s < 4; ++s) {
      const int sw = ((2 * s + h) ^ xsw) << 4;
      bf16x8 af[4], bfr[NI];
#pragma unroll
      for (int mi = 0; mi < 4; ++mi) af[mi] = *(const bf16x8*)(st + a_base + sw + mi * 4096);
#pragma unroll
      for (int ni = 0; ni < NI; ++ni) bfr[ni] = *(const bf16x8*)(st + b_base + sw + ni * 4096);
#pragma unroll
      for (int mi = 0; mi < 4; ++mi)
#pragma unroll
        for (int ni = 0; ni < NI; ++ni) acc[mi][ni] = MFMA32(af[mi], bfr[ni], acc[mi][ni]);
    }
    if (A_F32) { if (kt + 1 < nk) lstoreA((kt + 1) & 1); }
  }
}
template <int NI>
DI void zero_acc(f32x16 (&acc)[4][NI]) {
#pragma unroll
  for (int a = 0; a < 4; ++a)
#pragma unroll
    for (int b = 0; b < NI; ++b)
#pragma unroll
      for (int i = 0; i < 16; ++i) acc[a][b][i] = 0.f;
}
#define EPI_LOOP(NI_) _Pragma("unroll") for (int mi = 0; mi < 4; ++mi) _Pragma("unroll") for (int ni = 0; ni < NI_; ++ni) _Pragma("unroll") for (int i = 0; i < 16; ++i)
#define EPI_OFF0(mt, nt, NI_, ld) ((unsigned)((mt) * 256 + 128 * (wave >> 2) + 4 * (lane >> 5)) * (unsigned)(ld) + (unsigned)((nt) * 128 * NI_ + 32 * NI_ * (wave & 3) + (lane & 31)))
#define EPI_OFF(off0, ld) ((off0) + (unsigned)((32 * mi + (i & 3) + 8 * (i >> 2)) * (ld) + 32 * ni))
#define EPI_FENCE
DI void stage_tile_bf16(const f32x16 (&acc)[4][2], char* wl, int lane) {
  const int r32 = lane & 31, h = lane >> 5;
#pragma unroll
  for (int mi = 0; mi < 4; ++mi)
#pragma unroll
    for (int ni = 0; ni < 2; ++ni)
#pragma unroll
      for (int i = 0; i < 16; ++i) *(bf16_t*)(wl + (32 * mi + crow(i, h)) * 128 + (32 * ni + r32) * 2) = f2bf(acc[mi][ni][i]);
}
DI void tile_decode(int t, int ntn, int& mt, int& nt) {
  const int band = t / (8 * ntn), w = t - band * 8 * ntn;
  nt = w >> 3;
  mt = band * 8 + (w & 7);
}

template <int MODE>
DI void attn_unit(const bf16_t* __restrict__ U, bf16_t* __restrict__ OA, bf16_t* __restrict__ Y, int seq_l, int head, int qb,
                  const float* __restrict__ t5, const float* __restrict__ rpb, char* smem) {
  constexpr int DV = (MODE == 0) ? 128 : 64;
  constexpr int NDB = DV / 32;
  constexpr int NKB = (MODE == 2) ? 2 : 4;
  constexpr int KT = 32 * NKB;
  constexpr int KBYTES = KT * 128, VBYTES = KT * DV * 2, STAGE = KBYTES + VBYTES;
  constexpr int NKJ = KBYTES / 8192;
  constexpr int NVJ = VBYTES / 8192;
  float* lut = (float*)(smem + 98304);
  const int tid = opaque_tid(), lane = tid & 63, wave = tid >> 6, r32 = lane & 31, h = lane >> 5;
  const size_t tok0 = (size_t)seq_l * SEQ;
  const int q0 = qb * 256;
  int qcol, kcol, vcol;
  if (MODE == 0) { qcol = C_AQ + head * 64; kcol = C_AK + head * 64; vcol = C_AV + (head >> 1) * 128; }
  else if (MODE == 1) { qcol = C_BQ + head * 64; kcol = C_BK + (head >> 2) * 64; vcol = C_BV + (head >> 2) * 64; }
  else { qcol = C_CQ + head * 64; kcol = C_CK + head * 64; vcol = C_CV + head * 64; }
  int kt0 = 0, NT = SEQ / KT;
  if (MODE == 2) { int b0 = 4 * qb - 4; b0 = b0 < 0 ? 0 : (b0 > 53 ? 53 : b0); kt0 = b0; NT = 11; }

  __syncthreads();
  if (MODE == 0) {
    for (int i = tid; i < 257; i += 512) {
      const int r = i - 128, n = r < 0 ? -r : r;
      int b;
      if (n < 8) b = n;
      else { b = 8 + (n >= 12) + (n >= 16) + (n >= 23) + (n >= 32) + (n >= 46) + (n >= 64) + (n >= 91); }
      if (r > 0) b += 16;
      lut[i] = t5[b * 8 + head] * LOG2E;
    }
  } else if (MODE == 2) {
    for (int i = tid; i < 465; i += 512) lut[i] = rpb[head * 465 + i] * LOG2E;
  }

  const int qi = q0 + wave * 32 + r32;
  bf16x8 qf[4];
  {
    const bf16_t* qp = U + (tok0 + qi) * UP + qcol + 8 * h;
#pragma unroll
    for (int s = 0; s < 4; ++s) {
      const u32x4 raw = *(const u32x4*)(qp + 16 * s);
      u32x4 o;
#pragma unroll
      for (int e = 0; e < 4; ++e) o[e] = pk_bf16(bflo(raw[e]) * 0.125f, bfhi(raw[e]) * 0.125f);
      qf[s] = __builtin_bit_cast(bf16x8, o);
    }
  }

  const int wv = __builtin_amdgcn_readfirstlane(wave);
  int koff[NKJ], voff[NVJ];
#pragma unroll
  for (int j = 0; j < NKJ; ++j) {
    const int row = (wv + 8 * j) * 8 + (lane >> 3), ch = (lane & 7) ^ ((row >> 1) & 7);
    koff[j] = row * UP + kcol + ch * 8;
  }
#pragma unroll
  for (int j = 0; j < NVJ; ++j) {
    if (DV == 64) { const int row = (wv + 8 * j) * 8 + (lane >> 3), ch = (lane & 7) ^ (((row >> 1) & 1) << 2); voff[j] = row * UP + vcol + ch * 8; }
    else { const int row = (wv + 8 * j) * 4 + (lane >> 4), ch = (lane & 15) ^ ((row & 3) << 2); voff[j] = row * UP + vcol + ch * 8; }
  }
  auto issue = [&](int kt, int buf) {
    const bf16_t* base = U + (tok0 + (size_t)kt * KT) * UP;
    char* sk = smem + buf * STAGE + wv * 1024;
#pragma unroll
    for (int j = 0; j < NKJ; ++j) dma16(base + koff[j], sk + j * 8192);
#pragma unroll
    for (int j = 0; j < NVJ; ++j) dma16(base + voff[j], sk + KBYTES + j * 8192);
  };

  f32x16 o[NDB];
#pragma unroll
  for (int db = 0; db < NDB; ++db)
#pragma unroll
    for (int i = 0; i < 16; ++i) o[db][i] = 0.f;
  float m_run = -INFINITY, l_run = 0.f;

  const int q4 = (lane & 15) >> 2, p4 = lane & 3, blk = (lane >> 4) & 1;
  const int qr = 4 * qb + (wave >> 1), qc = (wave & 1) * 32 + r32;
  int sr = qr - 4; sr = sr < 0 ? 0 : (sr > 56 ? 56 : sr);
  int sc = qc - 8; sc = sc < 0 ? 0 : (sc > 48 ? 48 : sc);

  issue(kt0, 0);
  for (int it = 0; it < NT; ++it) {
    const int kt = kt0 + it;
    dma_sync();
    if (it + 1 < NT) issue(kt + 1, (it + 1) & 1);
    const char* sk = smem + (it & 1) * STAGE;
    const char* sv = sk + KBYTES;
    bool active = true;
    if (MODE == 2) active = (kt >= sr) && (kt < sr + 8);
    if (active) {
      f32x16 st[NKB];
#pragma unroll
      for (int kb = 0; kb < NKB; ++kb) {
#pragma unroll
        for (int i = 0; i < 16; ++i) st[kb][i] = 0.f;
        const int row = 32 * kb + r32;
#pragma unroll
        for (int s = 0; s < 4; ++s) {
          const bf16x8 kf = *(const bf16x8*)(sk + row * 128 + (((2 * s + h) ^ ((row >> 1) & 7)) << 4));
          st[kb] = MFMA32(kf, qf[s], st[kb]);
        }
      }
      bool uni = (MODE == 1);
      float bl = 0.f;
      if (MODE == 0) {
        const int rel_min = kt * KT - (q0 + 255), rel_max = kt * KT + (KT - 1) - q0;
        uni = (rel_min >= 128) || (rel_max <= -128);
        bl = (rel_min >= 128) ? lut[256] : lut[0];
      }
      if (!uni) {
        if (MODE == 0) {
#pragma unroll
          for (int kb = 0; kb < NKB; ++kb)
#pragma unroll
            for (int i = 0; i < 16; ++i) {
              int rel = kt * KT + 32 * kb + crow(i, h) - qi;
              rel = rel < -128 ? -128 : (rel > 128 ? 128 : rel);
              st[kb][i] = __builtin_fmaf(st[kb][i], LOG2E, lut[rel + 128]);
            }
        } else if (MODE == 2) {
          const int ri = kt - qr + 7;
#pragma unroll
          for (int kb = 0; kb < NKB; ++kb)
#pragma unroll
            for (int i = 0; i < 16; ++i) {
              const int kc = 32 * kb + crow(i, h);
              const bool ok = (kc >= sc) && (kc < sc + 16);
              int ci = kc - qc + 15; ci = ci < 0 ? 0 : (ci > 30 ? 30 : ci);
              const float bb = lut[ri * 31 + ci];
              st[kb][i] = ok ? __builtin_fmaf(st[kb][i], LOG2E, bb) : -INFINITY;
            }
        }
      }
      float mx;
      {
        float mk[NKB];
#pragma unroll
        for (int kb = 0; kb < NKB; ++kb) {
          float m0 = fmaxf(fmaxf(st[kb][0], st[kb][1]), st[kb][2]);
#pragma unroll
          for (int i = 3; i < 15; i += 2) m0 = fmaxf(fmaxf(m0, st[kb][i]), st[kb][i + 1]);
          mk[kb] = fmaxf(m0, st[kb][15]);
        }
        mx = fmaxf(mk[0], mk[1]);
        if (NKB == 4) mx = fmaxf(fmaxf(mx, mk[NKB - 2]), mk[NKB - 1]);
      }
      mx = fmaxf(mx, __shfl_xor(mx, 32));
      const float mt = uni ? __builtin_fmaf(mx, LOG2E, bl) : mx;
      if (__any(mt > m_run)) {
        const float m_new = fmaxf(m_run, mt);
        const float alpha = __builtin_amdgcn_exp2f(m_run - m_new);
        m_run = m_new;
        l_run *= alpha;
#pragma unroll
        for (int db = 0; db < NDB; ++db) o[db] = o[db] * alpha;
      }
      {
        const float mul = uni ? LOG2E : 1.0f, cc = uni ? (bl - m_run) : -m_run;
        float ps[NKB];
#pragma unroll
        for (int kb = 0; kb < NKB; ++kb) {
#pragma unroll
          for (int i = 0; i < 16; ++i) st[kb][i] = __builtin_amdgcn_exp2f(__builtin_fmaf(st[kb][i], mul, cc));
          const float s0 = (st[kb][0] + st[kb][1]) + (st[kb][2] + st[kb][3]), s1 = (st[kb][4] + st[kb][5]) + (st[kb][6] + st[kb][7]);
          const float s2 = (st[kb][8] + st[kb][9]) + (st[kb][10] + st[kb][11]), s3 = (st[kb][12] + st[kb][13]) + (st[kb][14] + st[kb][15]);
          ps[kb] = (s0 + s1) + (s2 + s3);
        }
        float pt = ps[0] + ps[1];
        if (NKB == 4) pt += ps[NKB - 2] + ps[NKB - 1];
        l_run += pt;
      }
#pragma unroll
      for (int kb = 0; kb < NKB; ++kb)
#pragma unroll
        for (int s2 = 0; s2 < 2; ++s2) {
          u32x4 w;
#pragma unroll
          for (int e = 0; e < 4; ++e) w[e] = pk_bf16(st[kb][8 * s2 + 2 * e], st[kb][8 * s2 + 2 * e + 1]);
          const bf16x8 pf = __builtin_bit_cast(bf16x8, w);
#pragma unroll
          for (int db = 0; db < NDB; ++db) {
            s16x4 part[2];
#pragma unroll
            for (int hf = 0; hf < 2; ++hf) {
              const int row = 32 * kb + 16 * s2 + 8 * hf + 4 * h + q4;
              const int chunk = 4 * db + 2 * blk + (p4 >> 1);
              int off;
              if (DV == 64) off = row * 128 + ((chunk ^ (((q4 >> 1) & 1) << 2)) << 4) + (p4 & 1) * 8;
              else off = row * 256 + ((chunk ^ (q4 << 2)) << 4) + (p4 & 1) * 8;
              part[hf] = __builtin_bit_cast(s16x4, __builtin_amdgcn_ds_read_tr16_b64_v4i16((LDSAS s16x4*)(sv + off)));
            }
            const bf16x8 vf = __builtin_shufflevector(part[0], part[1], 0, 1, 2, 3, 4, 5, 6, 7);
            o[db] = MFMA32(vf, pf, o[db]);
          }
        }
    }
  }
  const float l_tot = l_run + __shfl_xor(l_run, 32);
  const float inv = 1.0f / l_tot;
  const size_t tok = tok0 + qi;
#pragma unroll
  for (int db = 0; db < NDB; ++db)
#pragma unroll
    for (int g4 = 0; g4 < 4; ++g4) {
      const int d = 32 * db + 8 * g4 + 4 * h;
      float v0 = o[db][4 * g4] * inv, v1 = o[db][4 * g4 + 1] * inv, v2 = o[db][4 * g4 + 2] * inv, v3 = o[db][4 * g4 + 3] * inv;
      if (MODE == 0) {
        *(u32x2*)(OA + tok * DM + head * 128 + d) = (u32x2){pk_bf16(v0, v1), pk_bf16(v2, v3)};
      } else {
        const int gcol = (MODE == 1 ? C_BG : C_CG) + head * 64 + d;
        const u32x2 gw = *(const u32x2*)(U + tok * UP + gcol);
        v0 *= siluf_(bflo(gw[0])); v1 *= siluf_(bfhi(gw[0])); v2 *= siluf_(bflo(gw[1])); v3 *= siluf_(bfhi(gw[1]));
        *(u32x2*)(Y + tok * 1536 + (MODE == 1 ? 512 : 1024) + head * 64 + d) = (u32x2){pk_bf16(v0, v1), pk_bf16(v2, v3)};
      }
    }
}

DI void transpose_tile(const float* __restrict__ src, bf16_t* __restrict__ dst, int R, int C, int tr, int tc, char* smem) {
  float* tl = (float*)smem;
  const int tid = opaque_tid();
  const int r0 = tr * 64, c0 = tc * 64;
  __syncthreads();
#pragma unroll
  for (int i = 0; i < 8; ++i) {
    const int r = i * 8 + (tid >> 6), c = tid & 63;
    tl[r * 65 + c] = src[(size_t)(r0 + r) * C + c0 + c];
  }
  __syncthreads();
  const int n = tid >> 3, kb = (tid & 7) * 8;
  unsigned w[4];
#pragma unroll
  for (int e = 0; e < 4; ++e) w[e] = pk_bf16(tl[(kb + 2 * e) * 65 + n], tl[(kb + 2 * e + 1) * 65 + n]);
  *(u32x4*)(dst + (size_t)(c0 + n) * R + r0 + kb) = (u32x4){w[0], w[1], w[2], w[3]};
}

#define XB_TMO      128
#define XB_XCNT(j)  (256  + 64 * (j))
#define XB_XSUB(j)  (1280 + 64 * (j))
#define XB_XGEN(j)  (2304 + 64 * (j))
#define XB_TOP      3328
#define XB_TOPGEN   3392
#define XCD_BAR_WORDS 3456
#define XB_SPIN_CAP (1u << 20)
DI unsigned xb_ld(unsigned* p) { return __hip_atomic_load(p, __ATOMIC_RELAXED, __HIP_MEMORY_SCOPE_AGENT); }
DI unsigned xb_add(unsigned* p, unsigned v) { return __hip_atomic_fetch_add(p, v, __ATOMIC_RELAXED, __HIP_MEMORY_SCOPE_AGENT); }
DI unsigned xb_xcc_id() { return (unsigned)__builtin_amdgcn_s_getreg((3 << 11) | 20) & 0xFu; }
#define XB_SPIN(cond, bar) do { unsigned _sp = 0; while (cond) { __builtin_amdgcn_s_sleep(1); \
    if ((++_sp & 255u) == 0u) { if (xb_ld(&(bar)[XB_TMO])) break; if (_sp > XB_SPIN_CAP) { atomicAdd(&(bar)[XB_TMO], 1u); break; } } } } while (0)
struct XcdBarrier { unsigned* bar; unsigned x; volatile LDSAS unsigned* st; };
DI XcdBarrier xcd_barrier_post(unsigned* bar, volatile LDSAS unsigned* st) {
  XcdBarrier b; b.bar = bar; b.x = xb_xcc_id(); b.st = st;
  if (threadIdx.x == 0) (void)xb_add(&bar[XB_XCNT(b.x)], 1u);
  return b;
}
DI void xcd_barrier_complete(unsigned* bar, unsigned x, unsigned& nloc, unsigned& nx) {
  const unsigned Gn = gridDim.x * gridDim.y * gridDim.z;
  unsigned sum, cnt, mine, sp = 0u;
  for (;;) {
    sum = 0u; cnt = 0u; mine = 0u;
#pragma unroll
    for (unsigned j = 0; j < 16; ++j) { const unsigned c = xb_ld(&bar[XB_XCNT(j)]); sum += c; cnt += (c > 0u) ? 1u : 0u; mine = (j == x) ? c : mine; }
    if (sum == Gn) break;
    __builtin_amdgcn_s_sleep(1);
    if ((++sp & 255u) == 0u) { if (xb_ld(&bar[XB_TMO])) break; if (sp > XB_SPIN_CAP) { atomicAdd(&bar[XB_TMO], 1u); break; } }
  }
  nloc = mine > 0u ? mine : 1u; nx = cnt > 0u ? cnt : 1u;
}
DI void xcd_barrier(const XcdBarrier& b) {
  asm volatile("s_waitcnt vmcnt(0)" ::: "memory");
  __syncthreads();
  if (threadIdx.x == 0) {
    unsigned* bar = b.bar;
    __builtin_amdgcn_s_waitcnt(0);
    unsigned nloc = b.st[0], nx = b.st[1];
    if (nloc == 0u) { xcd_barrier_complete(bar, b.x, nloc, nx); b.st[0] = nloc; b.st[1] = nx; }
    const unsigned old = xb_add(&bar[XB_XSUB(b.x)], 1u);
    const unsigned gen = old / nloc;
    if (old + 1u == (gen + 1u) * nloc) {
      __builtin_amdgcn_fence(__ATOMIC_RELEASE, "agent");
      asm volatile("s_waitcnt vmcnt(0)" ::: "memory");
      const unsigned og = xb_add(&bar[XB_TOP], 1u);
      const unsigned tg = og / nx;
      if (og + 1u == (tg + 1u) * nx) xb_add(&bar[XB_TOPGEN], 1u);
      else XB_SPIN(xb_ld(&bar[XB_TOPGEN]) == tg, bar);
      __builtin_amdgcn_fence(__ATOMIC_ACQUIRE, "agent");
      xb_add(&bar[XB_XGEN(b.x)], 1u);
      asm volatile("s_waitcnt vmcnt(0)" ::: "memory");
    } else {
      XB_SPIN(xb_ld(&bar[XB_XGEN(b.x)]) == gen, bar);
      __builtin_amdgcn_fence(__ATOMIC_ACQUIRE, "agent");
      asm volatile("s_waitcnt vmcnt(0)" ::: "memory");
    }
  }
  __syncthreads();
}

constexpr int LDS_BYTES = 131072 + 16;
__global__ void __launch_bounds__(512, 2) fwd_kernel(Params p) {
  extern __shared__ __attribute__((aligned(16))) char smem[];
  cg::grid_group grid = cg::this_grid();
  const int nb = gridDim.x, bid = blockIdx.x;
  volatile LDSAS unsigned* xb_st = (volatile LDSAS unsigned*)(smem + 131072);
  if (threadIdx.x == 0) { xb_st[0] = 0u; xb_st[1] = 0u; xb_st[2] = 0u; xb_st[3] = 0u; }
  __syncthreads();
  const XcdBarrier xb = xcd_barrier_post((unsigned*)(p.ws + WS_BAR), xb_st);
#define GSYNC() xcd_barrier(xb)
  const int vb = (bid & 7) * (nb >> 3) + (bid >> 3);
  const int nw = nb * 8;
#define PHASE_IDS const int tid = opaque_tid(), lane = tid & 63, wave = tid >> 6, gw = vb * 8 + wave; (void)lane; (void)gw;
  unsigned char* ws = p.ws;
  bf16_t* WIN = (bf16_t*)(ws + WS_WIN);
  bf16_t* WBR = (bf16_t*)(ws + WS_WBR);
  bf16_t* WOUT = (bf16_t*)(ws + WS_WOUT);
  bf16_t* WPG = (bf16_t*)(ws + WS_WPG);
  bf16_t* WPE = (bf16_t*)(ws + WS_WPE);
  float* ROPE = (float*)(ws + WS_ROPE);
  bf16_t* U = (bf16_t*)(ws + WS_U);
  bf16_t* H = (bf16_t*)(ws + WS_H);
  bf16_t* OA = (bf16_t*)(ws + WS_OA);
  bf16_t* Y = (bf16_t*)(ws + WS_Y);
  bf16_t* M = (bf16_t*)(ws + WS_M);
  bf16_t* Zb = (bf16_t*)(ws + WS_Z);
  bf16_t* GP = (bf16_t*)(ws + WS_GP);

  {
        PHASE_IDS
    for (int t = bid; t < 4 * 3072; t += nb) {
      const int layer = t / 3072;
      int r = t - layer * 3072;
      if (r < 2112) {
        transpose_tile(p.in[6] + (size_t)layer * DM * INW, WIN + (size_t)layer * INW * DM, DM, INW, r / 132, r % 132, smem);
      } else if (r < 2112 + 384) {
        r -= 2112;
        const int j = r / 128; r -= j * 128;
        transpose_tile(p.in[12 + j] + (size_t)layer * 512 * DM, WBR + ((size_t)layer * 3 + j) * DM * 512, 512, DM, r / 16, r % 16, smem);
      } else if (r < 2112 + 384 + 256) {
        r -= 2112 + 384;
        transpose_tile(p.in[15] + (size_t)layer * DM * DM, WOUT + (size_t)layer * DM * DM, DM, DM, r / 16, r % 16, smem);
      } else if (r < 2112 + 384 + 512) {
        r -= 2112 + 384 + 256;
        transpose_tile(p.in[18] + (size_t)layer * DM * DM, WPG + (size_t)layer * DM * DM, DM, DM, r / 16, r % 16, smem);
      } else {
        r -= 2112 + 384 + 512;
        transpose_tile(p.in[17] + (size_t)layer * DPLE * DM, WPE + (size_t)layer * DM * DPLE, DPLE, DM, r / 16, r % 16, smem);
      }
    }
    if (bid < 2) {
      const int i = bid * 512 + tid;
      const int pos = i >> 4, f = i & 15;
      const float inv = powf(10000.0f, -(float)f / 16.0f);
      const float ang = (float)pos * inv;
      ROPE[i] = cosf(ang);
      ROPE[1024 + i] = sinf(ang);
    }
  }
  grid.sync();

  for (int gi = 0; gi < NG; ++gi) {
    const int seq0 = gi * G;
    const bool is_prompt = seq0 < 16;
    const float* xin = is_prompt ? p.in[0] + (size_t)seq0 * SEQ * DM : p.in[1] + (size_t)(seq0 - 16) * SEQ * DM;
    float* xout = p.out + (size_t)seq0 * SEQ * DM;
    for (int layer = 0; layer < NL; ++layer) {
      const float* xres = (layer == 0) ? xin : (const float*)xout;
      const float* pin = is_prompt ? p.in[2] + ((size_t)layer * 16 + seq0) * SEQ * DPLE : p.in[3] + ((size_t)layer * 8 + (seq0 - 16)) * SEQ * DPLE;
      const bf16_t* win = WIN + (size_t)layer * INW * DM;
      const bf16_t* wbr = WBR + (size_t)layer * 3 * DM * 512;
      const bf16_t* wout = WOUT + (size_t)layer * DM * DM;
      const bf16_t* wpg = WPG + (size_t)layer * DM * DM;
      const bf16_t* wpe = WPE + (size_t)layer * DM * DPLE;

      {
        PHASE_IDS
        const float* g = p.in[5] + layer * DM;
        f32x4 gv[4];
#pragma unroll
        for (int j = 0; j < 4; ++j) gv[j] = *(const f32x4*)(g + 4 * (lane + 64 * j));
        for (int row0 = gw; row0 < TG; row0 += 4 * nw) {
          f32x4 v[4][4];
#pragma unroll
          for (int r = 0; r < 4; ++r) {
            const int row = min(row0 + r * nw, TG - 1);
#pragma unroll
            for (int j = 0; j < 4; ++j) v[r][j] = *(const f32x4*)(xres + (size_t)row * DM + 4 * (lane + 64 * j));
          }
#pragma unroll
          for (int r = 0; r < 4; ++r) {
            const int row = row0 + r * nw;
            float ss = 0.f;
#pragma unroll
            for (int j = 0; j < 4; ++j) ss += v[r][j][0] * v[r][j][0] + v[r][j][1] * v[r][j][1] + v[r][j][2] * v[r][j][2] + v[r][j][3] * v[r][j][3];
            ss = wave_sum(ss);
            const float rstd = rsqrtf(ss * (1.0f / DM) + EPS);
            if (row < TG) {
#pragma unroll
              for (int j = 0; j < 4; ++j)
                *(u32x2*)(H + (size_t)row * DM + 4 * (lane + 64 * j)) =
                    (u32x2){pk_bf16(v[r][j][0] * rstd * gv[j][0], v[r][j][1] * rstd * gv[j][1]), pk_bf16(v[r][j][2] * rstd * gv[j][2], v[r][j][3] * rstd * gv[j][3])};
            }
          }
        }
      }
      GSYNC();
      for (int t = vb; t < (TG / 256) * (INW / 256); t += nb) {
        PHASE_IDS
        int mt, nt; tile_decode(t, INW / 256, mt, nt);
        f32x16 acc[4][2]; zero_acc<2>(acc);
        gemm_acc<2, false>(acc, H + (size_t)mt * 256 * DM, DM, win + (size_t)nt * 256 * DM, DM, DM, smem);
        __syncthreads();
        if (nt >= 21) {
          bf16_t* gb = GP + ((size_t)((mt * 12 + (nt - 21)) * 8 + wave) * 16) * 512 + lane * 8;
#pragma unroll
          for (int k = 0; k < 16; ++k) {
            const f32x16& a = acc[k >> 2][(k >> 1) & 1];
            const int b8 = 8 * (k & 1);
            *(u32x4*)(gb + k * 512) = (u32x4){pk_bf16(a[b8], a[b8 + 1]), pk_bf16(a[b8 + 2], a[b8 + 3]), pk_bf16(a[b8 + 4], a[b8 + 5]), pk_bf16(a[b8 + 6], a[b8 + 7])};
          }
        } else {
          char* wl = smem + wave * 16384;
          stage_tile_bf16(acc, wl, lane);
          const bool rope = (nt == 8) || (nt == 9) || (nt == 10 && (wave & 3) < 2);
          const int ch = lane & 7;
          float gg[8];
          {
            const float* gsrc = (nt == 10 ? p.in[10] : p.in[9]) + layer * 64 + ch * 8;
#pragma unroll
            for (int e = 0; e < 8; ++e) gg[e] = rope ? gsrc[e] : 0.f;
          }
          const int rowb = mt * 256 + 128 * (wave >> 2);
          bf16_t* ub = U + (size_t)rowb * UP + nt * 256 + 64 * (wave & 3) + ch * 8;
#pragma unroll 4
          for (int it = 0; it < 16; ++it) {
            const int row = it * 8 + (lane >> 3);
            u32x4 v = *(const u32x4*)(wl + row * 128 + ch * 16);
            if (rope) {
              float x[8];
#pragma unroll
              for (int e = 0; e < 4; ++e) { x[2 * e] = bflo(v[e]); x[2 * e + 1] = bfhi(v[e]); }
              float ss = 0.f;
#pragma unroll
              for (int e = 0; e < 8; ++e) ss += x[e] * x[e];
              ss += __shfl_xor(ss, 1); ss += __shfl_xor(ss, 2); ss += __shfl_xor(ss, 4);
              const float rs = rsqrtf(ss * (1.0f / 64.0f) + EPS);
              const int tt = (rowb + row) & (SEQ - 1);
              const int pos = (ch >> 2) ? (tt & 63) : (tt >> 6);
              const float* ct = ROPE + pos * 16 + 8 * (ch & 1);
              const f32x4 c0 = *(const f32x4*)ct, c1 = *(const f32x4*)(ct + 4), s0 = *(const f32x4*)(ct + 1024), s1 = *(const f32x4*)(ct + 1028);
              const float sgn = ((ch >> 1) & 1) ? 1.0f : -1.0f;
              float o8[8];
#pragma unroll
              for (int e = 0; e < 8; ++e) {
                const float y = x[e] * rs * gg[e];
                const float pt = __shfl_xor(y, 2);
                const float cc = e < 4 ? c0[e & 3] : c1[e & 3], sn = e < 4 ? s0[e & 3] : s1[e & 3];
                o8[e] = y * cc + sgn * pt * sn;
              }
              v = (u32x4){pk_bf16(o8[0], o8[1]), pk_bf16(o8[2], o8[3]), pk_bf16(o8[4], o8[5]), pk_bf16(o8[6], o8[7])};
            }
            *(u32x4*)(ub + (size_t)row * UP) = v;
          }
        }
      }
      GSYNC();
      {
        PHASE_IDS
        const float* rpb = p.in[11] + (size_t)layer * 8 * 465;
        const int nu = G * 8 * 16;
        int t = vb;
        for (; t < nu; t += nb) attn_unit<0>(U, OA, Y, t >> 7, (t >> 4) & 7, t & 15, p.in[4], rpb, smem);
        for (; t < 2 * nu; t += nb) { const int r = t - nu; attn_unit<1>(U, OA, Y, r >> 7, (r >> 4) & 7, r & 15, p.in[4], rpb, smem); }
        for (; t < 3 * nu; t += nb) { const int r = t - 2 * nu; attn_unit<2>(U, OA, Y, r >> 7, (r >> 4) & 7, r & 15, p.in[4], rpb, smem); }
      }
      GSYNC();
      {
        PHASE_IDS
        const float* lp = p.in[7] + layer * 256;
        const float li = p.lambda_init[layer];
        const float s1 = wave_sum(lp[lane] * lp[64 + lane]), s2 = wave_sum(lp[128 + lane] * lp[192 + lane]);
        const float lam = __expf(s1) - __expf(s2) + li;
        const float* sg = p.in[8] + layer * 128 + (lane & 15) * 8;
        float sgv[8];
#pragma unroll
        for (int e = 0; e < 8; ++e) sgv[e] = sg[e] * (1.0f - li);
        const int hh = lane >> 4, dd = (lane & 15) * 8;
        for (int row0 = gw; row0 < TG; row0 += 4 * nw) {
          u32x4 a0[4], a1[4], gt[4];
#pragma unroll
          for (int r = 0; r < 4; ++r) {
            const int row = min(row0 + r * nw, TG - 1);
            a0[r] = *(const u32x4*)(OA + (size_t)row * DM + hh * 256 + dd);
            a1[r] = *(const u32x4*)(OA + (size_t)row * DM + hh * 256 + 128 + dd);
            gt[r] = *(const u32x4*)(U + (size_t)row * UP + C_AG + lane * 8);
          }
#pragma unroll
          for (int r = 0; r < 4; ++r) {
            const int row = row0 + r * nw;
            float dv[8];
            float ss = 0.f;
#pragma unroll
            for (int e = 0; e < 4; ++e) {
              dv[2 * e] = bflo(a0[r][e]) - lam * bflo(a1[r][e]);
              dv[2 * e + 1] = bfhi(a0[r][e]) - lam * bfhi(a1[r][e]);
              ss += dv[2 * e] * dv[2 * e] + dv[2 * e + 1] * dv[2 * e + 1];
            }
            ss += __shfl_xor(ss, 1); ss += __shfl_xor(ss, 2); ss += __shfl_xor(ss, 4); ss += __shfl_xor(ss, 8);
            const float rstd = rsqrtf(ss * (1.0f / 128.0f) + EPS);
            u32x4 ow;
#pragma unroll
            for (int e = 0; e < 4; ++e)
              ow[e] = pk_bf16(dv[2 * e] * rstd * sgv[2 * e] * siluf_(bflo(gt[r][e])), dv[2 * e + 1] * rstd * sgv[2 * e + 1] * siluf_(bfhi(gt[r][e])));
            if (row < TG) *(u32x4*)(Y + (size_t)row * 1536 + lane * 8) = ow;
          }
        }
      }
      GSYNC();
      for (int t = vb; t < (TG / 256) * 4; t += nb) {
        PHASE_IDS
        int mt, nt; tile_decode(t, 4, mt, nt);
        f32x16 acc[4][2]; zero_acc<2>(acc);
        for (int j = 0; j < 3; ++j) {
          gemm_acc<2, false>(acc, Y + (size_t)mt * 256 * 1536 + 512 * j, 1536, wbr + ((size_t)j * DM + nt * 256) * 512, 512, 512, smem);
          const float fl = (j < 2) ? 1.0f : 0.0f;
          const bf16_t *ga_, *gb_;
          { const int tid = opaque_tid(), lane = tid & 63, wave = tid >> 6;
            ga_ = GP + ((size_t)((mt * 12 + 4 * j + nt) * 8 + wave) * 16) * 512 + lane * 8;
            gb_ = (j < 2) ? ga_ + (size_t)4 * 8 * 16 * 512 : ga_; }
#pragma unroll
          for (int k = 0; k < 16; ++k) {
            const u32x4 wa = *(const u32x4*)(ga_ + k * 512), wb = *(const u32x4*)(gb_ + k * 512);
            f32x16& a = acc[k >> 2][(k >> 1) & 1];
            const int b8 = 8 * (k & 1);
#pragma unroll
            for (int q = 0; q < 8; ++q) {
              const float av = (q & 1) ? bfhi(wa[q >> 1]) : bflo(wa[q >> 1]), bv = (q & 1) ? bfhi(wb[q >> 1]) : bflo(wb[q >> 1]);
              const float ea = __expf(-av), eb = __expf(-bv) * fl;
              a[b8 + q] *= (1.0f + eb) * __builtin_amdgcn_rcpf(1.0f + ea);
            }
            if ((k & 3) == 3) asm volatile("" : "+v"(acc[k >> 2][0]), "+v"(acc[k >> 2][1]) : : "memory");
          }
        }
        __syncthreads();
        {
          char* wl = smem + wave * 16384;
          stage_tile_bf16(acc, wl, lane);
          const int ch = lane & 7;
          bf16_t* mb = M + (size_t)(mt * 256 + 128 * (wave >> 2)) * DM + nt * 256 + 64 * (wave & 3) + ch * 8;
#pragma unroll 4
          for (int it = 0; it < 16; ++it) {
            const int row = it * 8 + (lane >> 3);
            *(u32x4*)(mb + (size_t)row * DM) = *(const u32x4*)(wl + row * 128 + ch * 16);
          }
        }
      }
      GSYNC();
      for (int t = vb; t < (TG / 256) * 4; t += nb) {
        PHASE_IDS
        int mt, nt; tile_decode(t, 4, mt, nt);
        f32x16 acc[4][2]; zero_acc<2>(acc);
        gemm_acc<2, false>(acc, M + (size_t)mt * 256 * DM, DM, wout + (size_t)nt * 256 * DM, DM, DM, smem);
        __syncthreads();
        {
          char* wl = smem + wave * 16384;
          stage_tile_bf16(acc, wl, lane);
          const int ch = lane & 7;
          bf16_t* zb = Zb + (size_t)(mt * 256 + 128 * (wave >> 2)) * DM + nt * 256 + 64 * (wave & 3) + ch * 8;
#pragma unroll 4
          for (int it = 0; it < 16; ++it) {
            const int row = it * 8 + (lane >> 3);
            *(u32x4*)(zb + (size_t)row * DM) = *(const u32x4*)(wl + row * 128 + ch * 16);
          }
        }
      }
      GSYNC();
      {
        PHASE_IDS
        const float* g = p.in[16] + layer * DM;
        f32x4 gv[4];
#pragma unroll
        for (int j = 0; j < 4; ++j) gv[j] = *(const f32x4*)(g + 4 * (lane + 64 * j));
        for (int row0 = gw; row0 < TG; row0 += 2 * nw) {
          f32x4 v[2][4], xv[2][4];
#pragma unroll
          for (int r = 0; r < 2; ++r) {
            const int row = min(row0 + r * nw, TG - 1);
#pragma unroll
            for (int j = 0; j < 4; ++j) {
              { const u32x2 zw = *(const u32x2*)(Zb + (size_t)row * DM + 4 * (lane + 64 * j)); v[r][j] = (f32x4){bflo(zw[0]), bfhi(zw[0]), bflo(zw[1]), bfhi(zw[1])}; }
              xv[r][j] = *(const f32x4*)(xres + (size_t)row * DM + 4 * (lane + 64 * j));
            }
          }
#pragma unroll
          for (int r = 0; r < 2; ++r) {
            const int row = row0 + r * nw;
            float ss = 0.f;
#pragma unroll
            for (int j = 0; j < 4; ++j) ss += v[r][j][0] * v[r][j][0] + v[r][j][1] * v[r][j][1] + v[r][j][2] * v[r][j][2] + v[r][j][3] * v[r][j][3];
            ss = wave_sum(ss);
            const float rstd = rsqrtf(ss * (1.0f / DM) + EPS);
            if (row < TG) {
#pragma unroll
              for (int j = 0; j < 4; ++j) {
                const int c = 4 * (lane + 64 * j);
                f32x4 o;
#pragma unroll
                for (int e = 0; e < 4; ++e) o[e] = xv[r][j][e] + v[r][j][e] * rstd * gv[j][e];
                *(f32x4*)(xout + (size_t)row * DM + c) = o;
                *(u32x2*)(H + (size_t)row * DM + c) = (u32x2){pk_bf16(o[0], o[1]), pk_bf16(o[2], o[3])};
              }
            }
          }
        }
      }
      GSYNC();
      for (int t = vb; t < (TG / 256) * 8; t += nb) {
        PHASE_IDS
        int mt, nt; tile_decode(t, 8, mt, nt);
        unsigned pe[4][8];
        {
          f32x16 acc2[4][1]; zero_acc<1>(acc2);
          gemm_acc<1, true>(acc2, pin + (size_t)mt * 256 * DPLE, DPLE, wpe + (size_t)nt * 128 * DPLE, DPLE, DPLE, smem);
#pragma unroll
          for (int mi = 0; mi < 4; ++mi)
#pragma unroll
            for (int e = 0; e < 8; ++e) pe[mi][e] = pk_bf16(acc2[mi][0][2 * e], acc2[mi][0][2 * e + 1]);
        }
        f32x16 acc[4][1]; zero_acc<1>(acc);
        gemm_acc<1, false>(acc, H + (size_t)mt * 256 * DM, DM, wpg + (size_t)nt * 128 * DM, DM, DM, smem);
        __syncthreads();
        {
          char* wl = smem + wave * 16384;
          const int r32 = lane & 31, h = lane >> 5;
#pragma unroll
          for (int mi = 0; mi < 4; ++mi)
#pragma unroll
            for (int i = 0; i < 16; ++i) {
              const float pv = (i & 1) ? bfhi(pe[mi][i >> 1]) : bflo(pe[mi][i >> 1]);
              *(float*)(wl + (32 * mi + crow(i, h)) * 128 + r32 * 4) = sigmoidf_(acc[mi][0][i]) * pv;
            }
          const int ch = lane & 7;
          float* xb = xout + (size_t)(mt * 256 + 128 * (wave >> 2)) * DM + nt * 128 + 32 * (wave & 3) + ch * 4;
#pragma unroll 4
          for (int it = 0; it < 16; ++it) {
            const int row = it * 8 + (lane >> 3);
            const f32x4 d = *(const f32x4*)(wl + row * 128 + ch * 16);
            f32x4* xp = (f32x4*)(xb + (size_t)row * DM);
            *xp = *xp + d;
          }
        }
      }
      GSYNC();
    }
  }
}

extern "C" void kernel_launch(void* const* d_in, const int* in_sizes, int n_in, void* d_out, int out_size, void* d_ws, size_t ws_size, hipStream_t stream) {
  static int grid_blocks = 0;
  if (!grid_blocks) {
    int dev = 0, cus = 0, per_cu = 0;
    (void)hipGetDevice(&dev);
    (void)hipDeviceGetAttribute(&cus, hipDeviceAttributeMultiprocessorCount, dev);
    (void)hipFuncSetAttribute((const void*)fwd_kernel, hipFuncAttributeMaxDynamicSharedMemorySize, LDS_BYTES);
    (void)hipOccupancyMaxActiveBlocksPerMultiprocessor(&per_cu, fwd_kernel, 512, LDS_BYTES);
    if (per_cu < 1) per_cu = 1;
    if (per_cu > 1) per_cu = 1;
    grid_blocks = cus * per_cu;
    grid_blocks -= grid_blocks % 8;
    if (ws_size < WS_END) fprintf(stderr, "kernel_launch: workspace too small: %zu < %zu\n", ws_size, (size_t)WS_END);
  }
  Params p{};
  for (int i = 0; i < 19; ++i) p.in[i] = (const float*)d_in[i];
  p.out = (float*)d_out;
  p.ws = (unsigned char*)d_ws;
  const float li[4] = {0.2f, 0.35550906759096926f, 0.47071301834358413f, 0.5560582041556852f};
  for (int i = 0; i < 4; ++i) p.lambda_init[i] = li[i];
  (void)hipMemsetAsync((char*)d_ws + WS_BAR, 0, 16384, stream);
  void* args[] = {&p};
  hipError_t e = hipLaunchCooperativeKernel((void*)fwd_kernel, dim3(grid_blocks), dim3(512), args, LDS_BYTES, stream);
  if (e != hipSuccess) fprintf(stderr, "cooperative launch failed: %s (grid %d)\n", hipGetErrorString(e), grid_blocks);
}
```

```cpp
#include <hip/hip_runtime.h>
#include <hip/hip_cooperative_groups.h>
#include <stdint.h>
#include <stdio.h>
namespace cg = cooperative_groups;

typedef unsigned short bf16_t;
typedef short bf16x8 __attribute__((ext_vector_type(8)));
typedef short s16x4 __attribute__((ext_vector_type(4)));
typedef float f32x16 __attribute__((ext_vector_type(16)));
typedef float f32x4 __attribute__((ext_vector_type(4)));
typedef float f32x2 __attribute__((ext_vector_type(2)));
typedef __bf16 bf16x2_t __attribute__((ext_vector_type(2)));
typedef unsigned u32x4 __attribute__((ext_vector_type(4)));
typedef unsigned u32x2 __attribute__((ext_vector_type(2)));
#define DI __device__ __forceinline__
#define LDSAS __attribute__((address_space(3)))

constexpr int DM = 1024, SEQ = 4096, NL = 4, INW = 8448, DPLE = 256;
constexpr int UP = 5376;
constexpr int G = 8;
constexpr int NG = 24 / G;
constexpr int TG = G * SEQ;
constexpr float EPS = 1e-6f;
constexpr float LOG2E = 1.4426950408889634f;
constexpr int C_AQ = 0, C_AK = 512, C_AV = 1024, C_AG = 1536, C_BQ = 2048, C_BK = 2560, C_BV = 2688, C_BG = 2816,
              C_CQ = 3328, C_CK = 3840, C_CV = 4352, C_CG = 4864, C_MG = 5376;
constexpr size_t WS_BAR = 0;
constexpr size_t WS_ROPE = 16384;
constexpr size_t WS_WIN = 32768;
constexpr size_t WS_WBR = WS_WIN + (size_t)NL * INW * DM * 2;
constexpr size_t WS_WOUT = WS_WBR + (size_t)NL * 3 * DM * 512 * 2;
constexpr size_t WS_WPG = WS_WOUT + (size_t)NL * DM * DM * 2;
constexpr size_t WS_WPE = WS_WPG + (size_t)NL * DM * DM * 2;
constexpr size_t WS_U = WS_WPE + (size_t)NL * DM * DPLE * 2;
constexpr size_t WS_H = WS_U + (size_t)TG * UP * 2;
constexpr size_t WS_OA = WS_H + (size_t)TG * DM * 2;
constexpr size_t WS_Y = WS_OA + (size_t)TG * DM * 2;
constexpr size_t WS_M = WS_OA;
constexpr size_t WS_Z = WS_Y;
constexpr size_t WS_GP = WS_Y + (size_t)TG * 1536 * 2;
constexpr size_t WS_XCH = WS_GP + (size_t)TG * 3072 * 2;
constexpr size_t WS_END = WS_XCH + (size_t)TG * 4 * 4;

struct Params {
  const float* in[19];
  float* out;
  unsigned char* ws;
  float lambda_init[4];
};

DI unsigned pk_bf16(float lo, float hi) { f32x2 v = {lo, hi}; bf16x2_t b = __builtin_convertvector(v, bf16x2_t); return __builtin_bit_cast(unsigned, b); }
DI float bf2f(unsigned short b) { return __uint_as_float(((unsigned)b) << 16); }
DI float bflo(unsigned w) { return __uint_as_float(w << 16); }
DI float bfhi(unsigned w) { return __uint_as_float(w & 0xffff0000u); }
DI unsigned short f2bf(float f) { return (unsigned short)(pk_bf16(f, 0.f) & 0xffffu); }
DI float wave_sum(float v) {
#pragma unroll
  for (int o = 32; o >= 1; o >>= 1) v += __shfl_xor(v, o);
  return v;
}
DI float sigmoidf_(float x) { return 1.0f / (1.0f + __expf(-x)); }
DI float siluf_(float x) { return x / (1.0f + __expf(-x)); }
DI int opaque_tid() { int t = threadIdx.x; asm volatile("" : "+v"(t)); return t; }
DI int crow(int i, int h) { return (i & 3) + 8 * (i >> 2) + 4 * h; }
#define MFMA32(a, b, c) __builtin_amdgcn_mfma_f32_32x32x16_bf16((a), (b), (c), 0, 0, 0)

DI void dma16(const void* gsrc, char* lds_wave_base) {
  __builtin_amdgcn_global_load_lds((const unsigned*)gsrc, (LDSAS unsigned*)lds_wave_base, 16, 0, 0);
}
DI void dma_sync() { asm volatile("s_waitcnt vmcnt(0)" ::: "memory"); __syncthreads(); }
template <int NI, bool A_F32>
DI void gemm_acc(f32x16 (&acc)[4][NI], const void* Aptr, int lda, const bf16_t* Wt, int ldw, int K, char* smem) {
  constexpr int A_BYTES = 32768, STG = A_BYTES + 16384 * NI;
  const int tid = opaque_tid(), lane = tid & 63, wave = __builtin_amdgcn_readfirstlane(tid >> 6), wr = wave >> 2, wc = wave & 3, r32 = lane & 31, h = lane >> 5;
  const int drow = wave * 8 + (lane >> 3);
  const int dch = (lane & 7) ^ ((drow >> 1) & 7);
  const bf16_t* wsrc = Wt + (size_t)drow * ldw + dch * 8;
  const bf16_t* asrc = (const bf16_t*)Aptr + (size_t)drow * lda + dch * 8;
  const int lrow = tid >> 3, lch = tid & 7;
  u32x4 ra[4];
  auto gloadA = [&](int k0) {
#pragma unroll
    for (int j = 0; j < 4; ++j) {
      const float* pa = (const float*)Aptr + (size_t)(lrow + 64 * j) * lda + k0 + lch * 8;
      const f32x4 v0 = *(const f32x4*)pa, v1 = *(const f32x4*)(pa + 4);
      ra[j] = (u32x4){pk_bf16(v0[0], v0[1]), pk_bf16(v0[2], v0[3]), pk_bf16(v1[0], v1[1]), pk_bf16(v1[2], v1[3])};
    }
  };
  auto lstoreA = [&](int buf) {
    char* sa = smem + buf * STG;
#pragma unroll
    for (int j = 0; j < 4; ++j) {
      const int row = lrow + 64 * j;
      *(u32x4*)(sa + row * 128 + ((lch ^ ((row >> 1) & 7)) << 4)) = ra[j];
    }
  };
  auto issue = [&](int kt, int buf) {
    char* sa = smem + buf * STG + wave * 1024;
    char* sb = sa + A_BYTES;
    if (!A_F32) {
#pragma unroll
      for (int j = 0; j < 4; ++j) dma16(asrc + (size_t)(64 * j) * lda + kt * 64, sa + j * 8192);
    }
#pragma unroll
    for (int j = 0; j < 2 * NI; ++j) dma16(wsrc + (size_t)(64 * j) * ldw + kt * 64, sb + j * 8192);
  };
  const int nk = K >> 6;
  const int xsw = (r32 >> 1) & 7;
  const int a_base = (128 * wr + r32) * 128, b_base = A_BYTES + (32 * NI * wc + r32) * 128;
  __syncthreads();
  if (A_F32) { gloadA(0); lstoreA(0); }
  issue(0, 0);
  for (int kt = 0; kt < nk; ++kt) {
    dma_sync();
    if (kt + 1 < nk) { issue(kt + 1, (kt + 1) & 1); if (A_F32) gloadA((kt + 1) << 6); }
    const char* st = smem + (kt & 1) * STG;
#pragma unroll
    for (int s = 0; s < 4; ++s) {
      const int sw = ((2 * s + h) ^ xsw) << 4;
      bf16x8 af[4], bfr[NI];
#pragma unroll
      for (int mi = 0; mi < 4; ++mi) af[mi] = *(const bf16x8*)(st + a_base + sw + mi * 4096);
#pragma unroll
      for (int ni = 0; ni < NI; ++ni) bfr[ni] = *(const bf16x8*)(st + b_base + sw + ni * 4096);
#pragma unroll
      for (int mi = 0; mi < 4; ++mi)
#pragma unroll
        for (int ni = 0; ni < NI; ++ni) acc[mi][ni] = MFMA32(af[mi], bfr[ni], acc[mi][ni]);
    }
    if (A_F32) { if (kt + 1 < nk) lstoreA((kt + 1) & 1); }
  }
}
template <int NI>
DI void zero_acc(f32x16 (&acc)[4][NI]) {
#pragma unroll
  for (int a = 0; a < 4; ++a)
#pragma unroll
    for (int b = 0; b < NI; ++b)
#pragma unroll
      for (int i = 0; i < 16; ++i) acc[a][b][i] = 0.f;
}
#define EPI_LOOP(NI_) _Pragma("unroll") for (int mi = 0; mi < 4; ++mi) _Pragma("unroll") for (int ni = 0; ni < NI_; ++ni) _Pragma("unroll") for (int i = 0; i < 16; ++i)
#define EPI_OFF0(mt, nt, NI_, ld) ((unsigned)((mt) * 256 + 128 * (wave >> 2) + 4 * (lane >> 5)) * (unsigned)(ld) + (unsigned)((nt) * 128 * NI_ + 32 * NI_ * (wave & 3) + (lane & 31)))
#define EPI_OFF(off0, ld) ((off0) + (unsigned)((32 * mi + (i & 3) + 8 * (i >> 2)) * (ld) + 32 * ni))
#define EPI_FENCE
DI void stage_tile_bf16(const f32x16 (&acc)[4][2], char* wl, int lane) {
  const int r32 = lane & 31, h = lane >> 5;
#pragma unroll
  for (int mi = 0; mi < 4; ++mi)
#pragma unroll
    for (int ni = 0; ni < 2; ++ni)
#pragma unroll
      for (int i = 0; i < 16; ++i) *(bf16_t*)(wl + (32 * mi + crow(i, h)) * 128 + (32 * ni + r32) * 2) = f2bf(acc[mi][ni][i]);
}
DI void tile_decode(int t, int ntn, int& mt, int& nt) {
  const int band = t / (8 * ntn), w = t - band * 8 * ntn;
  nt = w >> 3;
  mt = band * 8 + (w & 7);
}

template <int MODE>
DI void attn_unit(const bf16_t* __restrict__ U, bf16_t* __restrict__ OA, bf16_t* __restrict__ Y, int seq_l, int head, int qb,
                  const float* __restrict__ t5, const float* __restrict__ rpb, char* smem) {
  constexpr int DV = (MODE == 0) ? 128 : 64;
  constexpr int NDB = DV / 32;
  constexpr int NKB = (MODE == 2) ? 2 : 4;
  constexpr int KT = 32 * NKB;
  constexpr int KBYTES = KT * 128, VBYTES = KT * DV * 2, STAGE = KBYTES + VBYTES;
  constexpr int NKJ = KBYTES / 8192;
  constexpr int NVJ = VBYTES / 8192;
  float* lut = (float*)(smem + 98304);
  const int tid = opaque_tid(), lane = tid & 63, wave = tid >> 6, r32 = lane & 31, h = lane >> 5;
  const size_t tok0 = (size_t)seq_l * SEQ;
  const int q0 = qb * 256;
  int qcol, kcol, vcol;
  if (MODE == 0) { qcol = C_AQ + head * 64; kcol = C_AK + head * 64; vcol = C_AV + (head >> 1) * 128; }
  else if (MODE == 1) { qcol = C_BQ + head * 64; kcol = C_BK + (head >> 2) * 64; vcol = C_BV + (head >> 2) * 64; }
  else { qcol = C_CQ + head * 64; kcol = C_CK + head * 64; vcol = C_CV + head * 64; }
  int kt0 = 0, NT = SEQ / KT;
  if (MODE == 2) { int b0 = 4 * qb - 4; b0 = b0 < 0 ? 0 : (b0 > 53 ? 53 : b0); kt0 = b0; NT = 11; }

  __syncthreads();
  if (MODE == 0) {
    for (int i = tid; i < 257; i += 512) {
      const int r = i - 128, n = r < 0 ? -r : r;
      int b;
      if (n < 8) b = n;
      else { b = 8 + (n >= 12) + (n >= 16) + (n >= 23) + (n >= 32) + (n >= 46) + (n >= 64) + (n >= 91); }
      if (r > 0) b += 16;
      lut[i] = t5[b * 8 + head] * LOG2E;
    }
  } else if (MODE == 2) {
    for (int i = tid; i < 465; i += 512) lut[i] = rpb[head * 465 + i] * LOG2E;
  }

  const int qi = q0 + wave * 32 + r32;
  bf16x8 qf[4];
  {
    const bf16_t* qp = U + (tok0 + qi) * UP + qcol + 8 * h;
#pragma unroll
    for (int s = 0; s < 4; ++s) {
      const u32x4 raw = *(const u32x4*)(qp + 16 * s);
      u32x4 o;
#pragma unroll
      for (int e = 0; e < 4; ++e) o[e] = pk_bf16(bflo(raw[e]) * 0.125f, bfhi(raw[e]) * 0.125f);
      qf[s] = __builtin_bit_cast(bf16x8, o);
    }
  }

  const int wv = __builtin_amdgcn_readfirstlane(wave);
  int koff[NKJ], voff[NVJ];
#pragma unroll
  for (int j = 0; j < NKJ; ++j) {
    const int row = (wv + 8 * j) * 8 + (lane >> 3), ch = (lane & 7) ^ ((row >> 1) & 7);
    koff[j] = row * UP + kcol + ch * 8;
  }
#pragma unroll
  for (int j = 0; j < NVJ; ++j) {
    if (DV == 64) { const int row = (wv + 8 * j) * 8 + (lane >> 3), ch = (lane & 7) ^ (((row >> 1) & 1) << 2); voff[j] = row * UP + vcol + ch * 8; }
    else { const int row = (wv + 8 * j) * 4 + (lane >> 4), ch = (lane & 15) ^ ((row & 3) << 2); voff[j] = row * UP + vcol + ch * 8; }
  }
  auto issue = [&](int kt, int buf) {
    const bf16_t* base = U + (tok0 + (size_t)kt * KT) * UP;
    char* sk = smem + buf * STAGE + wv * 1024;
#pragma unroll
    for (int j = 0; j < NKJ; ++j) dma16(base + koff[j], sk + j * 8192);
#pragma unroll
    for (int j = 0; j < NVJ; ++j) dma16(base + voff[j], sk + KBYTES + j * 8192);
  };

  f32x16 o[NDB];
#pragma unroll
  for (int db = 0; db < NDB; ++db)
#pragma unroll
    for (int i = 0; i < 16; ++i) o[db][i] = 0.f;
  float m_run = -INFINITY, l_run = 0.f;

  const int q4 = (lane & 15) >> 2, p4 = lane & 3, blk = (lane >> 4) & 1;
  const int qr = 4 * qb + (wave >> 1), qc = (wave & 1) * 32 + r32;
  int sr = qr - 4; sr = sr < 0 ? 0 : (sr > 56 ? 56 : sr);
  int sc = qc - 8; sc = sc < 0 ? 0 : (sc > 48 ? 48 : sc);

  issue(kt0, 0);
  float bl_pos = 0.f, bl_neg = 0.f;
  for (int it = 0; it < NT; ++it) {
    const int kt = kt0 + it;
    dma_sync();
    if (it + 1 < NT) issue(kt + 1, (it + 1) & 1);
    if (MODE == 0 && it == 0) { bl_pos = lut[256]; bl_neg = lut[0]; }
    const char* sk = smem + (it & 1) * STAGE;
    const char* sv = sk + KBYTES;
    bool active = true;
    if (MODE == 2) active = (kt >= sr) && (kt < sr + 8);
    if (active) {
      f32x16 st[NKB];
      {
        bf16x8 kf[NKB][4];
        const int ksw = (r32 >> 1) & 7;
        const char* kp = sk + r32 * 128;
#pragma unroll
        for (int s = 0; s < 4; ++s) kf[0][s] = *(const bf16x8*)(kp + (((2 * s + h) ^ ksw) << 4));
        asm volatile("" ::: "memory");
#pragma unroll
        for (int kb = 0; kb < NKB; ++kb) {
          if (kb + 1 < NKB) {
#pragma unroll
            for (int s = 0; s < 4; ++s) kf[kb + 1][s] = *(const bf16x8*)(kp + (kb + 1) * 4096 + (((2 * s + h) ^ ksw) << 4));
            asm volatile("" ::: "memory");
          }
#pragma unroll
          for (int i = 0; i < 16; ++i) st[kb][i] = 0.f;
#pragma unroll
          for (int s = 0; s < 4; ++s) st[kb] = MFMA32(kf[kb][s], qf[s], st[kb]);
        }
      }
      bool uni = (MODE == 1);
      float bl = 0.f;
      if (MODE == 0) {
        const int rel_min = kt * KT - (q0 + 255), rel_max = kt * KT + (KT - 1) - q0;
        uni = (rel_min >= 128) || (rel_max <= -128);
        bl = (rel_min >= 128) ? bl_pos : bl_neg;
      }
      if (!uni) {
        if (MODE == 0) {
#pragma unroll
          for (int kb = 0; kb < NKB; ++kb)
#pragma unroll
            for (int i = 0; i < 16; ++i) {
              int rel = kt * KT + 32 * kb + crow(i, h) - qi;
              rel = rel < -128 ? -128 : (rel > 128 ? 128 : rel);
              st[kb][i] = __builtin_fmaf(st[kb][i], LOG2E, lut[rel + 128]);
            }
        } else if (MODE == 2) {
          const int ri = kt - qr + 7;
#pragma unroll
          for (int kb = 0; kb < NKB; ++kb)
#pragma unroll
            for (int i = 0; i < 16; ++i) {
              const int kc = 32 * kb + crow(i, h);
              const bool ok = (kc >= sc) && (kc < sc + 16);
              int ci = kc - qc + 15; ci = ci < 0 ? 0 : (ci > 30 ? 30 : ci);
              const float bb = lut[ri * 31 + ci];
              st[kb][i] = ok ? __builtin_fmaf(st[kb][i], LOG2E, bb) : -INFINITY;
            }
        }
      }
      float mx;
      {
        float mk[NKB];
#pragma unroll
        for (int kb = 0; kb < NKB; ++kb) {
          float m0 = fmaxf(fmaxf(st[kb][0], st[kb][1]), st[kb][2]);
#pragma unroll
          for (int i = 3; i < 15; i += 2) m0 = fmaxf(fmaxf(m0, st[kb][i]), st[kb][i + 1]);
          mk[kb] = fmaxf(m0, st[kb][15]);
        }
        mx = fmaxf(mk[0], mk[1]);
        if (NKB == 4) mx = fmaxf(fmaxf(mx, mk[NKB - 2]), mk[NKB - 1]);
      }
      { const auto rr = __builtin_amdgcn_permlane32_swap(__float_as_uint(mx), __float_as_uint(mx), false, false);
        mx = fmaxf(__uint_as_float(rr[0]), __uint_as_float(rr[1])); }
      const float mt = uni ? __builtin_fmaf(mx, LOG2E, bl) : mx;
      if (__any(mt > m_run)) {
        const float m_new = fmaxf(m_run, mt);
        const float alpha = __builtin_amdgcn_exp2f(m_run - m_new);
        m_run = m_new;
        l_run *= alpha;
#pragma unroll
        for (int db = 0; db < NDB; ++db) o[db] = o[db] * alpha;
      }
      {
        const float mul = uni ? LOG2E : 1.0f, cc = uni ? (bl - m_run) : -m_run;
        float ps[NKB];
#pragma unroll
        for (int kb = 0; kb < NKB; ++kb) {
#pragma unroll
          for (int i = 0; i < 16; ++i) st[kb][i] = __builtin_amdgcn_exp2f(__builtin_fmaf(st[kb][i], mul, cc));
          const float s0 = (st[kb][0] + st[kb][1]) + (st[kb][2] + st[kb][3]), s1 = (st[kb][4] + st[kb][5]) + (st[kb][6] + st[kb][7]);
          const float s2 = (st[kb][8] + st[kb][9]) + (st[kb][10] + st[kb][11]), s3 = (st[kb][12] + st[kb][13]) + (st[kb][14] + st[kb][15]);
          ps[kb] = (s0 + s1) + (s2 + s3);
        }
        float pt = ps[0] + ps[1];
        if (NKB == 4) pt += ps[NKB - 2] + ps[NKB - 1];
        l_run += pt;
      }
#pragma unroll
      for (int kb = 0; kb < NKB; ++kb)
#pragma unroll
        for (int s2 = 0; s2 < 2; ++s2) {
          u32x4 w;
#pragma unroll
          for (int e = 0; e < 4; ++e) w[e] = pk_bf16(st[kb][8 * s2 + 2 * e], st[kb][8 * s2 + 2 * e + 1]);
          const bf16x8 pf = __builtin_bit_cast(bf16x8, w);
#pragma unroll
          for (int db = 0; db < NDB; ++db) {
            s16x4 part[2];
#pragma unroll
            for (int hf = 0; hf < 2; ++hf) {
              const int row = 32 * kb + 16 * s2 + 8 * hf + 4 * h + q4;
              const int chunk = 4 * db + 2 * blk + (p4 >> 1);
              int off;
              if (DV == 64) off = row * 128 + ((chunk ^ (((q4 >> 1) & 1) << 2)) << 4) + (p4 & 1) * 8;
              else off = row * 256 + ((chunk ^ (q4 << 2)) << 4) + (p4 & 1) * 8;
              part[hf] = __builtin_bit_cast(s16x4, __builtin_amdgcn_ds_read_tr16_b64_v4i16((LDSAS s16x4*)(sv + off)));
            }
            const bf16x8 vf = __builtin_shufflevector(part[0], part[1], 0, 1, 2, 3, 4, 5, 6, 7);
            o[db] = MFMA32(vf, pf, o[db]);
          }
        }
    }
  }
  const float l_tot = l_run + __shfl_xor(l_run, 32);
  const float inv = 1.0f / l_tot;
  const size_t tok = tok0 + qi;
#pragma unroll
  for (int db = 0; db < NDB; ++db)
#pragma unroll
    for (int g4 = 0; g4 < 4; ++g4) {
      const int d = 32 * db + 8 * g4 + 4 * h;
      float v0 = o[db][4 * g4] * inv, v1 = o[db][4 * g4 + 1] * inv, v2 = o[db][4 * g4 + 2] * inv, v3 = o[db][4 * g4 + 3] * inv;
      if (MODE == 0) {
        *(u32x2*)(OA + tok * DM + head * 128 + d) = (u32x2){pk_bf16(v0, v1), pk_bf16(v2, v3)};
      } else {
        const int gcol = (MODE == 1 ? C_BG : C_CG) + head * 64 + d;
        const u32x2 gw = *(const u32x2*)(U + tok * UP + gcol);
        v0 *= siluf_(bflo(gw[0])); v1 *= siluf_(bfhi(gw[0])); v2 *= siluf_(bflo(gw[1])); v3 *= siluf_(bfhi(gw[1]));
        *(u32x2*)(Y + tok * 1536 + (MODE == 1 ? 512 : 1024) + head * 64 + d) = (u32x2){pk_bf16(v0, v1), pk_bf16(v2, v3)};
      }
    }
}

DI void transpose_tile(const float* __restrict__ src, bf16_t* __restrict__ dst, int R, int C, int tr, int tc, char* smem) {
  float* tl = (float*)smem;
  const int tid = opaque_tid();
  const int r0 = tr * 64, c0 = tc * 64;
  __syncthreads();
#pragma unroll
  for (int i = 0; i < 8; ++i) {
    const int r = i * 8 + (tid >> 6), c = tid & 63;
    tl[r * 65 + c] = src[(size_t)(r0 + r) * C + c0 + c];
  }
  __syncthreads();
  const int n = tid >> 3, kb = (tid & 7) * 8;
  unsigned w[4];
#pragma unroll
  for (int e = 0; e < 4; ++e) w[e] = pk_bf16(tl[(kb + 2 * e) * 65 + n], tl[(kb + 2 * e + 1) * 65 + n]);
  *(u32x4*)(dst + (size_t)(c0 + n) * R + r0 + kb) = (u32x4){w[0], w[1], w[2], w[3]};
}

#define XB_TMO      128
#define XB_XCNT(j)  (256  + 64 * (j))
#define XB_XSUB(j)  (1280 + 64 * (j))
#define XB_XGEN(j)  (2304 + 64 * (j))
#define XB_TOP      3328
#define XB_TOPGEN   3392
#define XCD_BAR_WORDS 3456
#define XB_SPIN_CAP (1u << 20)
DI unsigned xb_ld(unsigned* p) { return __hip_atomic_load(p, __ATOMIC_RELAXED, __HIP_MEMORY_SCOPE_AGENT); }
DI unsigned xb_add(unsigned* p, unsigned v) { return __hip_atomic_fetch_add(p, v, __ATOMIC_RELAXED, __HIP_MEMORY_SCOPE_AGENT); }
DI unsigned xb_xcc_id() { return (unsigned)__builtin_amdgcn_s_getreg((3 << 11) | 20) & 0xFu; }
#define XB_SPIN(cond, bar) do { unsigned _sp = 0; while (cond) { __builtin_amdgcn_s_sleep(1); \
    if ((++_sp & 255u) == 0u) { if (xb_ld(&(bar)[XB_TMO])) break; if (_sp > XB_SPIN_CAP) { atomicAdd(&(bar)[XB_TMO], 1u); break; } } } } while (0)
struct XcdBarrier { unsigned* bar; unsigned x; volatile LDSAS unsigned* st; };
DI XcdBarrier xcd_barrier_post(unsigned* bar, volatile LDSAS unsigned* st) {
  XcdBarrier b; b.bar = bar; b.x = xb_xcc_id(); b.st = st;
  if (threadIdx.x == 0) (void)xb_add(&bar[XB_XCNT(b.x)], 1u);
  return b;
}
DI void xcd_barrier_complete(unsigned* bar, unsigned x, unsigned& nloc, unsigned& nx) {
  const unsigned Gn = gridDim.x * gridDim.y * gridDim.z;
  unsigned sum, cnt, mine, sp = 0u;
  for (;;) {
    sum = 0u; cnt = 0u; mine = 0u;
#pragma unroll
    for (unsigned j = 0; j < 16; ++j) { const unsigned c = xb_ld(&bar[XB_XCNT(j)]); sum += c; cnt += (c > 0u) ? 1u : 0u; mine = (j == x) ? c : mine; }
    if (sum == Gn) break;
    __builtin_amdgcn_s_sleep(1);
    if ((++sp & 255u) == 0u) { if (xb_ld(&bar[XB_TMO])) break; if (sp > XB_SPIN_CAP) { atomicAdd(&bar[XB_TMO], 1u); break; } }
  }
  nloc = mine > 0u ? mine : 1u; nx = cnt > 0u ? cnt : 1u;
}
DI void xcd_barrier(const XcdBarrier& b) {
  asm volatile("s_waitcnt vmcnt(0)" ::: "memory");
  __syncthreads();
  if (threadIdx.x == 0) {
    unsigned* bar = b.bar;
    __builtin_amdgcn_s_waitcnt(0);
    unsigned nloc = b.st[0], nx = b.st[1];
    if (nloc == 0u) { xcd_barrier_complete(bar, b.x, nloc, nx); b.st[0] = nloc; b.st[1] = nx; }
    const unsigned old = xb_add(&bar[XB_XSUB(b.x)], 1u);
    const unsigned gen = old / nloc;
    if (old + 1u == (gen + 1u) * nloc) {
      __builtin_amdgcn_fence(__ATOMIC_RELEASE, "agent");
      asm volatile("s_waitcnt vmcnt(0)" ::: "memory");
      const unsigned og = xb_add(&bar[XB_TOP], 1u);
      const unsigned tg = og / nx;
      if (og + 1u == (tg + 1u) * nx) xb_add(&bar[XB_TOPGEN], 1u);
      else XB_SPIN(xb_ld(&bar[XB_TOPGEN]) == tg, bar);
      __builtin_amdgcn_fence(__ATOMIC_ACQUIRE, "agent");
      xb_add(&bar[XB_XGEN(b.x)], 1u);
      asm volatile("s_waitcnt vmcnt(0)" ::: "memory");
    } else {
      XB_SPIN(xb_ld(&bar[XB_XGEN(b.x)]) == gen, bar);
      __builtin_amdgcn_fence(__ATOMIC_ACQUIRE, "agent");
      asm volatile("s_waitcnt vmcnt(0)" ::: "memory");
    }
  }
  __syncthreads();
}

constexpr int LDS_BYTES = 131072 + 16 + 5120;
__global__ void __launch_bounds__(512, 2) fwd_kernel(Params p) {
  extern __shared__ __attribute__((aligned(16))) char smem[];
  cg::grid_group grid = cg::this_grid();
  const int nb = gridDim.x, bid = blockIdx.x;
  volatile LDSAS unsigned* xb_st = (volatile LDSAS unsigned*)(smem + 131072);
  if (threadIdx.x == 0) { xb_st[0] = 0u; xb_st[1] = 0u; xb_st[2] = 0u; xb_st[3] = 0u; }
  __syncthreads();
  const XcdBarrier xb = xcd_barrier_post((unsigned*)(p.ws + WS_BAR), xb_st);
#define GSYNC() xcd_barrier(xb)
  const int vb = (bid & 7) * (nb >> 3) + (bid >> 3);
  const int nw = nb * 8;
#define PHASE_IDS const int tid = opaque_tid(), lane = tid & 63, wave = tid >> 6, gw = vb * 8 + wave; (void)lane; (void)gw;
  unsigned char* ws = p.ws;
  bf16_t* WIN = (bf16_t*)(ws + WS_WIN);
  bf16_t* WBR = (bf16_t*)(ws + WS_WBR);
  bf16_t* WOUT = (bf16_t*)(ws + WS_WOUT);
  bf16_t* WPG = (bf16_t*)(ws + WS_WPG);
  bf16_t* WPE = (bf16_t*)(ws + WS_WPE);
  float* ROPE = (float*)(ws + WS_ROPE);
  bf16_t* U = (bf16_t*)(ws + WS_U);
  bf16_t* H = (bf16_t*)(ws + WS_H);
  bf16_t* OA = (bf16_t*)(ws + WS_OA);
  bf16_t* Y = (bf16_t*)(ws + WS_Y);
  bf16_t* M = (bf16_t*)(ws + WS_M);
  bf16_t* Zb = (bf16_t*)(ws + WS_Z);
  bf16_t* GP = (bf16_t*)(ws + WS_GP);
  float* XCH = (float*)(ws + WS_XCH);
  unsigned* XCNT = (unsigned*)(ws + WS_BAR) + 3584;

  {
        PHASE_IDS
    for (int t = bid; t < 4 * 3072; t += nb) {
      const int layer = t / 3072;
      int r = t - layer * 3072;
      if (r < 2112) {
        transpose_tile(p.in[6] + (size_t)layer * DM * INW, WIN + (size_t)layer * INW * DM, DM, INW, r / 132, r % 132, smem);
      } else if (r < 2112 + 384) {
        r -= 2112;
        const int j = r / 128; r -= j * 128;
        transpose_tile(p.in[12 + j] + (size_t)layer * 512 * DM, WBR + ((size_t)layer * 3 + j) * DM * 512, 512, DM, r / 16, r % 16, smem);
      } else if (r < 2112 + 384 + 256) {
        r -= 2112 + 384;
        transpose_tile(p.in[15] + (size_t)layer * DM * DM, WOUT + (size_t)layer * DM * DM, DM, DM, r / 16, r % 16, smem);
      } else if (r < 2112 + 384 + 512) {
        r -= 2112 + 384 + 256;
        transpose_tile(p.in[18] + (size_t)layer * DM * DM, WPG + (size_t)layer * DM * DM, DM, DM, r / 16, r % 16, smem);
      } else {
        r -= 2112 + 384 + 512;
        transpose_tile(p.in[17] + (size_t)layer * DPLE * DM, WPE + (size_t)layer * DM * DPLE, DPLE, DM, r / 16, r % 16, smem);
      }
    }
    if (bid < 2) {
      const int i = bid * 512 + tid;
      const int pos = i >> 4, f = i & 15;
      const float inv = powf(10000.0f, -(float)f / 16.0f);
      const float ang = (float)pos * inv;
      ROPE[i] = cosf(ang);
      ROPE[1024 + i] = sinf(ang);
    }
  }
  grid.sync();

  for (int gi = 0; gi < NG; ++gi) {
    const int seq0 = gi * G;
    const bool is_prompt = seq0 < 16;
    const float* xin = is_prompt ? p.in[0] + (size_t)seq0 * SEQ * DM : p.in[1] + (size_t)(seq0 - 16) * SEQ * DM;
    float* xout = p.out + (size_t)seq0 * SEQ * DM;
    for (int layer = 0; layer < NL; ++layer) {
      const float* xres = (layer == 0) ? xin : (const float*)xout;
      const float* pin = is_prompt ? p.in[2] + ((size_t)layer * 16 + seq0) * SEQ * DPLE : p.in[3] + ((size_t)layer * 8 + (seq0 - 16)) * SEQ * DPLE;
      const bf16_t* win = WIN + (size_t)layer * INW * DM;
      const bf16_t* wbr = WBR + (size_t)layer * 3 * DM * 512;
      const bf16_t* wout = WOUT + (size_t)layer * DM * DM;
      const bf16_t* wpg = WPG + (size_t)layer * DM * DM;
      const bf16_t* wpe = WPE + (size_t)layer * DM * DPLE;

      {
        PHASE_IDS
        const float* g = p.in[5] + layer * DM;
        f32x4 gv[4];
#pragma unroll
        for (int j = 0; j < 4; ++j) gv[j] = *(const f32x4*)(g + 4 * (lane + 64 * j));
        for (int row0 = gw; row0 < TG; row0 += 4 * nw) {
          f32x4 v[4][4];
#pragma unroll
          for (int r = 0; r < 4; ++r) {
            const int row = min(row0 + r * nw, TG - 1);
#pragma unroll
            for (int j = 0; j < 4; ++j) v[r][j] = *(const f32x4*)(xres + (size_t)row * DM + 4 * (lane + 64 * j));
          }
#pragma unroll
          for (int r = 0; r < 4; ++r) {
            const int row = row0 + r * nw;
            float ss = 0.f;
#pragma unroll
            for (int j = 0; j < 4; ++j) ss += v[r][j][0] * v[r][j][0] + v[r][j][1] * v[r][j][1] + v[r][j][2] * v[r][j][2] + v[r][j][3] * v[r][j][3];
            ss = wave_sum(ss);
            const float rstd = rsqrtf(ss * (1.0f / DM) + EPS);
            if (row < TG) {
#pragma unroll
              for (int j = 0; j < 4; ++j)
                *(u32x2*)(H + (size_t)row * DM + 4 * (lane + 64 * j)) =
                    (u32x2){pk_bf16(v[r][j][0] * rstd * gv[j][0], v[r][j][1] * rstd * gv[j][1]), pk_bf16(v[r][j][2] * rstd * gv[j][2], v[r][j][3] * rstd * gv[j][3])};
            }
          }
        }
      }
      GSYNC();
      for (int t = vb; t < (TG / 256) * (INW / 256); t += nb) {
        PHASE_IDS
        int mt, nt; tile_decode(t, INW / 256, mt, nt);
        f32x16 acc[4][2]; zero_acc<2>(acc);
        gemm_acc<2, false>(acc, H + (size_t)mt * 256 * DM, DM, win + (size_t)nt * 256 * DM, DM, DM, smem);
        __syncthreads();
        if (nt >= 21) {
          bf16_t* gb = GP + ((size_t)((mt * 12 + (nt - 21)) * 8 + wave) * 16) * 512 + lane * 8;
#pragma unroll
          for (int k = 0; k < 16; ++k) {
            const f32x16& a = acc[k >> 2][(k >> 1) & 1];
            const int b8 = 8 * (k & 1);
            *(u32x4*)(gb + k * 512) = (u32x4){pk_bf16(a[b8], a[b8 + 1]), pk_bf16(a[b8 + 2], a[b8 + 3]), pk_bf16(a[b8 + 4], a[b8 + 5]), pk_bf16(a[b8 + 6], a[b8 + 7])};
          }
        } else {
          char* wl = smem + wave * 16384;
          stage_tile_bf16(acc, wl, lane);
          const bool rope = (nt == 8) || (nt == 9) || (nt == 10 && (wave & 3) < 2);
          const int ch = lane & 7;
          float gg[8];
          {
            const float* gsrc = (nt == 10 ? p.in[10] : p.in[9]) + layer * 64 + ch * 8;
#pragma unroll
            for (int e = 0; e < 8; ++e) gg[e] = rope ? gsrc[e] : 0.f;
          }
          const int rowb = mt * 256 + 128 * (wave >> 2);
          bf16_t* ub = U + (size_t)rowb * UP + nt * 256 + 64 * (wave & 3) + ch * 8;
#pragma unroll 4
          for (int it = 0; it < 16; ++it) {
            const int row = it * 8 + (lane >> 3);
            u32x4 v = *(const u32x4*)(wl + row * 128 + ch * 16);
            if (rope) {
              float x[8];
#pragma unroll
              for (int e = 0; e < 4; ++e) { x[2 * e] = bflo(v[e]); x[2 * e + 1] = bfhi(v[e]); }
              float ss = 0.f;
#pragma unroll
              for (int e = 0; e < 8; ++e) ss += x[e] * x[e];
              ss += __shfl_xor(ss, 1); ss += __shfl_xor(ss, 2); ss += __shfl_xor(ss, 4);
              const float rs = rsqrtf(ss * (1.0f / 64.0f) + EPS);
              const int tt = (rowb + row) & (SEQ - 1);
              const int pos = (ch >> 2) ? (tt & 63) : (tt >> 6);
              const float* ct = ROPE + pos * 16 + 8 * (ch & 1);
              const f32x4 c0 = *(const f32x4*)ct, c1 = *(const f32x4*)(ct + 4), s0 = *(const f32x4*)(ct + 1024), s1 = *(const f32x4*)(ct + 1028);
              const float sgn = ((ch >> 1) & 1) ? 1.0f : -1.0f;
              float o8[8];
#pragma unroll
              for (int e = 0; e < 8; ++e) {
                const float y = x[e] * rs * gg[e];
                const float pt = __shfl_xor(y, 2);
                const float cc = e < 4 ? c0[e & 3] : c1[e & 3], sn = e < 4 ? s0[e & 3] : s1[e & 3];
                o8[e] = y * cc + sgn * pt * sn;
              }
              v = (u32x4){pk_bf16(o8[0], o8[1]), pk_bf16(o8[2], o8[3]), pk_bf16(o8[4], o8[5]), pk_bf16(o8[6], o8[7])};
            }
            *(u32x4*)(ub + (size_t)row * UP) = v;
          }
        }
      }
      GSYNC();
      {
        PHASE_IDS
        const float* rpb = p.in[11] + (size_t)layer * 8 * 465;
        const int nu = G * 8 * 16;
        int t = vb;
        for (; t < nu; t += nb) attn_unit<0>(U, OA, Y, t >> 7, (t >> 4) & 7, t & 15, p.in[4], rpb, smem);
        for (; t < 2 * nu; t += nb) { const int r = t - nu; attn_unit<1>(U, OA, Y, r >> 7, (r >> 4) & 7, r & 15, p.in[4], rpb, smem); }
        for (; t < 3 * nu; t += nb) { const int r = t - 2 * nu; attn_unit<2>(U, OA, Y, r >> 7, (r >> 4) & 7, r & 15, p.in[4], rpb, smem); }
      }
      GSYNC();
      {
        PHASE_IDS
        const float* lp = p.in[7] + layer * 256;
        const float li = p.lambda_init[layer];
        const float s1 = wave_sum(lp[lane] * lp[64 + lane]), s2 = wave_sum(lp[128 + lane] * lp[192 + lane]);
        const float lam = __expf(s1) - __expf(s2) + li;
        const float* sg = p.in[8] + layer * 128 + (lane & 15) * 8;
        float sgv[8];
#pragma unroll
        for (int e = 0; e < 8; ++e) sgv[e] = sg[e] * (1.0f - li);
        const int hh = lane >> 4, dd = (lane & 15) * 8;
        for (int row0 = gw; row0 < TG; row0 += 4 * nw) {
          u32x4 a0[4], a1[4], gt[4];
#pragma unroll
          for (int r = 0; r < 4; ++r) {
            const int row = min(row0 + r * nw, TG - 1);
            a0[r] = *(const u32x4*)(OA + (size_t)row * DM + hh * 256 + dd);
            a1[r] = *(const u32x4*)(OA + (size_t)row * DM + hh * 256 + 128 + dd);
            gt[r] = *(const u32x4*)(U + (size_t)row * UP + C_AG + lane * 8);
          }
#pragma unroll
          for (int r = 0; r < 4; ++r) {
            const int row = row0 + r * nw;
            float dv[8];
            float ss = 0.f;
#pragma unroll
            for (int e = 0; e < 4; ++e) {
              dv[2 * e] = bflo(a0[r][e]) - lam * bflo(a1[r][e]);
              dv[2 * e + 1] = bfhi(a0[r][e]) - lam * bfhi(a1[r][e]);
              ss += dv[2 * e] * dv[2 * e] + dv[2 * e + 1] * dv[2 * e + 1];
            }
            ss += __shfl_xor(ss, 1); ss += __shfl_xor(ss, 2); ss += __shfl_xor(ss, 4); ss += __shfl_xor(ss, 8);
            const float rstd = rsqrtf(ss * (1.0f / 128.0f) + EPS);
            u32x4 ow;
#pragma unroll
            for (int e = 0; e < 4; ++e)
              ow[e] = pk_bf16(dv[2 * e] * rstd * sgv[2 * e] * siluf_(bflo(gt[r][e])), dv[2 * e + 1] * rstd * sgv[2 * e + 1] * siluf_(bfhi(gt[r][e])));
            if (row < TG) *(u32x4*)(Y + (size_t)row * 1536 + lane * 8) = ow;
          }
        }
      }
      GSYNC();
      for (int t = vb; t < (TG / 256) * 4; t += nb) {
        PHASE_IDS
        int mt, nt; tile_decode(t, 4, mt, nt);
        f32x16 acc[4][2]; zero_acc<2>(acc);
        for (int j = 0; j < 3; ++j) {
          gemm_acc<2, false>(acc, Y + (size_t)mt * 256 * 1536 + 512 * j, 1536, wbr + ((size_t)j * DM + nt * 256) * 512, 512, 512, smem);
          const float fl = (j < 2) ? 1.0f : 0.0f;
          const bf16_t *ga_, *gb_;
          { const int tid = opaque_tid(), lane = tid & 63, wave = tid >> 6;
            ga_ = GP + ((size_t)((mt * 12 + 4 * j + nt) * 8 + wave) * 16) * 512 + lane * 8;
            gb_ = (j < 2) ? ga_ + (size_t)4 * 8 * 16 * 512 : ga_; }
#pragma unroll
          for (int k = 0; k < 16; ++k) {
            const u32x4 wa = *(const u32x4*)(ga_ + k * 512), wb = *(const u32x4*)(gb_ + k * 512);
            f32x16& a = acc[k >> 2][(k >> 1) & 1];
            const int b8 = 8 * (k & 1);
#pragma unroll
            for (int q = 0; q < 8; ++q) {
              const float av = (q & 1) ? bfhi(wa[q >> 1]) : bflo(wa[q >> 1]), bv = (q & 1) ? bfhi(wb[q >> 1]) : bflo(wb[q >> 1]);
              const float ea = __expf(-av), eb = __expf(-bv) * fl;
              a[b8 + q] *= (1.0f + eb) * __builtin_amdgcn_rcpf(1.0f + ea);
            }
            if ((k & 3) == 3) asm volatile("" : "+v"(acc[k >> 2][0]), "+v"(acc[k >> 2][1]) : : "memory");
          }
        }
        __syncthreads();
        {
          char* wl = smem + wave * 16384;
          stage_tile_bf16(acc, wl, lane);
          const int ch = lane & 7;
          bf16_t* mb = M + (size_t)(mt * 256 + 128 * (wave >> 2)) * DM + nt * 256 + 64 * (wave & 3) + ch * 8;
#pragma unroll 4
          for (int it = 0; it < 16; ++it) {
            const int row = it * 8 + (lane >> 3);
            *(u32x4*)(mb + (size_t)row * DM) = *(const u32x4*)(wl + row * 128 + ch * 16);
          }
        }
      }
      GSYNC();
      for (int t = vb; t < (TG / 256) * 4; t += nb) {
        PHASE_IDS
        int mt, nt; tile_decode(t, 4, mt, nt);
        f32x16 acc[4][2]; zero_acc<2>(acc);
        gemm_acc<2, false>(acc, M + (size_t)mt * 256 * DM, DM, wout + (size_t)nt * 256 * DM, DM, DM, smem);
        __syncthreads();
        {
          char* wl = smem + wave * 16384;
          stage_tile_bf16(acc, wl, lane);
          float* PT = (float*)(smem + 131072 + 16);
          float* RT = PT + 1024;
          const int ch = lane & 7;
#pragma unroll 4
          for (int it = 0; it < 16; ++it) {
            const int row = it * 8 + (lane >> 3);
            const u32x4 v = *(const u32x4*)(wl + row * 128 + ch * 16);
            float ss = 0.f;
#pragma unroll
            for (int e = 0; e < 4; ++e) { const float a0 = bflo(v[e]), a1 = bfhi(v[e]); ss += a0 * a0 + a1 * a1; }
            ss += __shfl_xor(ss, 1); ss += __shfl_xor(ss, 2); ss += __shfl_xor(ss, 4);
            if (ch == 0) PT[(128 * (wave >> 2) + row) * 4 + (wave & 3)] = ss;
          }
          __syncthreads();
          float* xrow = XCH + ((size_t)mt * 256 + (tid & 255)) * 4;
          if (tid < 256) {
            const f32x4 q = *(const f32x4*)(PT + tid * 4);
            __hip_atomic_store(xrow + nt, (q[0] + q[1]) + (q[2] + q[3]), __ATOMIC_RELAXED, __HIP_MEMORY_SCOPE_AGENT);
          }
          asm volatile("s_waitcnt vmcnt(0)" ::: "memory");
          __syncthreads();
          if (tid == 0) {
            unsigned* c = XCNT + mt;
            __hip_atomic_fetch_add(c, 1u, __ATOMIC_RELAXED, __HIP_MEMORY_SCOPE_AGENT);
            const unsigned want = 4u * (unsigned)(gi * NL + layer + 1);
            unsigned sp = 0;
            while (__hip_atomic_load(c, __ATOMIC_RELAXED, __HIP_MEMORY_SCOPE_AGENT) < want) { __builtin_amdgcn_s_sleep(2); if (++sp > (1u << 22)) break; }
          }
          __syncthreads();
          if (tid < 256) {
            float s = 0.f;
#pragma unroll
            for (int e = 0; e < 4; ++e) s += __hip_atomic_load(xrow + e, __ATOMIC_RELAXED, __HIP_MEMORY_SCOPE_AGENT);
            RT[tid] = rsqrtf(s * (1.0f / DM) + EPS);
          }
          __syncthreads();
          const int rowb = mt * 256 + 128 * (wave >> 2), colb = nt * 256 + 64 * (wave & 3) + ch * 8;
          const float* gp = p.in[16] + layer * DM + colb;
          const f32x4 g0 = *(const f32x4*)gp, g1 = *(const f32x4*)(gp + 4);
#pragma unroll 4
          for (int it = 0; it < 16; ++it) {
            const int row = it * 8 + (lane >> 3);
            const u32x4 v = *(const u32x4*)(wl + row * 128 + ch * 16);
            const float rs = RT[128 * (wave >> 2) + row];
            const size_t off = (size_t)(rowb + row) * DM + colb;
            const f32x4 x0 = *(const f32x4*)(xres + off), x1v = *(const f32x4*)(xres + off + 4);
            f32x4 o0, o1;
            o0[0] = x0[0] + bflo(v[0]) * rs * g0[0]; o0[1] = x0[1] + bfhi(v[0]) * rs * g0[1]; o0[2] = x0[2] + bflo(v[1]) * rs * g0[2]; o0[3] = x0[3] + bfhi(v[1]) * rs * g0[3];
            o1[0] = x1v[0] + bflo(v[2]) * rs * g1[0]; o1[1] = x1v[1] + bfhi(v[2]) * rs * g1[1]; o1[2] = x1v[2] + bflo(v[3]) * rs * g1[2]; o1[3] = x1v[3] + bfhi(v[3]) * rs * g1[3];
            *(f32x4*)(xout + off) = o0; *(f32x4*)(xout + off + 4) = o1;
            *(u32x4*)(H + off) = (u32x4){pk_bf16(o0[0], o0[1]), pk_bf16(o0[2], o0[3]), pk_bf16(o1[0], o1[1]), pk_bf16(o1[2], o1[3])};
          }
        }
      }
      GSYNC();
      for (int t = vb; t < (TG / 256) * 8; t += nb) {
        PHASE_IDS
        int mt, nt; tile_decode(t, 8, mt, nt);
        unsigned pe[4][8];
        {
          f32x16 acc2[4][1]; zero_acc<1>(acc2);
          gemm_acc<1, true>(acc2, pin + (size_t)mt * 256 * DPLE, DPLE, wpe + (size_t)nt * 128 * DPLE, DPLE, DPLE, smem);
#pragma unroll
          for (int mi = 0; mi < 4; ++mi)
#pragma unroll
            for (int e = 0; e < 8; ++e) pe[mi][e] = pk_bf16(acc2[mi][0][2 * e], acc2[mi][0][2 * e + 1]);
        }
        f32x16 acc[4][1]; zero_acc<1>(acc);
        gemm_acc<1, false>(acc, H + (size_t)mt * 256 * DM, DM, wpg + (size_t)nt * 128 * DM, DM, DM, smem);
        __syncthreads();
        {
          char* wl = smem + wave * 16384;
          const int r32 = lane & 31, h = lane >> 5;
#pragma unroll
          for (int mi = 0; mi < 4; ++mi)
#pragma unroll
            for (int i = 0; i < 16; ++i) {
              const float pv = (i & 1) ? bfhi(pe[mi][i >> 1]) : bflo(pe[mi][i >> 1]);
              *(float*)(wl + (32 * mi + crow(i, h)) * 128 + r32 * 4) = sigmoidf_(acc[mi][0][i]) * pv;
            }
          const int ch = lane & 7;
          float* xb = xout + (size_t)(mt * 256 + 128 * (wave >> 2)) * DM + nt * 128 + 32 * (wave & 3) + ch * 4;
#pragma unroll 4
          for (int it = 0; it < 16; ++it) {
            const int row = it * 8 + (lane >> 3);
            const f32x4 d = *(const f32x4*)(wl + row * 128 + ch * 16);
            f32x4* xp = (f32x4*)(xb + (size_t)row * DM);
            *xp = *xp + d;
          }
        }
      }
      GSYNC();
    }
  }
}

extern "C" void kernel_launch(void* const* d_in, const int* in_sizes, int n_in, void* d_out, int out_size, void* d_ws, size_t ws_size, hipStream_t stream) {
  static int grid_blocks = 0;
  if (!grid_blocks) {
    int dev = 0, cus = 0, per_cu = 0;
    (void)hipGetDevice(&dev);
    (void)hipDeviceGetAttribute(&cus, hipDeviceAttributeMultiprocessorCount, dev);
    (void)hipFuncSetAttribute((const void*)fwd_kernel, hipFuncAttributeMaxDynamicSharedMemorySize, LDS_BYTES);
    (void)hipOccupancyMaxActiveBlocksPerMultiprocessor(&per_cu, fwd_kernel, 512, LDS_BYTES);
    if (per_cu < 1) per_cu = 1;
    if (per_cu > 1) per_cu = 1;
    grid_blocks = cus * per_cu;
    grid_blocks -= grid_blocks % 8;
    if (ws_size < WS_END) fprintf(stderr, "kernel_launch: workspace too small: %zu < %zu\n", ws_size, (size_t)WS_END);
  }
  Params p{};
  for (int i = 0; i < 19; ++i) p.in[i] = (const float*)d_in[i];
  p.out = (float*)d_out;
  p.ws = (unsigned char*)d_ws;
  const float li[4] = {0.2f, 0.35550906759096926f, 0.47071301834358413f, 0.5560582041556852f};
  for (int i = 0; i < 4; ++i) p.lambda_init[i] = li[i];
  (void)hipMemsetAsync((char*)d_ws + WS_BAR, 0, 16384, stream);
  void* args[] = {&p};
  hipError_t e = hipLaunchCooperativeKernel((void*)fwd_kernel, dim3(grid_blocks), dim3(512), args, LDS_BYTES, stream);
  if (e != hipSuccess) fprintf(stderr, "cooperative launch failed: %s (grid %d)\n", hipGetErrorString(e), grid_blocks);
}
```

```cpp
#include <hip/hip_runtime.h>
#include <hip/hip_cooperative_groups.h>
#include <stdint.h>
#include <stdio.h>
namespace cg = cooperative_groups;

typedef unsigned short bf16_t;
typedef short bf16x8 __attribute__((ext_vector_type(8)));
typedef short s16x4 __attribute__((ext_vector_type(4)));
typedef float f32x16 __attribute__((ext_vector_type(16)));
typedef float f32x4 __attribute__((ext_vector_type(4)));
typedef float f32x2 __attribute__((ext_vector_type(2)));
typedef __bf16 bf16x2_t __attribute__((ext_vector_type(2)));
typedef unsigned u32x4 __attribute__((ext_vector_type(4)));
typedef unsigned u32x2 __attribute__((ext_vector_type(2)));
#define DI __device__ __forceinline__
#define LDSAS __attribute__((address_space(3)))

constexpr int DM = 1024, SEQ = 4096, NL = 4, INW = 8448, DPLE = 256;
constexpr int UP = 5376;
constexpr int G = 8;
constexpr int NG = 24 / G;
constexpr int TG = G * SEQ;
constexpr float EPS = 1e-6f;
constexpr float LOG2E = 1.4426950408889634f;
constexpr int C_AQ = 0, C_AK = 512, C_AV = 1024, C_AG = 1536, C_BQ = 2048, C_BK = 2560, C_BV = 2688, C_BG = 2816,
              C_CQ = 3328, C_CK = 3840, C_CV = 4352, C_CG = 4864, C_MG = 5376;
constexpr size_t WS_BAR = 0;
constexpr size_t WS_KMAX = 16384;
constexpr size_t WS_ROPE = 32768;
constexpr size_t WS_WIN = 49152;
constexpr size_t WS_WBR = WS_WIN + (size_t)NL * INW * DM * 2;
constexpr size_t WS_WOUT = WS_WBR + (size_t)NL * 3 * DM * 512 * 2;
constexpr size_t WS_WPG = WS_WOUT + (size_t)NL * DM * DM * 2;
constexpr size_t WS_WPE = WS_WPG + (size_t)NL * DM * DM * 2;
constexpr size_t WS_U = WS_WPE + (size_t)NL * DM * DPLE * 2;
constexpr size_t WS_H = WS_U + (size_t)TG * UP * 2;
constexpr size_t WS_OA = WS_H + (size_t)TG * DM * 2;
constexpr size_t WS_Y = WS_OA + (size_t)TG * DM * 2;
constexpr size_t WS_M = WS_OA;
constexpr size_t WS_Z = WS_Y;
constexpr size_t WS_GP = WS_Y + (size_t)TG * 1536 * 2;
constexpr size_t WS_XCH = WS_GP + (size_t)TG * 3072 * 2;
constexpr size_t WS_PB = WS_XCH + (size_t)TG * 4 * 4;
constexpr size_t WS_PE = WS_PB + (size_t)TG * DPLE * 2;
constexpr size_t WS_END = WS_PE + (size_t)TG * DM * 2;

struct Params {
  const float* in[19];
  float* out;
  unsigned char* ws;
  float lambda_init[4];
};

DI unsigned pk_bf16(float lo, float hi) { f32x2 v = {lo, hi}; bf16x2_t b = __builtin_convertvector(v, bf16x2_t); return __builtin_bit_cast(unsigned, b); }
DI float bf2f(unsigned short b) { return __uint_as_float(((unsigned)b) << 16); }
DI float bflo(unsigned w) { return __uint_as_float(w << 16); }
DI float bfhi(unsigned w) { return __uint_as_float(w & 0xffff0000u); }
DI unsigned short f2bf(float f) { return (unsigned short)(pk_bf16(f, 0.f) & 0xffffu); }
DI float wave_sum(float v) {
#pragma unroll
  for (int o = 32; o >= 1; o >>= 1) v += __shfl_xor(v, o);
  return v;
}
DI float sigmoidf_(float x) { return 1.0f / (1.0f + __expf(-x)); }
DI float siluf_(float x) { return x / (1.0f + __expf(-x)); }
DI int opaque_tid() { int t = threadIdx.x; asm volatile("" : "+v"(t)); return t; }
DI int crow(int i, int h) { return (i & 3) + 8 * (i >> 2) + 4 * h; }
#define MFMA32(a, b, c) __builtin_amdgcn_mfma_f32_32x32x16_bf16((a), (b), (c), 0, 0, 0)

DI void dma16(const void* gsrc, char* lds_wave_base) {
  __builtin_amdgcn_global_load_lds((const unsigned*)gsrc, (LDSAS unsigned*)lds_wave_base, 16, 0, 0);
}
DI void dma_sync() { asm volatile("s_waitcnt vmcnt(0)" ::: "memory"); __syncthreads(); }
template <int NI, bool A_F32>
DI void gemm_acc(f32x16 (&acc)[4][NI], const void* Aptr, int lda, const bf16_t* Wt, int ldw, int K, char* smem) {
  constexpr int A_BYTES = 32768, STG = A_BYTES + 16384 * NI;
  const int tid = opaque_tid(), lane = tid & 63, wave = __builtin_amdgcn_readfirstlane(tid >> 6), wr = wave >> 2, wc = wave & 3, r32 = lane & 31, h = lane >> 5;
  const int drow = wave * 8 + (lane >> 3);
  const int dch = (lane & 7) ^ ((drow >> 1) & 7);
  const bf16_t* wsrc = Wt + (size_t)drow * ldw + dch * 8;
  const bf16_t* asrc = (const bf16_t*)Aptr + (size_t)drow * lda + dch * 8;
  const int lrow = tid >> 3, lch = tid & 7;
  u32x4 ra[4];
  auto gloadA = [&](int k0) {
#pragma unroll
    for (int j = 0; j < 4; ++j) {
      const float* pa = (const float*)Aptr + (size_t)(lrow + 64 * j) * lda + k0 + lch * 8;
      const f32x4 v0 = *(const f32x4*)pa, v1 = *(const f32x4*)(pa + 4);
      ra[j] = (u32x4){pk_bf16(v0[0], v0[1]), pk_bf16(v0[2], v0[3]), pk_bf16(v1[0], v1[1]), pk_bf16(v1[2], v1[3])};
    }
  };
  auto lstoreA = [&](int buf) {
    char* sa = smem + buf * STG;
#pragma unroll
    for (int j = 0; j < 4; ++j) {
      const int row = lrow + 64 * j;
      *(u32x4*)(sa + row * 128 + ((lch ^ ((row >> 1) & 7)) << 4)) = ra[j];
    }
  };
  auto issue = [&](int kt, int buf) {
    char* sa = smem + buf * STG + wave * 1024;
    char* sb = sa + A_BYTES;
    if (!A_F32) {
#pragma unroll
      for (int j = 0; j < 4; ++j) dma16(asrc + (size_t)(64 * j) * lda + kt * 64, sa + j * 8192);
    }
#pragma unroll
    for (int j = 0; j < 2 * NI; ++j) dma16(wsrc + (size_t)(64 * j) * ldw + kt * 64, sb + j * 8192);
  };
  const int nk = K >> 6;
  const int xsw = (r32 >> 1) & 7;
  const int a_base = (128 * wr + r32) * 128, b_base = A_BYTES + (32 * NI * wc + r32) * 128;
  __syncthreads();
  if (A_F32) { gloadA(0); lstoreA(0); }
  issue(0, 0);
  for (int kt = 0; kt < nk; ++kt) {
    dma_sync();
    if (kt + 1 < nk) { issue(kt + 1, (kt + 1) & 1); if (A_F32) gloadA((kt + 1) << 6); }
    const char* st = smem + (kt & 1) * STG;
#pragma unroll
    for (int s = 0; s < 4; ++s) {
      const int sw = ((2 * s + h) ^ xsw) << 4;
      bf16x8 af[4], bfr[NI];
#pragma unroll
      for (int mi = 0; mi < 4; ++mi) af[mi] = *(const bf16x8*)(st + a_base + sw + mi * 4096);
#pragma unroll
      for (int ni = 0; ni < NI; ++ni) bfr[ni] = *(const bf16x8*)(st + b_base + sw + ni * 4096);
#pragma unroll
      for (int mi = 0; mi < 4; ++mi)
#pragma unroll
        for (int ni = 0; ni < NI; ++ni) acc[mi][ni] = MFMA32(af[mi], bfr[ni], acc[mi][ni]);
    }
    if (A_F32) { if (kt + 1 < nk) lstoreA((kt + 1) & 1); }
  }
}
template <int NI>
DI void zero_acc(f32x16 (&acc)[4][NI]) {
#pragma unroll
  for (int a = 0; a < 4; ++a)
#pragma unroll
    for (int b = 0; b < NI; ++b)
#pragma unroll
      for (int i = 0; i < 16; ++i) acc[a][b][i] = 0.f;
}
#define EPI_LOOP(NI_) _Pragma("unroll") for (int mi = 0; mi < 4; ++mi) _Pragma("unroll") for (int ni = 0; ni < NI_; ++ni) _Pragma("unroll") for (int i = 0; i < 16; ++i)
#define EPI_OFF0(mt, nt, NI_, ld) ((unsigned)((mt) * 256 + 128 * (wave >> 2) + 4 * (lane >> 5)) * (unsigned)(ld) + (unsigned)((nt) * 128 * NI_ + 32 * NI_ * (wave & 3) + (lane & 31)))
#define EPI_OFF(off0, ld) ((off0) + (unsigned)((32 * mi + (i & 3) + 8 * (i >> 2)) * (ld) + 32 * ni))
#define EPI_FENCE
DI void stage_tile_bf16(const f32x16 (&acc)[4][2], char* wl, int lane, float sc = 1.0f) {
  const int r32 = lane & 31, h = lane >> 5;
#pragma unroll
  for (int mi = 0; mi < 4; ++mi)
#pragma unroll
    for (int ni = 0; ni < 2; ++ni)
#pragma unroll
      for (int i = 0; i < 16; ++i) *(bf16_t*)(wl + (32 * mi + crow(i, h)) * 128 + (32 * ni + r32) * 2) = f2bf(acc[mi][ni][i] * sc);
}
DI void tile_decode(int t, int ntn, int& mt, int& nt) {
  const int band = t / (8 * ntn), w = t - band * 8 * ntn;
  nt = w >> 3;
  mt = band * 8 + (w & 7);
}

template <int MODE>
DI void attn_unit(const bf16_t* __restrict__ U, bf16_t* __restrict__ OA, bf16_t* __restrict__ Y, int seq_l, int head, int qb,
                  const float* __restrict__ t5, const float* __restrict__ rpb, char* smem, const float* __restrict__ gq = nullptr, const float* __restrict__ gk = nullptr, float kmax2 = 0.f) {
  constexpr int DV = (MODE == 0) ? 128 : 64;
  constexpr int NDB = DV / 32;
  constexpr int NKB = (MODE == 2) ? 2 : 4;
  constexpr int KT = 32 * NKB;
  constexpr int NKC = (MODE == 2) ? 1 : NKB;
  constexpr int KBYTES = KT * 128, VBYTES = KT * DV * 2, STAGE = KBYTES + VBYTES;
  constexpr int NKJ = KBYTES / 8192;
  constexpr int NVJ = VBYTES / 8192;
  float* lut = (float*)(smem + 98304);
  const int tid = opaque_tid(), lane = tid & 63, wave = tid >> 6, r32 = lane & 31, h = lane >> 5;
  const size_t tok0 = (size_t)seq_l * SEQ;
  const int q0 = qb * 256;
  int qcol, kcol, vcol;
  if (MODE == 0) { qcol = C_AQ + head * 64; kcol = C_AK + head * 64; vcol = C_AV + (head >> 1) * 128; }
  else if (MODE == 1) { qcol = C_BQ + head * 64; kcol = C_BK + (head >> 2) * 64; vcol = C_BV + (head >> 2) * 64; }
  else { qcol = C_CQ + head * 64; kcol = C_CK + head * 64; vcol = C_CV + head * 64; }
  int kt0 = 0, NT = SEQ / KT;
  if (MODE == 2) { int b0 = 4 * qb - 4; b0 = b0 < 0 ? 0 : (b0 > 53 ? 53 : b0); kt0 = b0; NT = 11; }

  __syncthreads();
  if (MODE == 0) {
    for (int i = tid; i < 257; i += 512) {
      const int r = i - 128, n = r < 0 ? -r : r;
      int b;
      if (n < 8) b = n;
      else { b = 8 + (n >= 12) + (n >= 16) + (n >= 23) + (n >= 32) + (n >= 46) + (n >= 64) + (n >= 91); }
      if (r > 0) b += 16;
      lut[i] = t5[b * 8 + head] * LOG2E;
    }
  } else if (MODE == 2) {
    for (int i = tid; i < 465; i += 512) lut[i] = rpb[head * 465 + i] * LOG2E;
  }

  const int qi = (MODE == 2) ? ((4 * qb + 2 * (wave >> 2) + (r32 >> 4)) * 64 + 16 * (wave & 3) + (r32 & 15)) : (q0 + wave * 32 + r32);
  bf16x8 qf[4];
  {
    const bf16_t* qp = U + (tok0 + qi) * UP + qcol + 8 * h;
#pragma unroll
    for (int s = 0; s < 4; ++s) {
      qf[s] = __builtin_bit_cast(bf16x8, *(const u32x4*)(qp + 16 * s));
    }
  }

  const int wv = __builtin_amdgcn_readfirstlane(wave);
  int koff[NKJ], voff[NVJ];
#pragma unroll
  for (int j = 0; j < NKJ; ++j) {
    const int row = (wv + 8 * j) * 8 + (lane >> 3), ch = (lane & 7) ^ ((row >> 1) & 7);
    koff[j] = row * UP + kcol + ch * 8;
  }
#pragma unroll
  for (int j = 0; j < NVJ; ++j) {
    if (DV == 64) { const int row = (wv + 8 * j) * 8 + (lane >> 3), ch = (lane & 7) ^ (((row >> 1) & 1) << 2); voff[j] = row * UP + vcol + ch * 8; }
    else { const int row = (wv + 8 * j) * 4 + (lane >> 4), ch = (lane & 15) ^ ((row & 3) << 2); voff[j] = row * UP + vcol + ch * 8; }
  }
  auto issue = [&](int kt, int buf) {
    const bf16_t* base = U + (tok0 + (size_t)kt * KT) * UP;
    char* sk = smem + buf * STAGE + wv * 1024;
#pragma unroll
    for (int j = 0; j < NKJ; ++j) dma16(base + koff[j], sk + j * 8192);
#pragma unroll
    for (int j = 0; j < NVJ; ++j) dma16(base + voff[j], sk + KBYTES + j * 8192);
  };

  f32x16 o[NDB];
#pragma unroll
  for (int db = 0; db < NDB; ++db)
#pragma unroll
    for (int i = 0; i < 16; ++i) o[db][i] = 0.f;
  float m_run = -INFINITY, l_run = 0.f;
  bool fixed_ref = false;
  if (MODE == 0) {
    float qs = 0.f;
#pragma unroll
    for (int s = 0; s < 4; ++s) {
      const u32x4 w = __builtin_bit_cast(u32x4, qf[s]);
#pragma unroll
      for (int e = 0; e < 4; ++e) { const float a0 = bflo(w[e]), a1 = bfhi(w[e]); qs += a0 * a0 + a1 * a1; }
    }
    qs += __shfl_xor(qs, 32);
    float bm = fabsf(t5[(lane & 31) * 8 + head]);
#pragma unroll
    for (int o_ = 16; o_ >= 1; o_ >>= 1) bm = fmaxf(bm, __shfl_xor(bm, o_));
    const float bound = sqrtf(qs * kmax2) * 1.02f + bm * LOG2E;
    fixed_ref = !__any(!(bound < 40.0f));
    if (fixed_ref) m_run = bound;
  }
  if (MODE == 1) {
    float ga = fabsf(gq[lane]), gb = fabsf(gk[lane]);
#pragma unroll
    for (int o_ = 32; o_ >= 1; o_ >>= 1) { ga = fmaxf(ga, __shfl_xor(ga, o_)); gb = fmaxf(gb, __shfl_xor(gb, o_)); }
    const float bound = 8.0f * ga * gb * 1.05f * LOG2E;
    fixed_ref = bound < 40.0f;
    if (fixed_ref) m_run = bound;
  }

  const int q4 = (lane & 15) >> 2, p4 = lane & 3, blk = (lane >> 4) & 1;
  const int qr = 4 * qb + 2 * (wave >> 2) + (r32 >> 4), qc = 16 * (wave & 3) + (r32 & 15);
  int sr = qr - 4; sr = sr < 0 ? 0 : (sr > 56 ? 56 : sr);
  int sc = qc - 8; sc = sc < 0 ? 0 : (sc > 48 ? 48 : sc);
  int sr_lo = 4 * qb + 2 * (wv >> 2) - 4; sr_lo = sr_lo < 0 ? 0 : (sr_lo > 56 ? 56 : sr_lo);
  int sr_hi = 4 * qb + 2 * (wv >> 2) - 3; sr_hi = sr_hi < 0 ? 0 : (sr_hi > 56 ? 56 : sr_hi);
  const int kc0 = (MODE == 2) ? (((wv & 3) == 0) ? 0 : ((wv & 3) == 1) ? 8 : ((wv & 3) == 2) ? 24 : 32) : 0;

  f32x16 cvec;
  int cstate = (MODE == 1 && fixed_ref) ? 1 : 0;
#pragma unroll
  for (int i = 0; i < 16; ++i) cvec[i] = (MODE == 1 && fixed_ref) ? -m_run : 0.f;
  issue(kt0, 0);
  float bl_pos = 0.f, bl_neg = 0.f;
  for (int it = 0; it < NT; ++it) {
    const int kt = kt0 + it;
    dma_sync();
    if (it + 1 < NT) issue(kt + 1, (it + 1) & 1);
    if (MODE == 0 && it == 0) { bl_pos = lut[256]; bl_neg = lut[0]; }
    const char* sk = smem + (it & 1) * STAGE;
    const char* sv = sk + KBYTES;
    bool active = true;
    if (MODE == 2) active = (kt >= sr_lo) && (kt < sr_hi + 8);
    if (active) {
      bool uni = (MODE == 1);
      float bl = 0.f;
      if (MODE == 0) {
        const int rel_min = kt * KT - (q0 + 255), rel_max = kt * KT + (KT - 1) - q0;
        uni = (rel_min >= 128) || (rel_max <= -128);
        bl = (rel_min >= 128) ? bl_pos : bl_neg;
      }
      const float ubias = uni ? bl : 0.f;
      if (MODE == 0) {
        const int want = (fixed_ref && uni) ? ((bl == bl_pos) ? 2 : 1) : 0;
        if (want != cstate) {
          cstate = want;
#pragma unroll
          for (int i = 0; i < 16; ++i) cvec[i] = want ? (bl - m_run) : 0.f;
        }
      }
      f32x16 st[NKC];
      {
        bf16x8 kf[NKC][4];
        const int ksw = ((kc0 + r32) >> 1) & 7;
        const char* kp = sk + (kc0 + r32) * 128;
#pragma unroll
        for (int s = 0; s < 4; ++s) kf[0][s] = *(const bf16x8*)(kp + (((2 * s + h) ^ ksw) << 4));
        asm volatile("" ::: "memory");
#pragma unroll
        for (int kb = 0; kb < NKC; ++kb) {
          if (kb + 1 < NKC) {
#pragma unroll
            for (int s = 0; s < 4; ++s) kf[kb + 1][s] = *(const bf16x8*)(kp + (kb + 1) * 4096 + (((2 * s + h) ^ ksw) << 4));
            asm volatile("" ::: "memory");
          }
          if (MODE == 1 || MODE == 0) {
            st[kb] = MFMA32(kf[kb][0], qf[0], cvec);
#pragma unroll
            for (int s = 1; s < 4; ++s) st[kb] = MFMA32(kf[kb][s], qf[s], st[kb]);
          } else {
#pragma unroll
            for (int i = 0; i < 16; ++i) st[kb][i] = 0.f;
#pragma unroll
            for (int s = 0; s < 4; ++s) st[kb] = MFMA32(kf[kb][s], qf[s], st[kb]);
          }
        }
      }
      if (!uni) {
        if (MODE == 0) {
#pragma unroll
          for (int kb = 0; kb < NKC; ++kb)
#pragma unroll
            for (int i = 0; i < 16; ++i) {
              int rel = kt * KT + 32 * kb + crow(i, h) - qi;
              rel = rel < -128 ? -128 : (rel > 128 ? 128 : rel);
              st[kb][i] += lut[rel + 128];
            }
        } else if (MODE == 2) {
          const int ri = kt - qr + 7;
#pragma unroll
          for (int kb = 0; kb < NKC; ++kb)
#pragma unroll
            for (int i = 0; i < 16; ++i) {
              const int kc = kc0 + 32 * kb + crow(i, h);
              const bool ok = (kt >= sr) && (kt < sr + 8) && (kc >= sc) && (kc < sc + 16);
              int ci = kc - qc + 15; ci = ci < 0 ? 0 : (ci > 30 ? 30 : ci);
              const float bb = lut[ri * 31 + ci];
              st[kb][i] = ok ? (st[kb][i] + bb) : -INFINITY;
            }
        }
      }
      if (!((MODE == 1 || MODE == 0) && fixed_ref)) {
      float mx;
      {
        float mk[NKC];
#pragma unroll
        for (int kb = 0; kb < NKC; ++kb) {
          float m0 = fmaxf(fmaxf(st[kb][0], st[kb][1]), st[kb][2]);
#pragma unroll
          for (int i = 3; i < 15; i += 2) m0 = fmaxf(fmaxf(m0, st[kb][i]), st[kb][i + 1]);
          mk[kb] = fmaxf(m0, st[kb][15]);
        }
        mx = mk[0];
#pragma unroll
        for (int kb = 1; kb < NKC; ++kb) mx = fmaxf(mx, mk[kb]);
      }
      { const auto rr = __builtin_amdgcn_permlane32_swap(__float_as_uint(mx), __float_as_uint(mx), false, false);
        mx = fmaxf(__uint_as_float(rr[0]), __uint_as_float(rr[1])); }
      const float mt = mx + ubias;
      if (__any(mt > m_run)) {
        const float m_new = fmaxf(m_run, mt);
        const float alpha = (MODE == 2 && m_new == -INFINITY) ? 1.0f : __builtin_amdgcn_exp2f(m_run - m_new);
        m_run = m_new;
        l_run *= alpha;
#pragma unroll
        for (int db = 0; db < NDB; ++db) o[db] = o[db] * alpha;
      }
      }
      {
        float ps[NKC];
        if (cstate == 0) {
          const float cc = (MODE == 2 && m_run == -INFINITY) ? 0.f : (ubias - m_run);
#pragma unroll
          for (int kb = 0; kb < NKC; ++kb)
#pragma unroll
            for (int i = 0; i < 16; ++i) st[kb][i] += cc;
        }
#pragma unroll
        for (int kb = 0; kb < NKC; ++kb) {
#pragma unroll
          for (int i = 0; i < 16; ++i) st[kb][i] = __builtin_amdgcn_exp2f(st[kb][i]);
          const float s0 = (st[kb][0] + st[kb][1]) + (st[kb][2] + st[kb][3]), s1 = (st[kb][4] + st[kb][5]) + (st[kb][6] + st[kb][7]);
          const float s2 = (st[kb][8] + st[kb][9]) + (st[kb][10] + st[kb][11]), s3 = (st[kb][12] + st[kb][13]) + (st[kb][14] + st[kb][15]);
          ps[kb] = (s0 + s1) + (s2 + s3);
        }
        float pt = ps[0];
#pragma unroll
        for (int kb = 1; kb < NKC; ++kb) pt += ps[kb];
        l_run += pt;
      }
#pragma unroll
      for (int kb = 0; kb < NKC; ++kb)
#pragma unroll
        for (int s2 = 0; s2 < 2; ++s2) {
          u32x4 w;
#pragma unroll
          for (int e = 0; e < 4; ++e) w[e] = pk_bf16(st[kb][8 * s2 + 2 * e], st[kb][8 * s2 + 2 * e + 1]);
          const bf16x8 pf = __builtin_bit_cast(bf16x8, w);
#pragma unroll
          for (int db = 0; db < NDB; ++db) {
            s16x4 part[2];
#pragma unroll
            for (int hf = 0; hf < 2; ++hf) {
              const int row = kc0 + 32 * kb + 16 * s2 + 8 * hf + 4 * h + q4;
              const int chunk = 4 * db + 2 * blk + (p4 >> 1);
              int off;
              if (DV == 64) off = row * 128 + ((chunk ^ (((q4 >> 1) & 1) << 2)) << 4) + (p4 & 1) * 8;
              else off = row * 256 + ((chunk ^ (q4 << 2)) << 4) + (p4 & 1) * 8;
              part[hf] = __builtin_bit_cast(s16x4, __builtin_amdgcn_ds_read_tr16_b64_v4i16((LDSAS s16x4*)(sv + off)));
            }
            const bf16x8 vf = __builtin_shufflevector(part[0], part[1], 0, 1, 2, 3, 4, 5, 6, 7);
            o[db] = MFMA32(vf, pf, o[db]);
          }
        }
    }
  }
  const float l_tot = l_run + __shfl_xor(l_run, 32);
  const float inv = 1.0f / l_tot;
  const size_t tok = tok0 + qi;
#pragma unroll
  for (int db = 0; db < NDB; ++db)
#pragma unroll
    for (int g4 = 0; g4 < 4; ++g4) {
      const int d = 32 * db + 8 * g4 + 4 * h;
      float v0 = o[db][4 * g4] * inv, v1 = o[db][4 * g4 + 1] * inv, v2 = o[db][4 * g4 + 2] * inv, v3 = o[db][4 * g4 + 3] * inv;
      if (MODE == 0) {
        *(u32x2*)(OA + tok * DM + head * 128 + d) = (u32x2){pk_bf16(v0, v1), pk_bf16(v2, v3)};
      } else {
        const int gcol = (MODE == 1 ? C_BG : C_CG) + head * 64 + d;
        const u32x2 gw = *(const u32x2*)(U + tok * UP + gcol);
        v0 *= siluf_(bflo(gw[0])); v1 *= siluf_(bfhi(gw[0])); v2 *= siluf_(bflo(gw[1])); v3 *= siluf_(bfhi(gw[1]));
        *(u32x2*)(Y + tok * 1536 + (MODE == 1 ? 512 : 1024) + head * 64 + d) = (u32x2){pk_bf16(v0, v1), pk_bf16(v2, v3)};
      }
    }
}

DI void transpose_tile(const float* __restrict__ src, bf16_t* __restrict__ dst, int R, int C, int tr, int tcw, char* smem, int ldd = 0) {
  if (ldd == 0) ldd = R;
  float* tl = (float*)smem;
  const int tid = opaque_tid();
  const int r0 = tr * 64, c0 = tcw * 256;
  __syncthreads();
  float v[8][4];
#pragma unroll
  for (int i = 0; i < 8; ++i)
#pragma unroll
    for (int q = 0; q < 4; ++q) v[i][q] = src[(size_t)(r0 + i * 8 + (tid >> 6)) * C + c0 + (tid & 63) + 64 * q];
#pragma unroll
  for (int i = 0; i < 8; ++i)
#pragma unroll
    for (int q = 0; q < 4; ++q) tl[(i * 8 + (tid >> 6)) * 257 + (tid & 63) + 64 * q] = v[i][q];
  __syncthreads();
  const int n = tid >> 1, kb = (tid & 1) * 32;
  bf16_t* dp = dst + (size_t)(c0 + n) * ldd + r0 + kb;
#pragma unroll
  for (int j = 0; j < 4; ++j) {
    unsigned w[4];
#pragma unroll
    for (int e = 0; e < 4; ++e) w[e] = pk_bf16(tl[(kb + 8 * j + 2 * e) * 257 + n], tl[(kb + 8 * j + 2 * e + 1) * 257 + n]);
    *(u32x4*)(dp + 8 * j) = (u32x4){w[0], w[1], w[2], w[3]};
  }
}

namespace pg8 {
#define PG8_LAS __attribute__((address_space(3)))
constexpr int BM = 256, BK = 64, HALF = 128, HTB = HALF * BK * 2  , STAGE_BYTES = 8 * HTB, NXCD = 8, WGM = 8;

__host__ __device__ __forceinline__ int lds_byte(int r, int c) { const int st = (r >> 4) * 2 + (c >> 5), rr = r & 15, cc = c & 31, ob = rr * 64 + cc * 2; return st * 1024 + (ob ^ (((ob >> 9) & 1) << 5)); }
__host__ __device__ __forceinline__ void stage_rc(int b, int& R, int& C) { const int st = b / 1024, sb = b % 1024, swz = sb ^ (((sb >> 9) & 1) << 5); R = (st >> 1) * 16 + swz / 64; C = (st & 1) * 32 + (swz % 64) / 2; }
__host__ __device__ __forceinline__ int perm32(int rho) { const int n = rho >> 4, i = rho & 15; return 8 * (i >> 2) + 4 * n + (i & 3); }

struct Unit { int pm, pn; };
struct Gemm { const bf16_t* A; const bf16_t* Bt; int M, N, K; };

template <class Epi, class Sched, bool ALIGN_EPI = false, bool SP2 = false>
__device__ __forceinline__ void gemm_phase(PG8_LAS unsigned char* lds, const Gemm g, const Sched& S, const Epi& E) {
    const int tid = ::opaque_tid(), wid = __builtin_amdgcn_readfirstlane(tid >> 6), lane = tid & 63, wr = wid >> 2, wc = wid & 3, fr = lane & 15, fq = lane >> 4;
    const int K = g.K, nt = K / BK;
    unsigned voffA[2], voffB[2];
#pragma unroll
    for (int i = 0; i < 2; ++i) { int R, C; stage_rc(tid * 16 + i * 8192, R, C); const int Rb = Epi::PERM ? ((R & ~31) + perm32(R & 31)) : R;
        voffA[i] = (unsigned)(R * K + C) * 2u; voffB[i] = (unsigned)(Rb * K + C) * 2u; }
    const size_t kstep = (size_t)(BK * 2);
    const size_t hstep = (size_t)HALF * K * 2;
    const size_t tstep = 2 * hstep;
    const unsigned ldsw = (unsigned)wid * 1024u;
    const int aoff = lds_byte(wr * 64 + fr, fq * 8), boff = lds_byte(wc * 32 + fr, fq * 8);
#define PG8_SA(b, h) (((b) * 2 + (h)) * HTB)
#define PG8_SB(b, h) ((4 + (b) * 2 + (h)) * HTB)
#define PG8_STAGE(bufoff, gbase, voff) do { _Pragma("unroll") for (int _i = 0; _i < 2; ++_i) \
        __builtin_amdgcn_global_load_lds((const unsigned*)((const char*)(gbase) + (voff)[_i]), (PG8_LAS unsigned*)(lds + (bufoff) + ldsw + _i * 8192), 16, 0, 0); } while (0)
#define PG8_LDA(dst, b, h) do { _Pragma("unroll") for (int m = 0; m < 4; ++m) _Pragma("unroll") for (int k = 0; k < 2; ++k) dst[m][k] = *(const PG8_LAS bf16x8*)(lds + PG8_SA(b, h) + aoff + m * 2048 + k * 1024); } while (0)
#define PG8_LDB(dst, b, h) do { _Pragma("unroll") for (int n = 0; n < 2; ++n) _Pragma("unroll") for (int k = 0; k < 2; ++k) dst[n][k] = *(const PG8_LAS bf16x8*)(lds + PG8_SB(b, h) + boff + n * 2048 + k * 1024); } while (0)
#define PG8_MMA(ai, bj, At, Bt) do { __builtin_amdgcn_s_setprio(1); _Pragma("unroll") for (int m = 0; m < 4; ++m) _Pragma("unroll") for (int n = 0; n < 2; ++n) _Pragma("unroll") for (int k = 0; k < 2; ++k) \
        acc[ai][bj][m][n] = __builtin_amdgcn_mfma_f32_16x16x32_bf16(Bt[n][k], At[m][k], acc[ai][bj][m][n], 0, 0, 0); __builtin_amdgcn_s_setprio(0); } while (0)
#define PG8_WAIT_V(n) asm volatile("s_waitcnt vmcnt(" #n ")" ::: "memory")
#define PG8_WAIT_L(n) asm volatile("s_waitcnt lgkmcnt(" #n ")" ::: "memory")
#define PG8_BAR __builtin_amdgcn_s_barrier()
#define PG8_SCHED __builtin_amdgcn_sched_barrier(0)
    Unit cur, nxt; int ui = 0;
    if (!S.next(0, cur)) return;
    f32x4 acc[2][2][4][2];
#pragma unroll
    for (int a = 0; a < 2; ++a)
#pragma unroll
        for (int b = 0; b < 2; ++b)
#pragma unroll
            for (int m = 0; m < 4; ++m)
#pragma unroll
                for (int n = 0; n < 2; ++n) acc[a][b][m][n] = (f32x4){0.f, 0.f, 0.f, 0.f};
    bf16x8 At[4][2], B0[2][2], B1[2][2];
    const char* cA = (const char*)g.A + (size_t)cur.pm * tstep; const char* cB = (const char*)g.Bt + (size_t)cur.pn * tstep;
    S.a_ready(cur);
    if constexpr (SP2) {
        PG8_STAGE(PG8_SB(0, 0), cB, voffB); PG8_STAGE(PG8_SB(0, 1), cB + hstep, voffB); PG8_STAGE(PG8_SA(0, 0), cA, voffA); PG8_STAGE(PG8_SA(0, 1), cA + hstep, voffA);
        if (wr == 1) PG8_BAR;
        PG8_WAIT_V(2); PG8_BAR;
        PG8_STAGE(PG8_SB(1, 0), cB + kstep, voffB); PG8_STAGE(PG8_SA(1, 0), cA + kstep, voffA); PG8_STAGE(PG8_SB(1, 1), cB + hstep + kstep, voffB);
        PG8_WAIT_V(6); PG8_BAR;
    } else {
        PG8_STAGE(PG8_SB(0, 0), cB, voffB); PG8_STAGE(PG8_SA(0, 0), cA, voffA); PG8_STAGE(PG8_SB(0, 1), cB + hstep, voffB); PG8_STAGE(PG8_SA(0, 1), cA + hstep, voffA);
        if (wr == 1) PG8_BAR;
        PG8_WAIT_V(4); PG8_BAR;
        PG8_STAGE(PG8_SB(1, 0), cB + kstep, voffB); PG8_STAGE(PG8_SA(1, 0), cA + kstep, voffA); PG8_STAGE(PG8_SB(1, 1), cB + hstep + kstep, voffB);
        PG8_WAIT_V(6); PG8_BAR;
    }
    for (;;) {
        const bool has_next = S.next(ui + 1, nxt);
        const char* nA = has_next ? (const char*)g.A + (size_t)nxt.pm * tstep : cA; const char* nB = has_next ? (const char*)g.Bt + (size_t)nxt.pn * tstep : cB;
        for (int t = 0; t < nt; t += 2) {
            const bool last = (t == nt - 2);
            const char* a1 = cA + (size_t)(t + 1) * kstep;
            const char* a2 = last ? nA : cA + (size_t)(t + 2) * kstep; const char* b2 = last ? nB : cB + (size_t)(t + 2) * kstep;
            const char* a3 = a2 + kstep; const char* b3 = b2 + kstep;
            if (last && has_next) S.a_ready(nxt);
            if constexpr (SP2) {
            PG8_LDB(B0, 0, 0); PG8_LDB(B1, 0, 1); PG8_SCHED; PG8_LDA(At, 0, 0); PG8_STAGE(PG8_SA(1, 1), a1 + hstep, voffA);
            PG8_WAIT_V(8); PG8_WAIT_L(0); PG8_BAR; PG8_MMA(0, 0, At, B0); PG8_MMA(0, 1, At, B1); PG8_BAR; PG8_SCHED;
            PG8_LDA(At, 0, 1); PG8_STAGE(PG8_SB(0, 0), b2, voffB); PG8_STAGE(PG8_SB(0, 1), b2 + hstep, voffB); PG8_STAGE(PG8_SA(0, 0), a2, voffA);
            PG8_WAIT_V(8); PG8_WAIT_L(0); PG8_BAR; PG8_MMA(1, 0, At, B0); PG8_MMA(1, 1, At, B1); PG8_BAR; PG8_SCHED;
            PG8_LDB(B0, 1, 0); PG8_LDB(B1, 1, 1); PG8_SCHED; PG8_LDA(At, 1, 0); PG8_STAGE(PG8_SA(0, 1), a2 + hstep, voffA);
            PG8_WAIT_V(8); PG8_WAIT_L(0); PG8_BAR; PG8_MMA(0, 0, At, B0); PG8_MMA(0, 1, At, B1); PG8_BAR; PG8_SCHED;
            PG8_LDA(At, 1, 1); PG8_STAGE(PG8_SB(1, 0), b3, voffB); PG8_STAGE(PG8_SB(1, 1), b3 + hstep, voffB); PG8_STAGE(PG8_SA(1, 0), a3, voffA);
            PG8_WAIT_V(8); PG8_WAIT_L(0); PG8_BAR; PG8_MMA(1, 0, At, B0); PG8_MMA(1, 1, At, B1); PG8_BAR; PG8_SCHED;
            } else {
            PG8_LDB(B0, 0, 0); PG8_SCHED; PG8_LDA(At, 0, 0); PG8_STAGE(PG8_SA(1, 1), a1 + hstep, voffA);
            PG8_WAIT_L(8); PG8_BAR; PG8_WAIT_L(0); PG8_MMA(0, 0, At, B0); PG8_BAR; PG8_SCHED;
            PG8_LDB(B1, 0, 1); PG8_STAGE(PG8_SB(0, 0), b2, voffB);
            PG8_BAR; PG8_WAIT_L(0); PG8_MMA(0, 1, At, B1); PG8_BAR;
            PG8_LDA(At, 0, 1); PG8_STAGE(PG8_SA(0, 0), a2, voffA);
            PG8_BAR; PG8_WAIT_L(0); PG8_MMA(1, 0, At, B0); PG8_BAR; PG8_SCHED;
            PG8_STAGE(PG8_SB(0, 1), b2 + hstep, voffB);
            PG8_WAIT_V(6); PG8_BAR; PG8_MMA(1, 1, At, B1); PG8_BAR;
            PG8_LDB(B0, 1, 0); PG8_SCHED; PG8_LDA(At, 1, 0); PG8_STAGE(PG8_SA(0, 1), a2 + hstep, voffA);
            PG8_WAIT_L(8); PG8_BAR; PG8_WAIT_L(0); PG8_MMA(0, 0, At, B0); PG8_BAR; PG8_SCHED;
            PG8_LDB(B1, 1, 1); PG8_STAGE(PG8_SB(1, 0), b3, voffB);
            PG8_BAR; PG8_WAIT_L(0); PG8_MMA(0, 1, At, B1); PG8_BAR;
            PG8_LDA(At, 1, 1); PG8_STAGE(PG8_SA(1, 0), a3, voffA);
            PG8_BAR; PG8_WAIT_L(0); PG8_MMA(1, 0, At, B0); PG8_BAR; PG8_SCHED;
            PG8_STAGE(PG8_SB(1, 1), b3 + hstep, voffB);
            PG8_WAIT_V(6); PG8_BAR; PG8_MMA(1, 1, At, B1); PG8_BAR;
            }
            if constexpr (Epi::HAS_HOOK) { if ((((t + 2) & 7) == 0) && (t + 2 < nt)) E.hook(acc, cur, (t + 2) >> 3, wr, wc, fr, fq); }
        }
        if constexpr (ALIGN_EPI) { if (wr == 0) PG8_BAR; }
        if constexpr (!Epi::AFTER_DRAIN) { E(acc, cur, wr, wc, fr, fq); S.done(cur); }
        if (!has_next) break;
#pragma unroll
        for (int a = 0; a < 2; ++a)
#pragma unroll
            for (int b = 0; b < 2; ++b)
#pragma unroll
                for (int m = 0; m < 4; ++m)
#pragma unroll
                    for (int n = 0; n < 2; ++n) acc[a][b][m][n] = (f32x4){0.f, 0.f, 0.f, 0.f};
        cur = nxt; cA = nA; cB = nB; ++ui;
        if constexpr (ALIGN_EPI) { if (wr == 1) PG8_BAR; }
    }
    PG8_WAIT_V(0);
    if constexpr (!ALIGN_EPI) { if (wr == 0) PG8_BAR; }
    PG8_BAR;
    if constexpr (Epi::AFTER_DRAIN) { E.fused(acc, cur, wr, wc, fr, fq, lds, wid, lane); S.done(cur); }
#undef PG8_SA
#undef PG8_SB
#undef PG8_STAGE
#undef PG8_LDA
#undef PG8_LDB
#undef PG8_MMA
#undef PG8_WAIT_V
#undef PG8_WAIT_L
#undef PG8_BAR
#undef PG8_SCHED
}
}

struct P2Sched {
  int vb, nb, ntiles;
  __device__ __forceinline__ bool next(int i, pg8::Unit& u) const {
    const int t = vb + i * nb; if (t >= ntiles) return false;
    const int band = t / (8 * 33), w = t - band * 8 * 33;
    u.pn = w >> 3; u.pm = band * 8 + (w & 7); return true;
  }
  __device__ __forceinline__ void a_ready(const pg8::Unit&) const {}
  __device__ __forceinline__ void done(const pg8::Unit&) const {}
};
struct P2Epi {
  static constexpr bool PERM = true, AFTER_DRAIN = false, HAS_HOOK = false;
  const float* rope; const float* gq; const float* gk; char* smem;
  bf16_t* U; bf16_t* GP; unsigned* KMAXH; int kbase;
  __device__ __forceinline__ void operator()(const f32x4 (&acc)[2][2][4][2], const pg8::Unit& u, int wr, int wc, int fr, int fq) const {
    if (u.pn >= 21) {
      bf16_t* gb = GP + ((size_t)((u.pm * 12 + (u.pn - 21)) * 8 + (wr * 4 + wc)) * 16) * 512 + (fq * 16 + fr) * 8;
#pragma unroll
      for (int k = 0; k < 16; ++k) {
        const f32x4 v0 = acc[k >> 3][(k >> 2) & 1][k & 3][0], v1 = acc[k >> 3][(k >> 2) & 1][k & 3][1];
        *(u32x4*)(gb + k * 512) = (u32x4){pk_bf16(v0[0], v0[1]), pk_bf16(v0[2], v0[3]), pk_bf16(v1[0], v1[1]), pk_bf16(v1[2], v1[3])};
      }
      return;
    }
    if (u.pn >= 8 && u.pn <= 10) {
      float* XP = (float*)(smem + 131072 + 16 + 5120);
      const bool qtile = u.pn < 10;
#pragma unroll
      for (int ai = 0; ai < 2; ++ai)
#pragma unroll
        for (int m = 0; m < 4; ++m)
#pragma unroll
          for (int bj = 0; bj < 2; ++bj) {
            const f32x4 v0 = acc[ai][bj][m][0], v1 = acc[ai][bj][m][1];
            float ss = (v0[0] * v0[0] + v0[1] * v0[1]) + (v0[2] * v0[2] + v0[3] * v0[3]) + (v1[0] * v1[0] + v1[1] * v1[1]) + (v1[2] * v1[2] + v1[3] * v1[3]);
            ss += __shfl_xor(ss, 16); ss += __shfl_xor(ss, 32);
            if (fq == 0) XP[((128 * ai + 64 * wr + 16 * m + fr) * 2 + bj) * 4 + wc] = ss;
          }
      __syncthreads();
      const float* gsrc = (qtile ? gq : gk) + 32 * (wc & 1) + 8 * fq;
      const float qs = qtile ? (LOG2E * 0.125f) : 1.0f;
      const f32x4 ga = *(const f32x4*)gsrc * qs, gb4 = *(const f32x4*)(gsrc + 4) * qs;
      const float sgn = ((fq >> 1) & 1) ? 1.0f : -1.0f;
      const int rowl0 = 64 * wr + fr, colg = u.pn * 256 + wc * 32 + 8 * fq;
#pragma unroll
      for (int ai = 0; ai < 2; ++ai)
#pragma unroll
        for (int m = 0; m < 4; ++m) {
          const int rl = 128 * ai + 16 * m + rowl0;
          const int tt = (u.pm * 256 + rl) & (SEQ - 1);
          const int pos = (wc & 1) ? (tt & 63) : (tt >> 6);
          const float* ct = rope + pos * 16 + 8 * (fq & 1);
          const f32x4 c0 = *(const f32x4*)ct, c1 = *(const f32x4*)(ct + 4), s0 = *(const f32x4*)(ct + 1024), s1 = *(const f32x4*)(ct + 1028);
#pragma unroll
          for (int bj = 0; bj < 2; ++bj) {
            f32x4 v0 = acc[ai][bj][m][0], v1 = acc[ai][bj][m][1];
            if (qtile || bj == 0) {
              const float* xp = XP + (rl * 2 + bj) * 4 + (wc & 2);
              const float rs = rsqrtf((xp[0] + xp[1]) * (1.0f / 64.0f) + EPS);
              v0 = v0 * rs * ga; v1 = v1 * rs * gb4;
              f32x4 p0, p1;
#pragma unroll
              for (int e = 0; e < 4; ++e) { p0[e] = __shfl_xor(v0[e], 32); p1[e] = __shfl_xor(v1[e], 32); }
              v0 = v0 * c0 + sgn * (p0 * s0); v1 = v1 * c1 + sgn * (p1 * s1);
            }
            *(u32x4*)(U + (size_t)(u.pm * 256 + rl) * UP + colg + bj * 128) = (u32x4){pk_bf16(v0[0], v0[1]), pk_bf16(v0[2], v0[3]), pk_bf16(v1[0], v1[1]), pk_bf16(v1[2], v1[3])};
          }
        }
      __syncthreads();
      return;
    }
    const float sc = (u.pn == 0 || u.pn == 1 || u.pn == 13 || u.pn == 14) ? (LOG2E * 0.125f) : 1.0f;
    const bool akt = (u.pn == 2) || (u.pn == 3);
    const int row0 = u.pm * 256 + wr * 64 + fr, col0 = u.pn * 256 + wc * 32 + 8 * fq;
    float kmx0 = 0.f, kmx1 = 0.f;
#pragma unroll
    for (int ai = 0; ai < 2; ++ai)
#pragma unroll
      for (int m = 0; m < 4; ++m) {
        bf16_t* rowp = U + (size_t)(row0 + ai * 128 + m * 16) * UP + col0;
#pragma unroll
        for (int bj = 0; bj < 2; ++bj) {
          const f32x4 v0 = acc[ai][bj][m][0] * sc, v1 = acc[ai][bj][m][1] * sc;
          const u32x4 w = (u32x4){pk_bf16(v0[0], v0[1]), pk_bf16(v0[2], v0[3]), pk_bf16(v1[0], v1[1]), pk_bf16(v1[2], v1[3])};
          *(u32x4*)(rowp + bj * 128) = w;
          if (akt) {
            float ss = 0.f;
#pragma unroll
            for (int e = 0; e < 4; ++e) { const float a0 = bflo(w[e]), a1 = bfhi(w[e]); ss += a0 * a0 + a1 * a1; }
            ss += __shfl_xor(ss, 16); ss += __shfl_xor(ss, 32);
            if (bj == 0) kmx0 = fmaxf(kmx0, ss); else kmx1 = fmaxf(kmx1, ss);
          }
        }
      }
    if (akt) {
#pragma unroll
      for (int o_ = 1; o_ <= 8; o_ <<= 1) { kmx0 = fmaxf(kmx0, __shfl_xor(kmx0, o_)); kmx1 = fmaxf(kmx1, __shfl_xor(kmx1, o_)); }
      if (fr == 0 && fq == 0) {
        unsigned* kp = KMAXH + kbase + (u.pm >> 4) * 16 + ((u.pn - 2) * 4 + (wc >> 1)) * 2 + (wc & 1);
        atomicMax(kp, __float_as_uint(kmx0));
        atomicMax(kp + 4, __float_as_uint(kmx1));
      }
    }
  }
};

DI void gemm_accT(f32x4 (&acc)[2][2][4][2], const bf16_t* Aptr, int lda, const bf16_t* Wt, int ldw, int K, char* smem) {
  constexpr int A_BYTES = 32768, STG = 65536;
  const int tid = opaque_tid(), lane = tid & 63, wave = __builtin_amdgcn_readfirstlane(tid >> 6), wr = wave >> 2, wc = wave & 3, r16 = lane & 15, q = lane >> 4;
  const int drow = wave * 8 + (lane >> 3);
  const int dch = (lane & 7) ^ ((drow >> 1) & 7);
  const bf16_t* wsrc = Wt + (size_t)drow * ldw + dch * 8;
  const bf16_t* asrc = Aptr + (size_t)drow * lda + dch * 8;
  auto issue = [&](int kt, int buf) {
    char* sa = smem + buf * STG + wave * 1024;
    char* sb = sa + A_BYTES;
#pragma unroll
    for (int j = 0; j < 4; ++j) dma16(asrc + (size_t)(64 * j) * lda + kt * 64, sa + j * 8192);
#pragma unroll
    for (int j = 0; j < 4; ++j) dma16(wsrc + (size_t)(64 * j) * ldw + kt * 64, sb + j * 8192);
  };
  const int nk = K >> 6;
  const int xa = (r16 >> 1) & 7;
  const int a_base = (64 * wr + r16) * 128;
  const int wrow0 = 32 * wc + 8 * (r16 >> 2) + (r16 & 3);
  __syncthreads();
  issue(0, 0);
  for (int kt = 0; kt < nk; ++kt) {
    dma_sync();
    if (kt + 1 < nk) issue(kt + 1, (kt + 1) & 1);
    const char* st = smem + (kt & 1) * STG;
#pragma unroll
    for (int ks = 0; ks < 2; ++ks) {
      const int chunk = 4 * ks + q;
      bf16x8 afr[2][4], wfr[2][2];
#pragma unroll
      for (int ai = 0; ai < 2; ++ai)
#pragma unroll
        for (int m = 0; m < 4; ++m) afr[ai][m] = *(const bf16x8*)(st + a_base + (128 * ai + 16 * m) * 128 + ((chunk ^ xa) << 4));
#pragma unroll
      for (int bj = 0; bj < 2; ++bj)
#pragma unroll
        for (int n = 0; n < 2; ++n) {
          const int wrow = wrow0 + 128 * bj + 4 * n;
          wfr[bj][n] = *(const bf16x8*)(st + A_BYTES + wrow * 128 + ((chunk ^ ((wrow >> 1) & 7)) << 4));
        }
#pragma unroll
      for (int ai = 0; ai < 2; ++ai)
#pragma unroll
        for (int m = 0; m < 4; ++m)
#pragma unroll
          for (int bj = 0; bj < 2; ++bj)
#pragma unroll
            for (int n = 0; n < 2; ++n) acc[ai][bj][m][n] = __builtin_amdgcn_mfma_f32_16x16x32_bf16(wfr[bj][n], afr[ai][m], acc[ai][bj][m][n], 0, 0, 0);
    }
  }
}

struct P7Sched {
  int vb, nb, ntiles;
  __device__ __forceinline__ bool next(int i, pg8::Unit& u) const {
    const int t = vb + i * nb; if (t >= ntiles) return false;
    const int band = t >> 5, w = t & 31; u.pn = w >> 3; u.pm = band * 8 + (w & 7); return true;
  }
  __device__ __forceinline__ void a_ready(const pg8::Unit&) const {}
  __device__ __forceinline__ void done(const pg8::Unit&) const {}
};
struct P7Epi {
  static constexpr bool PERM = true, AFTER_DRAIN = false, HAS_HOOK = false;
  const float* xres; float* xout; bf16_t* H; const float* g; float* XCH; unsigned* XCNT; unsigned want; char* smem;
  __device__ __forceinline__ void operator()(const f32x4 (&acc)[2][2][4][2], const pg8::Unit& u, int wr, int wc, int fr, int fq) const {
    float* PT = (float*)(smem + 131072 + 16);
    float* RT = PT + 1024;
    const int tid = (wr * 4 + wc) * 64 + fq * 16 + fr;
    u32x4 zw[2][4][2];
#pragma unroll
    for (int ai = 0; ai < 2; ++ai)
#pragma unroll
      for (int m = 0; m < 4; ++m) {
        float ss = 0.f;
#pragma unroll
        for (int bj = 0; bj < 2; ++bj) {
          const f32x4 v0 = acc[ai][bj][m][0], v1 = acc[ai][bj][m][1];
          const u32x4 w = (u32x4){pk_bf16(v0[0], v0[1]), pk_bf16(v0[2], v0[3]), pk_bf16(v1[0], v1[1]), pk_bf16(v1[2], v1[3])};
          zw[ai][m][bj] = w;
#pragma unroll
          for (int e = 0; e < 4; ++e) { const float a0 = bflo(w[e]), a1 = bfhi(w[e]); ss += a0 * a0 + a1 * a1; }
        }
        ss += __shfl_xor(ss, 16); ss += __shfl_xor(ss, 32);
        if (fq == 0) PT[(128 * ai + 64 * wr + 16 * m + fr) * 4 + wc] = ss;
      }
    __syncthreads();
    float* xrow = XCH + ((size_t)u.pm * 256 + (tid & 255)) * 4;
    if (tid < 256) {
      const f32x4 q = *(const f32x4*)(PT + tid * 4);
      __hip_atomic_store(xrow + u.pn, (q[0] + q[1]) + (q[2] + q[3]), __ATOMIC_RELAXED, __HIP_MEMORY_SCOPE_AGENT);
    }
    asm volatile("s_waitcnt vmcnt(0)" ::: "memory");
    __syncthreads();
    if (tid == 0) {
      unsigned* c = XCNT + u.pm;
      __hip_atomic_fetch_add(c, 1u, __ATOMIC_RELAXED, __HIP_MEMORY_SCOPE_AGENT);
      unsigned sp = 0;
      while (__hip_atomic_load(c, __ATOMIC_RELAXED, __HIP_MEMORY_SCOPE_AGENT) < want) { __builtin_amdgcn_s_sleep(2); if (++sp > (1u << 22)) break; }
    }
    __syncthreads();
    if (tid < 256) {
      float s = 0.f;
#pragma unroll
      for (int e = 0; e < 4; ++e) s += __hip_atomic_load(xrow + e, __ATOMIC_RELAXED, __HIP_MEMORY_SCOPE_AGENT);
      RT[tid] = rsqrtf(s * (1.0f / DM) + EPS);
    }
    __syncthreads();
    const int col0 = u.pn * 256 + wc * 32 + 8 * fq;
#pragma unroll
    for (int bj = 0; bj < 2; ++bj) {
      const f32x4 g0 = *(const f32x4*)(g + col0 + 128 * bj), g1 = *(const f32x4*)(g + col0 + 128 * bj + 4);
#pragma unroll
      for (int ai = 0; ai < 2; ++ai)
#pragma unroll
        for (int m = 0; m < 4; ++m) {
          const int rl = 128 * ai + 64 * wr + 16 * m + fr;
          const float rs = RT[rl];
          const size_t off = (size_t)(u.pm * 256 + rl) * DM + col0 + 128 * bj;
          const u32x4 v = zw[ai][m][bj];
          const f32x4 x0 = *(const f32x4*)(xres + off), x1v = *(const f32x4*)(xres + off + 4);
          f32x4 o0, o1;
          o0[0] = x0[0] + bflo(v[0]) * rs * g0[0]; o0[1] = x0[1] + bfhi(v[0]) * rs * g0[1]; o0[2] = x0[2] + bflo(v[1]) * rs * g0[2]; o0[3] = x0[3] + bfhi(v[1]) * rs * g0[3];
          o1[0] = x1v[0] + bflo(v[2]) * rs * g1[0]; o1[1] = x1v[1] + bfhi(v[2]) * rs * g1[1]; o1[2] = x1v[2] + bflo(v[3]) * rs * g1[2]; o1[3] = x1v[3] + bfhi(v[3]) * rs * g1[3];
          *(f32x4*)(xout + off) = o0; *(f32x4*)(xout + off + 4) = o1;
          *(u32x4*)(H + off) = (u32x4){pk_bf16(o0[0], o0[1]), pk_bf16(o0[2], o0[3]), pk_bf16(o1[0], o1[1]), pk_bf16(o1[2], o1[3])};
        }
    }
    __syncthreads();
  }
};

struct P9Sched {
  int vb, nb, ntiles;
  __device__ __forceinline__ bool next(int i, pg8::Unit& u) const {
    const int t = vb + i * nb; if (t >= ntiles) return false;
    const int band = t >> 5, w = t & 31; u.pn = w >> 3; u.pm = band * 8 + (w & 7); return true;
  }
  __device__ __forceinline__ void a_ready(const pg8::Unit&) const {}
  __device__ __forceinline__ void done(const pg8::Unit&) const {}
};
struct PEPSched {
  int hv, hb, ntiles;
  __device__ __forceinline__ bool next(int i, pg8::Unit& u) const {
    if (hv < 0) return false;
    const int t = hv + i * hb; if (t >= ntiles) return false;
    const int band = t >> 5, w = t & 31; u.pn = w >> 3; u.pm = band * 8 + (w & 7); return true;
  }
  __device__ __forceinline__ void a_ready(const pg8::Unit&) const {}
  __device__ __forceinline__ void done(const pg8::Unit&) const {}
};
struct PEPEpi {
  static constexpr bool PERM = true, AFTER_DRAIN = false, HAS_HOOK = false;
  bf16_t* PE;
  __device__ __forceinline__ void operator()(const f32x4 (&acc)[2][2][4][2], const pg8::Unit& u, int wr, int wc, int fr, int fq) const {
    bf16_t* base = PE + (size_t)(u.pm * 256 + wr * 64 + fr) * DM + u.pn * 256 + wc * 32 + 8 * fq;
#pragma unroll
    for (int ai = 0; ai < 2; ++ai)
#pragma unroll
      for (int m = 0; m < 4; ++m)
#pragma unroll
        for (int bj = 0; bj < 2; ++bj) {
          const f32x4 v0 = acc[ai][bj][m][0], v1 = acc[ai][bj][m][1];
          *(u32x4*)(base + (size_t)(ai * 128 + m * 16) * DM + bj * 128) = (u32x4){pk_bf16(v0[0], v0[1]), pk_bf16(v0[2], v0[3]), pk_bf16(v1[0], v1[1]), pk_bf16(v1[2], v1[3])};
        }
  }
};
struct P9EpiX {
  static constexpr bool PERM = true, AFTER_DRAIN = false, HAS_HOOK = false;
  const bf16_t* PE; float* xout;
  __device__ __forceinline__ void operator()(const f32x4 (&acc)[2][2][4][2], const pg8::Unit& u, int wr, int wc, int fr, int fq) const {
    const unsigned base = (unsigned)(u.pm * 256 + wr * 64 + fr) * DM + u.pn * 256 + wc * 32 + 8 * fq;
    u32x4 zw[2][4][2];
#pragma unroll
    for (int ai = 0; ai < 2; ++ai)
#pragma unroll
      for (int m = 0; m < 4; ++m)
#pragma unroll
        for (int bj = 0; bj < 2; ++bj) {
          f32x4 v0 = acc[ai][bj][m][0], v1 = acc[ai][bj][m][1];
#pragma unroll
          for (int e = 0; e < 4; ++e) { v0[e] = __builtin_amdgcn_rcpf(1.0f + __expf(-v0[e])); v1[e] = __builtin_amdgcn_rcpf(1.0f + __expf(-v1[e])); }
          zw[ai][m][bj] = (u32x4){pk_bf16(v0[0], v0[1]), pk_bf16(v0[2], v0[3]), pk_bf16(v1[0], v1[1]), pk_bf16(v1[2], v1[3])};
        }
#pragma unroll
    for (int ai = 0; ai < 2; ++ai)
#pragma unroll
      for (int m = 0; m < 4; ++m)
#pragma unroll
        for (int bj = 0; bj < 2; ++bj) {
          const unsigned off = base + (unsigned)((ai * 128 + m * 16) * DM + bj * 128);
          const u32x4 g = zw[ai][m][bj];
          const u32x4 pw = *(const u32x4*)(PE + off);
          f32x4 x0 = *(const f32x4*)(xout + off), x1v = *(const f32x4*)(xout + off + 4);
          x0[0] += bflo(g[0]) * bflo(pw[0]); x0[1] += bfhi(g[0]) * bfhi(pw[0]); x0[2] += bflo(g[1]) * bflo(pw[1]); x0[3] += bfhi(g[1]) * bfhi(pw[1]);
          x1v[0] += bflo(g[2]) * bflo(pw[2]); x1v[1] += bfhi(g[2]) * bfhi(pw[2]); x1v[2] += bflo(g[3]) * bflo(pw[3]); x1v[3] += bfhi(g[3]) * bfhi(pw[3]);
          *(f32x4*)(xout + off) = x0; *(f32x4*)(xout + off + 4) = x1v;
          asm volatile("" ::: "memory");
        }
  }
};

struct P6Epi {
  static constexpr bool PERM = true, AFTER_DRAIN = false, HAS_HOOK = true;
  const bf16_t* GP; bf16_t* M;
  __device__ __forceinline__ void rescale(f32x4 (&acc)[2][2][4][2], const pg8::Unit& u, int j, bool last, int wr, int wc, int fr, int fq) const {
    const unsigned ga = (unsigned)(((u.pm * 12 + 4 * j + u.pn) * 8 + (wr * 4 + wc)) * 16) * 512u + (unsigned)(fq * 16 + fr) * 8u;
    const unsigned gb = last ? ga : ga + 4u * 8u * 16u * 512u;
    const float fl = last ? 0.0f : 1.0f;
#pragma unroll
    for (int k = 0; k < 16; ++k) {
      const u32x4 wa = *(const u32x4*)(GP + ga + k * 512), wb = *(const u32x4*)(GP + gb + k * 512);
#pragma unroll
      for (int q = 0; q < 8; ++q) {
        const float av = (q & 1) ? bfhi(wa[q >> 1]) : bflo(wa[q >> 1]), bv = (q & 1) ? bfhi(wb[q >> 1]) : bflo(wb[q >> 1]);
        const float ea = __expf(-av), eb = __expf(-bv) * fl;
        acc[k >> 3][(k >> 2) & 1][k & 3][q >> 2][q & 3] *= (1.0f + eb) * __builtin_amdgcn_rcpf(1.0f + ea);
      }
      asm volatile("" ::: "memory");
    }
  }
  __device__ __forceinline__ void hook(f32x4 (&acc)[2][2][4][2], const pg8::Unit& u, int seam, int wr, int wc, int fr, int fq) const { rescale(acc, u, seam - 1, false, wr, wc, fr, fq); }
  __device__ __forceinline__ void operator()(f32x4 (&acc)[2][2][4][2], const pg8::Unit& u, int wr, int wc, int fr, int fq) const {
    rescale(acc, u, 2, true, wr, wc, fr, fq);
    bf16_t* mb = M + (size_t)(u.pm * 256 + 64 * wr + fr) * DM + u.pn * 256 + 32 * wc + 8 * fq;
#pragma unroll
    for (int ai = 0; ai < 2; ++ai)
#pragma unroll
      for (int m = 0; m < 4; ++m)
#pragma unroll
        for (int bj = 0; bj < 2; ++bj) {
          const f32x4 v0 = acc[ai][bj][m][0], v1 = acc[ai][bj][m][1];
          *(u32x4*)(mb + (size_t)(128 * ai + 16 * m) * DM + 128 * bj) = (u32x4){pk_bf16(v0[0], v0[1]), pk_bf16(v0[2], v0[3]), pk_bf16(v1[0], v1[1]), pk_bf16(v1[2], v1[3])};
        }
  }
};

#define XB_TMO      128
#define XB_XCNT(j)  (256  + 64 * (j))
#define XB_XSUB(j)  (1280 + 64 * (j))
#define XB_XGEN(j)  (2304 + 64 * (j))
#define XB_TOP      3328
#define XB_TOPGEN   3392
#define XCD_BAR_WORDS 3456
#define XB_SPIN_CAP (1u << 20)
DI unsigned xb_ld(unsigned* p) { return __hip_atomic_load(p, __ATOMIC_RELAXED, __HIP_MEMORY_SCOPE_AGENT); }
DI unsigned xb_add(unsigned* p, unsigned v) { return __hip_atomic_fetch_add(p, v, __ATOMIC_RELAXED, __HIP_MEMORY_SCOPE_AGENT); }
DI unsigned xb_xcc_id() { return (unsigned)__builtin_amdgcn_s_getreg((3 << 11) | 20) & 0xFu; }
#define XB_SPIN(cond, bar) do { unsigned _sp = 0; while (cond) { __builtin_amdgcn_s_sleep(1); \
    if ((++_sp & 255u) == 0u) { if (xb_ld(&(bar)[XB_TMO])) break; if (_sp > XB_SPIN_CAP) { atomicAdd(&(bar)[XB_TMO], 1u); break; } } } } while (0)
struct XcdBarrier { unsigned* bar; unsigned x; volatile LDSAS unsigned* st; };
DI XcdBarrier xcd_barrier_post(unsigned* bar, volatile LDSAS unsigned* st) {
  XcdBarrier b; b.bar = bar; b.x = xb_xcc_id(); b.st = st;
  if (threadIdx.x == 0) (void)xb_add(&bar[XB_XCNT(b.x)], 1u);
  return b;
}
DI void xcd_barrier_complete(unsigned* bar, unsigned x, unsigned& nloc, unsigned& nx) {
  const unsigned Gn = gridDim.x * gridDim.y * gridDim.z;
  unsigned sum, cnt, mine, sp = 0u;
  for (;;) {
    sum = 0u; cnt = 0u; mine = 0u;
#pragma unroll
    for (unsigned j = 0; j < 16; ++j) { const unsigned c = xb_ld(&bar[XB_XCNT(j)]); sum += c; cnt += (c > 0u) ? 1u : 0u; mine = (j == x) ? c : mine; }
    if (sum == Gn) break;
    __builtin_amdgcn_s_sleep(1);
    if ((++sp & 255u) == 0u) { if (xb_ld(&bar[XB_TMO])) break; if (sp > XB_SPIN_CAP) { atomicAdd(&bar[XB_TMO], 1u); break; } }
  }
  nloc = mine > 0u ? mine : 1u; nx = cnt > 0u ? cnt : 1u;
}
DI void xcd_barrier(const XcdBarrier& b) {
  asm volatile("s_waitcnt vmcnt(0)" ::: "memory");
  __syncthreads();
  if (threadIdx.x == 0) {
    unsigned* bar = b.bar;
    __builtin_amdgcn_s_waitcnt(0);
    unsigned nloc = b.st[0], nx = b.st[1];
    if (nloc == 0u) { xcd_barrier_complete(bar, b.x, nloc, nx); b.st[0] = nloc; b.st[1] = nx; }
    const unsigned old = xb_add(&bar[XB_XSUB(b.x)], 1u);
    const unsigned gen = old / nloc;
    if (old + 1u == (gen + 1u) * nloc) {
      __builtin_amdgcn_fence(__ATOMIC_RELEASE, "agent");
      asm volatile("s_waitcnt vmcnt(0)" ::: "memory");
      const unsigned og = xb_add(&bar[XB_TOP], 1u);
      const unsigned tg = og / nx;
      if (og + 1u == (tg + 1u) * nx) xb_add(&bar[XB_TOPGEN], 1u);
      else XB_SPIN(xb_ld(&bar[XB_TOPGEN]) == tg, bar);
      __builtin_amdgcn_fence(__ATOMIC_ACQUIRE, "agent");
      xb_add(&bar[XB_XGEN(b.x)], 1u);
      asm volatile("s_waitcnt vmcnt(0)" ::: "memory");
    } else {
      XB_SPIN(xb_ld(&bar[XB_XGEN(b.x)]) == gen, bar);
      __builtin_amdgcn_fence(__ATOMIC_ACQUIRE, "agent");
      asm volatile("s_waitcnt vmcnt(0)" ::: "memory");
    }
  }
  __syncthreads();
}

constexpr int LDS_BYTES = 131072 + 16 + 5120 + 8192;
__global__ void __launch_bounds__(512, 2) fwd_kernel(Params p) {
  extern __shared__ __attribute__((aligned(16))) char smem[];
  cg::grid_group grid = cg::this_grid();
  const int nb = gridDim.x, bid = blockIdx.x;
  volatile LDSAS unsigned* xb_st = (volatile LDSAS unsigned*)(smem + 131072);
  if (threadIdx.x == 0) { xb_st[0] = 0u; xb_st[1] = 0u; xb_st[2] = 0u; xb_st[3] = 0u; }
  __syncthreads();
  const XcdBarrier xb = xcd_barrier_post((unsigned*)(p.ws + WS_BAR), xb_st);
#define GSYNC() xcd_barrier(xb)
  const int vb = (bid & 7) * (nb >> 3) + (bid >> 3);
  const int nw = nb * 8;
#define PHASE_IDS const int tid = opaque_tid(), lane = tid & 63, wave = tid >> 6, gw = vb * 8 + wave; (void)lane; (void)gw;
  unsigned char* ws = p.ws;
  bf16_t* WIN = (bf16_t*)(ws + WS_WIN);
  bf16_t* WBR = (bf16_t*)(ws + WS_WBR);
  bf16_t* WOUT = (bf16_t*)(ws + WS_WOUT);
  bf16_t* WPG = (bf16_t*)(ws + WS_WPG);
  bf16_t* WPE = (bf16_t*)(ws + WS_WPE);
  float* ROPE = (float*)(ws + WS_ROPE);
  bf16_t* U = (bf16_t*)(ws + WS_U);
  bf16_t* H = (bf16_t*)(ws + WS_H);
  bf16_t* OA = (bf16_t*)(ws + WS_OA);
  bf16_t* Y = (bf16_t*)(ws + WS_Y);
  bf16_t* M = (bf16_t*)(ws + WS_M);
  bf16_t* Zb = (bf16_t*)(ws + WS_Z);
  bf16_t* GP = (bf16_t*)(ws + WS_GP);
  float* XCH = (float*)(ws + WS_XCH);
  bf16_t* PB = (bf16_t*)(ws + WS_PB);
  bf16_t* PE = (bf16_t*)(ws + WS_PE);
  unsigned* KMAX = (unsigned*)(ws + WS_KMAX);
  unsigned* XCNT = (unsigned*)(ws + WS_BAR) + 3584;

  {
        PHASE_IDS
    for (int t = bid; t < 4 * 768; t += nb) {
      const int layer = t / 768;
      int r = t - layer * 768;
      if (r < 528) {
        transpose_tile(p.in[6] + (size_t)layer * DM * INW, WIN + (size_t)layer * INW * DM, DM, INW, r / 33, r % 33, smem);
      } else if (r < 528 + 96) {
        r -= 528;
        const int j = r / 32; r -= j * 32;
        transpose_tile(p.in[12 + j] + (size_t)layer * 512 * DM, WBR + (size_t)layer * DM * 1536 + 512 * j, 512, DM, r / 4, r % 4, smem, 1536);
      } else if (r < 528 + 96 + 64) {
        r -= 528 + 96;
        transpose_tile(p.in[15] + (size_t)layer * DM * DM, WOUT + (size_t)layer * DM * DM, DM, DM, r / 4, r % 4, smem);
      } else if (r < 528 + 96 + 128) {
        r -= 528 + 96 + 64;
        transpose_tile(p.in[18] + (size_t)layer * DM * DM, WPG + (size_t)layer * DM * DM, DM, DM, r / 4, r % 4, smem);
      } else {
        r -= 528 + 96 + 128;
        transpose_tile(p.in[17] + (size_t)layer * DPLE * DM, WPE + (size_t)layer * DM * DPLE, DPLE, DM, r / 4, r % 4, smem);
      }
    }
    if (bid < 2) {
      const int i = bid * 512 + tid;
      const int pos = i >> 4, f = i & 15;
      const float inv = powf(10000.0f, -(float)f / 16.0f);
      const float ang = (float)pos * inv;
      ROPE[i] = cosf(ang);
      ROPE[1024 + i] = sinf(ang);
    }
  }
  grid.sync();

  for (int gi = 0; gi < NG; ++gi) {
    const int seq0 = gi * G;
    const bool is_prompt = seq0 < 16;
    const float* xin = is_prompt ? p.in[0] + (size_t)seq0 * SEQ * DM : p.in[1] + (size_t)(seq0 - 16) * SEQ * DM;
    float* xout = p.out + (size_t)seq0 * SEQ * DM;
    for (int layer = 0; layer < NL; ++layer) {
      const float* xres = (layer == 0) ? xin : (const float*)xout;
      const float* pin = is_prompt ? p.in[2] + ((size_t)layer * 16 + seq0) * SEQ * DPLE : p.in[3] + ((size_t)layer * 8 + (seq0 - 16)) * SEQ * DPLE;
      const bf16_t* win = WIN + (size_t)layer * INW * DM;
      const bf16_t* wbr = WBR + (size_t)layer * DM * 1536;
      const bf16_t* wout = WOUT + (size_t)layer * DM * DM;
      const bf16_t* wpg = WPG + (size_t)layer * DM * DM;
      const bf16_t* wpe = WPE + (size_t)layer * DM * DPLE;

      {
        PHASE_IDS
        const float* g = p.in[5] + layer * DM;
        f32x4 gv[4];
#pragma unroll
        for (int j = 0; j < 4; ++j) gv[j] = *(const f32x4*)(g + 4 * (lane + 64 * j));
        for (int row0 = gw; row0 < TG; row0 += 4 * nw) {
          f32x4 v[4][4];
#pragma unroll
          for (int r = 0; r < 4; ++r) {
            const int row = min(row0 + r * nw, TG - 1);
#pragma unroll
            for (int j = 0; j < 4; ++j) v[r][j] = *(const f32x4*)(xres + (size_t)row * DM + 4 * (lane + 64 * j));
          }
#pragma unroll
          for (int r = 0; r < 4; ++r) {
            const int row = row0 + r * nw;
            float ss = 0.f;
#pragma unroll
            for (int j = 0; j < 4; ++j) ss += v[r][j][0] * v[r][j][0] + v[r][j][1] * v[r][j][1] + v[r][j][2] * v[r][j][2] + v[r][j][3] * v[r][j][3];
            ss = wave_sum(ss);
            const float rstd = rsqrtf(ss * (1.0f / DM) + EPS);
            if (row < TG) {
#pragma unroll
              for (int j = 0; j < 4; ++j)
                *(u32x2*)(H + (size_t)row * DM + 4 * (lane + 64 * j)) =
                    (u32x2){pk_bf16(v[r][j][0] * rstd * gv[j][0], v[r][j][1] * rstd * gv[j][1]), pk_bf16(v[r][j][2] * rstd * gv[j][2], v[r][j][3] * rstd * gv[j][3])};
              const f32x4 pv = *(const f32x4*)(pin + (size_t)row * DPLE + lane * 4);
              *(u32x2*)(PB + (size_t)row * DPLE + lane * 4) = (u32x2){pk_bf16(pv[0], pv[1]), pk_bf16(pv[2], pv[3])};
            }
          }
        }
      }
      GSYNC();
      {
        const int ntp2 = (TG / 256) * 33;
        const int rem = ntp2 % nb;
        PEPSched SP; SP.hb = rem ? nb - rem : nb; SP.hv = rem ? vb - rem : vb; SP.ntiles = (TG / 256) * 4;
        PEPEpi EP; EP.PE = PE;
        pg8::Gemm gp; gp.A = PB; gp.Bt = wpe; gp.M = TG; gp.N = DM; gp.K = DPLE;
        pg8::gemm_phase<PEPEpi, PEPSched, false, true>((PG8_LAS unsigned char*)smem, gp, SP, EP);
      }
      {
        P2Sched S2; S2.vb = vb; S2.nb = nb; S2.ntiles = (TG / 256) * 33;
        P2Epi E2; E2.U = U; E2.GP = GP; E2.KMAXH = KMAX; E2.rope = ROPE; E2.gq = p.in[9] + layer * 64; E2.gk = p.in[10] + layer * 64; E2.smem = smem; E2.kbase = (gi * NL + layer) * G * 16;
        pg8::Gemm g2; g2.A = H; g2.Bt = win; g2.M = TG; g2.N = INW; g2.K = DM;
        pg8::gemm_phase<P2Epi, P2Sched, true, true>((PG8_LAS unsigned char*)smem, g2, S2, E2);
      }
      GSYNC();
      {
        PHASE_IDS
        const float* rpb = p.in[11] + (size_t)layer * 8 * 465;
        const int nu = G * 8 * 16;
        int t = vb;
        for (; t < nu; t += nb) attn_unit<0>(U, OA, Y, t >> 7, (t >> 4) & 7, t & 15, p.in[4], rpb, smem, nullptr, nullptr, __uint_as_float(__hip_atomic_load(KMAX + (((gi * NL + layer) * G + (t >> 7)) * 16 + ((t >> 4) & 7) * 2), __ATOMIC_RELAXED, __HIP_MEMORY_SCOPE_AGENT)) +
                                                       __uint_as_float(__hip_atomic_load(KMAX + (((gi * NL + layer) * G + (t >> 7)) * 16 + ((t >> 4) & 7) * 2 + 1), __ATOMIC_RELAXED, __HIP_MEMORY_SCOPE_AGENT)));
        for (; t < 2 * nu; t += nb) { const int r = t - nu; attn_unit<1>(U, OA, Y, r >> 7, (r >> 4) & 7, r & 15, p.in[4], rpb, smem, p.in[9] + layer * 64, p.in[10] + layer * 64); }
        for (; t < 3 * nu; t += nb) { const int r = t - 2 * nu; attn_unit<2>(U, OA, Y, r >> 7, (r >> 4) & 7, r & 15, p.in[4], rpb, smem); }
      }
      GSYNC();
      {
        PHASE_IDS
        const float* lp = p.in[7] + layer * 256;
        const float li = p.lambda_init[layer];
        const float s1 = wave_sum(lp[lane] * lp[64 + lane]), s2 = wave_sum(lp[128 + lane] * lp[192 + lane]);
        const float lam = __expf(s1) - __expf(s2) + li;
        const float* sg = p.in[8] + layer * 128 + (lane & 15) * 8;
        float sgv[8];
#pragma unroll
        for (int e = 0; e < 8; ++e) sgv[e] = sg[e] * (1.0f - li);
        const int hh = lane >> 4, dd = (lane & 15) * 8;
        for (int row0 = gw; row0 < TG; row0 += 4 * nw) {
          u32x4 a0[4], a1[4], gt[4];
#pragma unroll
          for (int r = 0; r < 4; ++r) {
            const int row = min(row0 + r * nw, TG - 1);
            a0[r] = *(const u32x4*)(OA + (size_t)row * DM + hh * 256 + dd);
            a1[r] = *(const u32x4*)(OA + (size_t)row * DM + hh * 256 + 128 + dd);
            gt[r] = *(const u32x4*)(U + (size_t)row * UP + C_AG + lane * 8);
          }
#pragma unroll
          for (int r = 0; r < 4; ++r) {
            const int row = row0 + r * nw;
            float dv[8];
            float ss = 0.f;
#pragma unroll
            for (int e = 0; e < 4; ++e) {
              dv[2 * e] = bflo(a0[r][e]) - lam * bflo(a1[r][e]);
              dv[2 * e + 1] = bfhi(a0[r][e]) - lam * bfhi(a1[r][e]);
              ss += dv[2 * e] * dv[2 * e] + dv[2 * e + 1] * dv[2 * e + 1];
            }
            ss += __shfl_xor(ss, 1); ss += __shfl_xor(ss, 2); ss += __shfl_xor(ss, 4); ss += __shfl_xor(ss, 8);
            const float rstd = rsqrtf(ss * (1.0f / 128.0f) + EPS);
            u32x4 ow;
#pragma unroll
            for (int e = 0; e < 4; ++e)
              ow[e] = pk_bf16(dv[2 * e] * rstd * sgv[2 * e] * siluf_(bflo(gt[r][e])), dv[2 * e + 1] * rstd * sgv[2 * e + 1] * siluf_(bfhi(gt[r][e])));
            if (row < TG) {
              *(u32x4*)(Y + (size_t)row * 1536 + lane * 8) = ow;
            }
          }
        }
      }
      GSYNC();
      {
        P7Sched S6; S6.vb = vb; S6.nb = nb; S6.ntiles = (TG / 256) * 4;
        P6Epi E6; E6.GP = GP; E6.M = M;
        pg8::Gemm g6; g6.A = Y; g6.Bt = wbr; g6.M = TG; g6.N = DM; g6.K = 1536;
        pg8::gemm_phase<P6Epi, P7Sched, true, true>((PG8_LAS unsigned char*)smem, g6, S6, E6);
      }
      GSYNC();
      {
        P7Sched S7; S7.vb = vb; S7.nb = nb; S7.ntiles = (TG / 256) * 4;
        P7Epi E7; E7.xres = xres; E7.xout = xout; E7.H = H; E7.g = p.in[16] + layer * DM; E7.XCH = XCH; E7.XCNT = XCNT; E7.want = 4u * (unsigned)(gi * NL + layer + 1); E7.smem = smem;
        pg8::Gemm g7; g7.A = M; g7.Bt = wout; g7.M = TG; g7.N = DM; g7.K = DM;
        pg8::gemm_phase<P7Epi, P7Sched, true, true>((PG8_LAS unsigned char*)smem, g7, S7, E7);
      }
      GSYNC();
      {
        P9Sched S9; S9.vb = vb; S9.nb = nb; S9.ntiles = (TG / 256) * 4;
        P9EpiX E9b; E9b.PE = PE; E9b.xout = xout;
        pg8::Gemm g9b; g9b.A = H; g9b.Bt = wpg; g9b.M = TG; g9b.N = DM; g9b.K = DM;
        pg8::gemm_phase<P9EpiX, P9Sched, false, true>((PG8_LAS unsigned char*)smem, g9b, S9, E9b);
      }
      GSYNC();
    }
  }
}

extern "C" void kernel_launch(void* const* d_in, const int* in_sizes, int n_in, void* d_out, int out_size, void* d_ws, size_t ws_size, hipStream_t stream) {
  static int grid_blocks = 0;
  if (!grid_blocks) {
    int dev = 0, cus = 0, per_cu = 0;
    (void)hipGetDevice(&dev);
    (void)hipDeviceGetAttribute(&cus, hipDeviceAttributeMultiprocessorCount, dev);
    (void)hipFuncSetAttribute((const void*)fwd_kernel, hipFuncAttributeMaxDynamicSharedMemorySize, LDS_BYTES);
    (void)hipOccupancyMaxActiveBlocksPerMultiprocessor(&per_cu, fwd_kernel, 512, LDS_BYTES);
    if (per_cu < 1) per_cu = 1;
    if (per_cu > 1) per_cu = 1;
    grid_blocks = cus * per_cu;
    grid_blocks -= grid_blocks % 8;
    if (ws_size < WS_END) fprintf(stderr, "kernel_launch: workspace too small: %zu < %zu\n", ws_size, (size_t)WS_END);
  }
  Params p{};
  for (int i = 0; i < 19; ++i) p.in[i] = (const float*)d_in[i];
  p.out = (float*)d_out;
  p.ws = (unsigned char*)d_ws;
  const float li[4] = {0.2f, 0.35550906759096926f, 0.47071301834358413f, 0.5560582041556852f};
  for (int i = 0; i < 4; ++i) p.lambda_init[i] = li[i];
  (void)hipMemsetAsync((char*)d_ws + WS_BAR, 0, 32768, stream);
  void* args[] = {&p};
  hipError_t e = hipLaunchCooperativeKernel((void*)fwd_kernel, dim3(grid_blocks), dim3(512), args, LDS_BYTES, stream);
  if (e != hipSuccess) fprintf(stderr, "cooperative launch failed: %s (grid %d)\n", hipGetErrorString(e), grid_blocks);
}
```

```cpp
#include <hip/hip_runtime.h>
#include <hip/hip_cooperative_groups.h>
#include <stdint.h>
#include <stdio.h>
namespace cg = cooperative_groups;

typedef unsigned short bf16_t;
typedef short bf16x8 __attribute__((ext_vector_type(8)));
typedef short s16x4 __attribute__((ext_vector_type(4)));
typedef float f32x16 __attribute__((ext_vector_type(16)));
typedef float f32x4 __attribute__((ext_vector_type(4)));
typedef float f32x2 __attribute__((ext_vector_type(2)));
typedef __bf16 bf16x2_t __attribute__((ext_vector_type(2)));
typedef unsigned u32x4 __attribute__((ext_vector_type(4)));
typedef unsigned u32x2 __attribute__((ext_vector_type(2)));
#define DI __device__ __forceinline__
#define LDSAS __attribute__((address_space(3)))

constexpr int DM = 1024, SEQ = 4096, NL = 4, INW = 8448, DPLE = 256;
constexpr int UP = 5376;
constexpr int G = 8;
constexpr int NG = 24 / G;
constexpr int TG = G * SEQ;
constexpr float EPS = 1e-6f;
constexpr float LOG2E = 1.4426950408889634f;
constexpr int C_AQ = 0, C_AK = 512, C_AV = 1024, C_AG = 1536, C_BQ = 2048, C_BK = 2560, C_BV = 2688, C_BG = 2816,
              C_CQ = 3328, C_CK = 3840, C_CV = 4352, C_CG = 4864, C_MG = 5376;
constexpr size_t WS_BAR = 0;
constexpr size_t WS_KMAX = 16384;
constexpr size_t WS_ROPE = 32768;
constexpr size_t WS_WIN = 49152;
constexpr size_t WS_WBR = WS_WIN + (size_t)NL * INW * DM * 2;
constexpr size_t WS_WOUT = WS_WBR + (size_t)NL * 3 * DM * 512 * 2;
constexpr size_t WS_WPG = WS_WOUT + (size_t)NL * DM * DM * 2;
constexpr size_t WS_WPE = WS_WPG + (size_t)NL * DM * DM * 2;
constexpr size_t WS_U = WS_WPE + (size_t)NL * DM * DPLE * 2;
constexpr size_t WS_H = WS_U + (size_t)TG * UP * 2;
constexpr size_t WS_OA = WS_H + (size_t)TG * DM * 2;
constexpr size_t WS_Y = WS_OA + (size_t)TG * DM * 2;
constexpr size_t WS_M = WS_OA;
constexpr size_t WS_Z = WS_Y;
constexpr size_t WS_GP = WS_Y + (size_t)TG * 1536 * 2;
constexpr size_t WS_XCH = WS_GP + (size_t)TG * 3072 * 2;
constexpr size_t WS_PB = WS_XCH + (size_t)TG * 4 * 4;
constexpr size_t WS_PE = WS_PB + (size_t)TG * DPLE * 2;
constexpr size_t WS_END = WS_PE + (size_t)TG * DM * 2;

struct Params {
  const float* in[19];
  float* out;
  unsigned char* ws;
  float lambda_init[4];
};

DI unsigned pk_bf16(float lo, float hi) { f32x2 v = {lo, hi}; bf16x2_t b = __builtin_convertvector(v, bf16x2_t); return __builtin_bit_cast(unsigned, b); }
DI float bf2f(unsigned short b) { return __uint_as_float(((unsigned)b) << 16); }
DI float bflo(unsigned w) { return __uint_as_float(w << 16); }
DI float bfhi(unsigned w) { return __uint_as_float(w & 0xffff0000u); }
DI unsigned short f2bf(float f) { return (unsigned short)(pk_bf16(f, 0.f) & 0xffffu); }
DI float wave_sum(float v) {
#pragma unroll
  for (int o = 32; o >= 1; o >>= 1) v += __shfl_xor(v, o);
  return v;
}
DI float sigmoidf_(float x) { return 1.0f / (1.0f + __expf(-x)); }
DI float siluf_(float x) { return x / (1.0f + __expf(-x)); }
DI int opaque_tid() { int t = threadIdx.x; asm volatile("" : "+v"(t)); return t; }
DI int crow(int i, int h) { return (i & 3) + 8 * (i >> 2) + 4 * h; }
#define MFMA32(a, b, c) __builtin_amdgcn_mfma_f32_32x32x16_bf16((a), (b), (c), 0, 0, 0)

DI void dma16(const void* gsrc, char* lds_wave_base) {
  __builtin_amdgcn_global_load_lds((const unsigned*)gsrc, (LDSAS unsigned*)lds_wave_base, 16, 0, 0);
}
DI void dma_sync() { asm volatile("s_waitcnt vmcnt(0)" ::: "memory"); __syncthreads(); }
template <int NI, bool A_F32>
DI void gemm_acc(f32x16 (&acc)[4][NI], const void* Aptr, int lda, const bf16_t* Wt, int ldw, int K, char* smem) {
  constexpr int A_BYTES = 32768, STG = A_BYTES + 16384 * NI;
  const int tid = opaque_tid(), lane = tid & 63, wave = __builtin_amdgcn_readfirstlane(tid >> 6), wr = wave >> 2, wc = wave & 3, r32 = lane & 31, h = lane >> 5;
  const int drow = wave * 8 + (lane >> 3);
  const int dch = (lane & 7) ^ ((drow >> 1) & 7);
  const bf16_t* wsrc = Wt + (size_t)drow * ldw + dch * 8;
  const bf16_t* asrc = (const bf16_t*)Aptr + (size_t)drow * lda + dch * 8;
  const int lrow = tid >> 3, lch = tid & 7;
  u32x4 ra[4];
  auto gloadA = [&](int k0) {
#pragma unroll
    for (int j = 0; j < 4; ++j) {
      const float* pa = (const float*)Aptr + (size_t)(lrow + 64 * j) * lda + k0 + lch * 8;
      const f32x4 v0 = *(const f32x4*)pa, v1 = *(const f32x4*)(pa + 4);
      ra[j] = (u32x4){pk_bf16(v0[0], v0[1]), pk_bf16(v0[2], v0[3]), pk_bf16(v1[0], v1[1]), pk_bf16(v1[2], v1[3])};
    }
  };
  auto lstoreA = [&](int buf) {
    char* sa = smem + buf * STG;
#pragma unroll
    for (int j = 0; j < 4; ++j) {
      const int row = lrow + 64 * j;
      *(u32x4*)(sa + row * 128 + ((lch ^ ((row >> 1) & 7)) << 4)) = ra[j];
    }
  };
  auto issue = [&](int kt, int buf) {
    char* sa = smem + buf * STG + wave * 1024;
    char* sb = sa + A_BYTES;
    if (!A_F32) {
#pragma unroll
      for (int j = 0; j < 4; ++j) dma16(asrc + (size_t)(64 * j) * lda + kt * 64, sa + j * 8192);
    }
#pragma unroll
    for (int j = 0; j < 2 * NI; ++j) dma16(wsrc + (size_t)(64 * j) * ldw + kt * 64, sb + j * 8192);
  };
  const int nk = K >> 6;
  const int xsw = (r32 >> 1) & 7;
  const int a_base = (128 * wr + r32) * 128, b_base = A_BYTES + (32 * NI * wc + r32) * 128;
  __syncthreads();
  if (A_F32) { gloadA(0); lstoreA(0); }
  issue(0, 0);
  for (int kt = 0; kt < nk; ++kt) {
    dma_sync();
    if (kt + 1 < nk) { issue(kt + 1, (kt + 1) & 1); if (A_F32) gloadA((kt + 1) << 6); }
    const char* st = smem + (kt & 1) * STG;
#pragma unroll
    for (int s = 0; s < 4; ++s) {
      const int sw = ((2 * s + h) ^ xsw) << 4;
      bf16x8 af[4], bfr[NI];
#pragma unroll
      for (int mi = 0; mi < 4; ++mi) af[mi] = *(const bf16x8*)(st + a_base + sw + mi * 4096);
#pragma unroll
      for (int ni = 0; ni < NI; ++ni) bfr[ni] = *(const bf16x8*)(st + b_base + sw + ni * 4096);
#pragma unroll
      for (int mi = 0; mi < 4; ++mi)
#pragma unroll
        for (int ni = 0; ni < NI; ++ni) acc[mi][ni] = MFMA32(af[mi], bfr[ni], acc[mi][ni]);
    }
    if (A_F32) { if (kt + 1 < nk) lstoreA((kt + 1) & 1); }
  }
}
template <int NI>
DI void zero_acc(f32x16 (&acc)[4][NI]) {
#pragma unroll
  for (int a = 0; a < 4; ++a)
#pragma unroll
    for (int b = 0; b < NI; ++b)
#pragma unroll
      for (int i = 0; i < 16; ++i) acc[a][b][i] = 0.f;
}
#define EPI_LOOP(NI_) _Pragma("unroll") for (int mi = 0; mi < 4; ++mi) _Pragma("unroll") for (int ni = 0; ni < NI_; ++ni) _Pragma("unroll") for (int i = 0; i < 16; ++i)
#define EPI_OFF0(mt, nt, NI_, ld) ((unsigned)((mt) * 256 + 128 * (wave >> 2) + 4 * (lane >> 5)) * (unsigned)(ld) + (unsigned)((nt) * 128 * NI_ + 32 * NI_ * (wave & 3) + (lane & 31)))
#define EPI_OFF(off0, ld) ((off0) + (unsigned)((32 * mi + (i & 3) + 8 * (i >> 2)) * (ld) + 32 * ni))
#define EPI_FENCE
DI void stage_tile_bf16(const f32x16 (&acc)[4][2], char* wl, int lane, float sc = 1.0f) {
  const int r32 = lane & 31, h = lane >> 5;
#pragma unroll
  for (int mi = 0; mi < 4; ++mi)
#pragma unroll
    for (int ni = 0; ni < 2; ++ni)
#pragma unroll
      for (int i = 0; i < 16; ++i) *(bf16_t*)(wl + (32 * mi + crow(i, h)) * 128 + (32 * ni + r32) * 2) = f2bf(acc[mi][ni][i] * sc);
}
DI void tile_decode(int t, int ntn, int& mt, int& nt) {
  const int band = t / (8 * ntn), w = t - band * 8 * ntn;
  nt = w >> 3;
  mt = band * 8 + (w & 7);
}

template <int MODE>
DI void attn_unit(const bf16_t* __restrict__ U, bf16_t* __restrict__ OA, bf16_t* __restrict__ Y, int seq_l, int head, int qb,
                  const float* __restrict__ t5, const float* __restrict__ rpb, char* smem, const float* __restrict__ gq = nullptr, const float* __restrict__ gk = nullptr, float kmax2 = 0.f) {
  constexpr int DV = (MODE == 0) ? 128 : 64;
  constexpr int NDB = DV / 32;
  constexpr int NKB = (MODE == 2) ? 2 : 4;
  constexpr int KT = 32 * NKB;
  constexpr int NKC = (MODE == 2) ? 1 : NKB;
  constexpr int KBYTES = KT * 128, VBYTES = KT * DV * 2, STAGE = KBYTES + VBYTES;
  constexpr int NKJ = KBYTES / 8192;
  constexpr int NVJ = VBYTES / 8192;
  float* lut = (float*)(smem + 98304);
  const int tid = opaque_tid(), lane = tid & 63, wave = tid >> 6, r32 = lane & 31, h = lane >> 5;
  const size_t tok0 = (size_t)seq_l * SEQ;
  const int q0 = qb * 256;
  int qcol, kcol, vcol;
  if (MODE == 0) { qcol = C_AQ + head * 64; kcol = C_AK + head * 64; vcol = C_AV + (head >> 1) * 128; }
  else if (MODE == 1) { qcol = C_BQ + head * 64; kcol = C_BK + (head >> 2) * 64; vcol = C_BV + (head >> 2) * 64; }
  else { qcol = C_CQ + head * 64; kcol = C_CK + head * 64; vcol = C_CV + head * 64; }
  int kt0 = 0, NT = SEQ / KT;
  if (MODE == 2) { int b0 = 4 * qb - 4; b0 = b0 < 0 ? 0 : (b0 > 53 ? 53 : b0); kt0 = b0; NT = 11; }

  __syncthreads();
  if (MODE == 0) {
    for (int i = tid; i < 257; i += 512) {
      const int r = i - 128, n = r < 0 ? -r : r;
      int b;
      if (n < 8) b = n;
      else { b = 8 + (n >= 12) + (n >= 16) + (n >= 23) + (n >= 32) + (n >= 46) + (n >= 64) + (n >= 91); }
      if (r > 0) b += 16;
      lut[i] = t5[b * 8 + head] * LOG2E;
    }
  } else if (MODE == 2) {
    for (int i = tid; i < 465; i += 512) lut[i] = rpb[head * 465 + i] * LOG2E;
  }

  const int qi = (MODE == 2) ? ((4 * qb + 2 * (wave >> 2) + (r32 >> 4)) * 64 + 16 * (wave & 3) + (r32 & 15)) : (q0 + wave * 32 + r32);
  bf16x8 qf[4];
  {
    const bf16_t* qp = U + (tok0 + qi) * UP + qcol + 8 * h;
#pragma unroll
    for (int s = 0; s < 4; ++s) {
      qf[s] = __builtin_bit_cast(bf16x8, *(const u32x4*)(qp + 16 * s));
    }
  }

  const int wv = __builtin_amdgcn_readfirstlane(wave);
  int koff[NKJ], voff[NVJ];
#pragma unroll
  for (int j = 0; j < NKJ; ++j) {
    const int row = (wv + 8 * j) * 8 + (lane >> 3), ch = (lane & 7) ^ ((row >> 1) & 7);
    koff[j] = row * UP + kcol + ch * 8;
  }
#pragma unroll
  for (int j = 0; j < NVJ; ++j) {
    if (DV == 64) { const int row = (wv + 8 * j) * 8 + (lane >> 3), ch = (lane & 7) ^ (((row >> 1) & 1) << 2); voff[j] = row * UP + vcol + ch * 8; }
    else { const int row = (wv + 8 * j) * 4 + (lane >> 4), ch = (lane & 15) ^ ((row & 3) << 2); voff[j] = row * UP + vcol + ch * 8; }
  }
  auto issue = [&](int kt, int buf) {
    const bf16_t* base = U + (tok0 + (size_t)kt * KT) * UP;
    char* sk = smem + buf * STAGE + wv * 1024;
#pragma unroll
    for (int j = 0; j < NKJ; ++j) dma16(base + koff[j], sk + j * 8192);
#pragma unroll
    for (int j = 0; j < NVJ; ++j) dma16(base + voff[j], sk + KBYTES + j * 8192);
  };

  f32x16 o[NDB];
#pragma unroll
  for (int db = 0; db < NDB; ++db)
#pragma unroll
    for (int i = 0; i < 16; ++i) o[db][i] = 0.f;
  float m_run = -INFINITY, l_run = 0.f;
  bool fixed_ref = false;
  if (MODE == 0) {
    float qs = 0.f;
#pragma unroll
    for (int s = 0; s < 4; ++s) {
      const u32x4 w = __builtin_bit_cast(u32x4, qf[s]);
#pragma unroll
      for (int e = 0; e < 4; ++e) { const float a0 = bflo(w[e]), a1 = bfhi(w[e]); qs += a0 * a0 + a1 * a1; }
    }
    qs += __shfl_xor(qs, 32);
    float bm = fabsf(t5[(lane & 31) * 8 + head]);
#pragma unroll
    for (int o_ = 16; o_ >= 1; o_ >>= 1) bm = fmaxf(bm, __shfl_xor(bm, o_));
    const float bound = sqrtf(qs * kmax2) * 1.02f + bm * LOG2E;
    fixed_ref = !__any(!(bound < 40.0f));
    if (fixed_ref) m_run = bound;
  }
  if (MODE == 1) {
    float ga = fabsf(gq[lane]), gb = fabsf(gk[lane]);
#pragma unroll
    for (int o_ = 32; o_ >= 1; o_ >>= 1) { ga = fmaxf(ga, __shfl_xor(ga, o_)); gb = fmaxf(gb, __shfl_xor(gb, o_)); }
    const float bound = 8.0f * ga * gb * 1.05f * LOG2E;
    fixed_ref = bound < 40.0f;
    if (fixed_ref) m_run = bound;
  }

  const int q4 = (lane & 15) >> 2, p4 = lane & 3, blk = (lane >> 4) & 1;
  const int qr = 4 * qb + 2 * (wave >> 2) + (r32 >> 4), qc = 16 * (wave & 3) + (r32 & 15);
  int sr = qr - 4; sr = sr < 0 ? 0 : (sr > 56 ? 56 : sr);
  int sc = qc - 8; sc = sc < 0 ? 0 : (sc > 48 ? 48 : sc);
  int sr_lo = 4 * qb + 2 * (wv >> 2) - 4; sr_lo = sr_lo < 0 ? 0 : (sr_lo > 56 ? 56 : sr_lo);
  int sr_hi = 4 * qb + 2 * (wv >> 2) - 3; sr_hi = sr_hi < 0 ? 0 : (sr_hi > 56 ? 56 : sr_hi);
  const int kc0 = (MODE == 2) ? (((wv & 3) == 0) ? 0 : ((wv & 3) == 1) ? 8 : ((wv & 3) == 2) ? 24 : 32) : 0;

  f32x16 cvec;
  int cstate = (MODE == 1 && fixed_ref) ? 1 : 0;
#pragma unroll
  for (int i = 0; i < 16; ++i) cvec[i] = (MODE == 1 && fixed_ref) ? -m_run : 0.f;
  issue(kt0, 0);
  float bl_pos = 0.f, bl_neg = 0.f;
  for (int it = 0; it < NT; ++it) {
    const int kt = kt0 + it;
    dma_sync();
    if (it + 1 < NT) issue(kt + 1, (it + 1) & 1);
    if (MODE == 0 && it == 0) { bl_pos = lut[256]; bl_neg = lut[0]; }
    const char* sk = smem + (it & 1) * STAGE;
    const char* sv = sk + KBYTES;
    bool active = true;
    if (MODE == 2) active = (kt >= sr_lo) && (kt < sr_hi + 8);
    if (active) {
      bool uni = (MODE == 1);
      float bl = 0.f;
      if (MODE == 0) {
        const int rel_min = kt * KT - (q0 + 255), rel_max = kt * KT + (KT - 1) - q0;
        uni = (rel_min >= 128) || (rel_max <= -128);
        bl = (rel_min >= 128) ? bl_pos : bl_neg;
      }
      const float ubias = uni ? bl : 0.f;
      if (MODE == 0) {
        const int want = (fixed_ref && uni) ? ((bl == bl_pos) ? 2 : 1) : 0;
        if (want != cstate) {
          cstate = want;
#pragma unroll
          for (int i = 0; i < 16; ++i) cvec[i] = want ? (bl - m_run) : 0.f;
        }
      }
      f32x16 st[NKC];
      {
        bf16x8 kf[NKC][4];
        const int ksw = ((kc0 + r32) >> 1) & 7;
        const char* kp = sk + (kc0 + r32) * 128;
#pragma unroll
        for (int s = 0; s < 4; ++s) kf[0][s] = *(const bf16x8*)(kp + (((2 * s + h) ^ ksw) << 4));
        asm volatile("" ::: "memory");
#pragma unroll
        for (int kb = 0; kb < NKC; ++kb) {
          if (kb + 1 < NKC) {
#pragma unroll
            for (int s = 0; s < 4; ++s) kf[kb + 1][s] = *(const bf16x8*)(kp + (kb + 1) * 4096 + (((2 * s + h) ^ ksw) << 4));
            asm volatile("" ::: "memory");
          }
          if (MODE == 1 || MODE == 0) {
            st[kb] = MFMA32(kf[kb][0], qf[0], cvec);
#pragma unroll
            for (int s = 1; s < 4; ++s) st[kb] = MFMA32(kf[kb][s], qf[s], st[kb]);
          } else {
#pragma unroll
            for (int i = 0; i < 16; ++i) st[kb][i] = 0.f;
#pragma unroll
            for (int s = 0; s < 4; ++s) st[kb] = MFMA32(kf[kb][s], qf[s], st[kb]);
          }
        }
      }
      if (!uni) {
        if (MODE == 0) {
#pragma unroll
          for (int kb = 0; kb < NKC; ++kb)
#pragma unroll
            for (int i = 0; i < 16; ++i) {
              int rel = kt * KT + 32 * kb + crow(i, h) - qi;
              rel = rel < -128 ? -128 : (rel > 128 ? 128 : rel);
              st[kb][i] += lut[rel + 128];
            }
        } else if (MODE == 2) {
          const int ri = kt - qr + 7;
#pragma unroll
          for (int kb = 0; kb < NKC; ++kb)
#pragma unroll
            for (int i = 0; i < 16; ++i) {
              const int kc = kc0 + 32 * kb + crow(i, h);
              const bool ok = (kt >= sr) && (kt < sr + 8) && (kc >= sc) && (kc < sc + 16);
              int ci = kc - qc + 15; ci = ci < 0 ? 0 : (ci > 30 ? 30 : ci);
              const float bb = lut[ri * 31 + ci];
              st[kb][i] = ok ? (st[kb][i] + bb) : -INFINITY;
            }
        }
      }
      if (!((MODE == 1 || MODE == 0) && fixed_ref)) {
      float mx;
      {
        float mk[NKC];
#pragma unroll
        for (int kb = 0; kb < NKC; ++kb) {
          float m0 = fmaxf(fmaxf(st[kb][0], st[kb][1]), st[kb][2]);
#pragma unroll
          for (int i = 3; i < 15; i += 2) m0 = fmaxf(fmaxf(m0, st[kb][i]), st[kb][i + 1]);
          mk[kb] = fmaxf(m0, st[kb][15]);
        }
        mx = mk[0];
#pragma unroll
        for (int kb = 1; kb < NKC; ++kb) mx = fmaxf(mx, mk[kb]);
      }
      { const auto rr = __builtin_amdgcn_permlane32_swap(__float_as_uint(mx), __float_as_uint(mx), false, false);
        mx = fmaxf(__uint_as_float(rr[0]), __uint_as_float(rr[1])); }
      const float mt = mx + ubias;
      if (__any(mt > m_run)) {
        const float m_new = fmaxf(m_run, mt);
        const float alpha = (MODE == 2 && m_new == -INFINITY) ? 1.0f : __builtin_amdgcn_exp2f(m_run - m_new);
        m_run = m_new;
        l_run *= alpha;
#pragma unroll
        for (int db = 0; db < NDB; ++db) o[db] = o[db] * alpha;
      }
      }
      {
        float ps[NKC];
        if (cstate == 0) {
          const float cc = (MODE == 2 && m_run == -INFINITY) ? 0.f : (ubias - m_run);
#pragma unroll
          for (int kb = 0; kb < NKC; ++kb)
#pragma unroll
            for (int i = 0; i < 16; ++i) st[kb][i] += cc;
        }
#pragma unroll
        for (int kb = 0; kb < NKC; ++kb) {
#pragma unroll
          for (int i = 0; i < 16; ++i) st[kb][i] = __builtin_amdgcn_exp2f(st[kb][i]);
          const float s0 = (st[kb][0] + st[kb][1]) + (st[kb][2] + st[kb][3]), s1 = (st[kb][4] + st[kb][5]) + (st[kb][6] + st[kb][7]);
          const float s2 = (st[kb][8] + st[kb][9]) + (st[kb][10] + st[kb][11]), s3 = (st[kb][12] + st[kb][13]) + (st[kb][14] + st[kb][15]);
          ps[kb] = (s0 + s1) + (s2 + s3);
        }
        float pt = ps[0];
#pragma unroll
        for (int kb = 1; kb < NKC; ++kb) pt += ps[kb];
        l_run += pt;
      }
#pragma unroll
      for (int kb = 0; kb < NKC; ++kb)
#pragma unroll
        for (int s2 = 0; s2 < 2; ++s2) {
          u32x4 w;
#pragma unroll
          for (int e = 0; e < 4; ++e) w[e] = pk_bf16(st[kb][8 * s2 + 2 * e], st[kb][8 * s2 + 2 * e + 1]);
          const bf16x8 pf = __builtin_bit_cast(bf16x8, w);
#pragma unroll
          for (int db = 0; db < NDB; ++db) {
            s16x4 part[2];
#pragma unroll
            for (int hf = 0; hf < 2; ++hf) {
              const int row = kc0 + 32 * kb + 16 * s2 + 8 * hf + 4 * h + q4;
              const int chunk = 4 * db + 2 * blk + (p4 >> 1);
              int off;
              if (DV == 64) off = row * 128 + ((chunk ^ (((q4 >> 1) & 1) << 2)) << 4) + (p4 & 1) * 8;
              else off = row * 256 + ((chunk ^ (q4 << 2)) << 4) + (p4 & 1) * 8;
              part[hf] = __builtin_bit_cast(s16x4, __builtin_amdgcn_ds_read_tr16_b64_v4i16((LDSAS s16x4*)(sv + off)));
            }
            const bf16x8 vf = __builtin_shufflevector(part[0], part[1], 0, 1, 2, 3, 4, 5, 6, 7);
            o[db] = MFMA32(vf, pf, o[db]);
          }
        }
    }
  }
  const float l_tot = l_run + __shfl_xor(l_run, 32);
  const float inv = 1.0f / l_tot;
  const size_t tok = tok0 + qi;
#pragma unroll
  for (int db = 0; db < NDB; ++db)
#pragma unroll
    for (int g4 = 0; g4 < 4; ++g4) {
      const int d = 32 * db + 8 * g4 + 4 * h;
      float v0 = o[db][4 * g4] * inv, v1 = o[db][4 * g4 + 1] * inv, v2 = o[db][4 * g4 + 2] * inv, v3 = o[db][4 * g4 + 3] * inv;
      if (MODE == 0) {
        *(u32x2*)(OA + tok * DM + head * 128 + d) = (u32x2){pk_bf16(v0, v1), pk_bf16(v2, v3)};
      } else {
        const int gcol = (MODE == 1 ? C_BG : C_CG) + head * 64 + d;
        const u32x2 gw = *(const u32x2*)(U + tok * UP + gcol);
        v0 *= siluf_(bflo(gw[0])); v1 *= siluf_(bfhi(gw[0])); v2 *= siluf_(bflo(gw[1])); v3 *= siluf_(bfhi(gw[1]));
        *(u32x2*)(Y + tok * 1536 + (MODE == 1 ? 512 : 1024) + head * 64 + d) = (u32x2){pk_bf16(v0, v1), pk_bf16(v2, v3)};
      }
    }
}

DI void transpose_tile(const float* __restrict__ src, bf16_t* __restrict__ dst, int R, int C, int tr, int tc, char* smem, int ldd = 0) {
  if (ldd == 0) ldd = R;
  float* tl = (float*)smem;
  const int tid = opaque_tid();
  const int r0 = tr * 64, c0 = tc * 64;
  __syncthreads();
#pragma unroll
  for (int i = 0; i < 8; ++i) {
    const int r = i * 8 + (tid >> 6), c = tid & 63;
    tl[r * 65 + c] = src[(size_t)(r0 + r) * C + c0 + c];
  }
  __syncthreads();
  const int n = tid >> 3, kb = (tid & 7) * 8;
  unsigned w[4];
#pragma unroll
  for (int e = 0; e < 4; ++e) w[e] = pk_bf16(tl[(kb + 2 * e) * 65 + n], tl[(kb + 2 * e + 1) * 65 + n]);
  *(u32x4*)(dst + (size_t)(c0 + n) * ldd + r0 + kb) = (u32x4){w[0], w[1], w[2], w[3]};
}

namespace pg8 {
#define PG8_LAS __attribute__((address_space(3)))
constexpr int BM = 256, BK = 64, HALF = 128, HTB = HALF * BK * 2  , STAGE_BYTES = 8 * HTB, NXCD = 8, WGM = 8;

__host__ __device__ __forceinline__ int lds_byte(int r, int c) { const int st = (r >> 4) * 2 + (c >> 5), rr = r & 15, cc = c & 31, ob = rr * 64 + cc * 2; return st * 1024 + (ob ^ (((ob >> 9) & 1) << 5)); }
__host__ __device__ __forceinline__ void stage_rc(int b, int& R, int& C) { const int st = b / 1024, sb = b % 1024, swz = sb ^ (((sb >> 9) & 1) << 5); R = (st >> 1) * 16 + swz / 64; C = (st & 1) * 32 + (swz % 64) / 2; }
__host__ __device__ __forceinline__ int perm32(int rho) { const int n = rho >> 4, i = rho & 15; return 8 * (i >> 2) + 4 * n + (i & 3); }

struct Unit { int pm, pn; };
struct Gemm { const bf16_t* A; const bf16_t* Bt; int M, N, K; };

template <class Epi, class Sched, bool ALIGN_EPI = false, bool SP2 = false>
__device__ __forceinline__ void gemm_phase(PG8_LAS unsigned char* lds, const Gemm g, const Sched& S, const Epi& E) {
    const int tid = ::opaque_tid(), wid = __builtin_amdgcn_readfirstlane(tid >> 6), lane = tid & 63, wr = wid >> 2, wc = wid & 3, fr = lane & 15, fq = lane >> 4;
    const int K = g.K, nt = K / BK;
    unsigned voffA[2], voffB[2];
#pragma unroll
    for (int i = 0; i < 2; ++i) { int R, C; stage_rc(tid * 16 + i * 8192, R, C); const int Rb = Epi::PERM ? ((R & ~31) + perm32(R & 31)) : R;
        voffA[i] = (unsigned)(R * K + C) * 2u; voffB[i] = (unsigned)(Rb * K + C) * 2u; }
    const size_t kstep = (size_t)(BK * 2);
    const size_t hstep = (size_t)HALF * K * 2;
    const size_t tstep = 2 * hstep;
    const unsigned ldsw = (unsigned)wid * 1024u;
    const int aoff = lds_byte(wr * 64 + fr, fq * 8), boff = lds_byte(wc * 32 + fr, fq * 8);
#define PG8_SA(b, h) (((b) * 2 + (h)) * HTB)
#define PG8_SB(b, h) ((4 + (b) * 2 + (h)) * HTB)
#define PG8_STAGE(bufoff, gbase, voff) do { _Pragma("unroll") for (int _i = 0; _i < 2; ++_i) \
        __builtin_amdgcn_global_load_lds((const unsigned*)((const char*)(gbase) + (voff)[_i]), (PG8_LAS unsigned*)(lds + (bufoff) + ldsw + _i * 8192), 16, 0, 0); } while (0)
#define PG8_LDA(dst, b, h) do { _Pragma("unroll") for (int m = 0; m < 4; ++m) _Pragma("unroll") for (int k = 0; k < 2; ++k) dst[m][k] = *(const PG8_LAS bf16x8*)(lds + PG8_SA(b, h) + aoff + m * 2048 + k * 1024); } while (0)
#define PG8_LDB(dst, b, h) do { _Pragma("unroll") for (int n = 0; n < 2; ++n) _Pragma("unroll") for (int k = 0; k < 2; ++k) dst[n][k] = *(const PG8_LAS bf16x8*)(lds + PG8_SB(b, h) + boff + n * 2048 + k * 1024); } while (0)
#define PG8_MMA(ai, bj, At, Bt) do { __builtin_amdgcn_s_setprio(1); _Pragma("unroll") for (int m = 0; m < 4; ++m) _Pragma("unroll") for (int n = 0; n < 2; ++n) _Pragma("unroll") for (int k = 0; k < 2; ++k) \
        acc[ai][bj][m][n] = __builtin_amdgcn_mfma_f32_16x16x32_bf16(Bt[n][k], At[m][k], acc[ai][bj][m][n], 0, 0, 0); __builtin_amdgcn_s_setprio(0); } while (0)
#define PG8_WAIT_V(n) asm volatile("s_waitcnt vmcnt(" #n ")" ::: "memory")
#define PG8_WAIT_L(n) asm volatile("s_waitcnt lgkmcnt(" #n ")" ::: "memory")
#define PG8_BAR __builtin_amdgcn_s_barrier()
#define PG8_SCHED __builtin_amdgcn_sched_barrier(0)
    Unit cur, nxt; int ui = 0;
    if (!S.next(0, cur)) return;
    f32x4 acc[2][2][4][2];
#pragma unroll
    for (int a = 0; a < 2; ++a)
#pragma unroll
        for (int b = 0; b < 2; ++b)
#pragma unroll
            for (int m = 0; m < 4; ++m)
#pragma unroll
                for (int n = 0; n < 2; ++n) acc[a][b][m][n] = (f32x4){0.f, 0.f, 0.f, 0.f};
    bf16x8 At[4][2], B0[2][2], B1[2][2];
    const char* cA = (const char*)g.A + (size_t)cur.pm * tstep; const char* cB = (const char*)g.Bt + (size_t)cur.pn * tstep;
    S.a_ready(cur);
    if constexpr (SP2) {
        PG8_STAGE(PG8_SB(0, 0), cB, voffB); PG8_STAGE(PG8_SB(0, 1), cB + hstep, voffB); PG8_STAGE(PG8_SA(0, 0), cA, voffA); PG8_STAGE(PG8_SA(0, 1), cA + hstep, voffA);
        if (wr == 1) PG8_BAR;
        PG8_WAIT_V(2); PG8_BAR;
        PG8_STAGE(PG8_SB(1, 0), cB + kstep, voffB); PG8_STAGE(PG8_SA(1, 0), cA + kstep, voffA); PG8_STAGE(PG8_SB(1, 1), cB + hstep + kstep, voffB);
        PG8_WAIT_V(6); PG8_BAR;
    } else {
        PG8_STAGE(PG8_SB(0, 0), cB, voffB); PG8_STAGE(PG8_SA(0, 0), cA, voffA); PG8_STAGE(PG8_SB(0, 1), cB + hstep, voffB); PG8_STAGE(PG8_SA(0, 1), cA + hstep, voffA);
        if (wr == 1) PG8_BAR;
        PG8_WAIT_V(4); PG8_BAR;
        PG8_STAGE(PG8_SB(1, 0), cB + kstep, voffB); PG8_STAGE(PG8_SA(1, 0), cA + kstep, voffA); PG8_STAGE(PG8_SB(1, 1), cB + hstep + kstep, voffB);
        PG8_WAIT_V(6); PG8_BAR;
    }
    for (;;) {
        const bool has_next = S.next(ui + 1, nxt);
        const char* nA = has_next ? (const char*)g.A + (size_t)nxt.pm * tstep : cA; const char* nB = has_next ? (const char*)g.Bt + (size_t)nxt.pn * tstep : cB;
        for (int t = 0; t < nt; t += 2) {
            const bool last = (t == nt - 2);
            const char* a1 = cA + (size_t)(t + 1) * kstep;
            const char* a2 = last ? nA : cA + (size_t)(t + 2) * kstep; const char* b2 = last ? nB : cB + (size_t)(t + 2) * kstep;
            const char* a3 = a2 + kstep; const char* b3 = b2 + kstep;
            if (last && has_next) S.a_ready(nxt);
            if constexpr (SP2) {
            PG8_LDB(B0, 0, 0); PG8_LDB(B1, 0, 1); PG8_SCHED; PG8_LDA(At, 0, 0); PG8_STAGE(PG8_SA(1, 1), a1 + hstep, voffA);
            PG8_WAIT_V(8); PG8_WAIT_L(0); PG8_BAR; PG8_MMA(0, 0, At, B0); PG8_MMA(0, 1, At, B1); PG8_BAR; PG8_SCHED;
            PG8_LDA(At, 0, 1); PG8_STAGE(PG8_SB(0, 0), b2, voffB); PG8_STAGE(PG8_SB(0, 1), b2 + hstep, voffB); PG8_STAGE(PG8_SA(0, 0), a2, voffA);
            PG8_WAIT_V(8); PG8_WAIT_L(0); PG8_BAR; PG8_MMA(1, 0, At, B0); PG8_MMA(1, 1, At, B1); PG8_BAR; PG8_SCHED;
            PG8_LDB(B0, 1, 0); PG8_LDB(B1, 1, 1); PG8_SCHED; PG8_LDA(At, 1, 0); PG8_STAGE(PG8_SA(0, 1), a2 + hstep, voffA);
            PG8_WAIT_V(8); PG8_WAIT_L(0); PG8_BAR; PG8_MMA(0, 0, At, B0); PG8_MMA(0, 1, At, B1); PG8_BAR; PG8_SCHED;
            PG8_LDA(At, 1, 1); PG8_STAGE(PG8_SB(1, 0), b3, voffB); PG8_STAGE(PG8_SB(1, 1), b3 + hstep, voffB); PG8_STAGE(PG8_SA(1, 0), a3, voffA);
            PG8_WAIT_V(8); PG8_WAIT_L(0); PG8_BAR; PG8_MMA(1, 0, At, B0); PG8_MMA(1, 1, At, B1); PG8_BAR; PG8_SCHED;
            } else {
            PG8_LDB(B0, 0, 0); PG8_SCHED; PG8_LDA(At, 0, 0); PG8_STAGE(PG8_SA(1, 1), a1 + hstep, voffA);
            PG8_WAIT_L(8); PG8_BAR; PG8_WAIT_L(0); PG8_MMA(0, 0, At, B0); PG8_BAR; PG8_SCHED;
            PG8_LDB(B1, 0, 1); PG8_STAGE(PG8_SB(0, 0), b2, voffB);
            PG8_BAR; PG8_WAIT_L(0); PG8_MMA(0, 1, At, B1); PG8_BAR;
            PG8_LDA(At, 0, 1); PG8_STAGE(PG8_SA(0, 0), a2, voffA);
            PG8_BAR; PG8_WAIT_L(0); PG8_MMA(1, 0, At, B0); PG8_BAR; PG8_SCHED;
            PG8_STAGE(PG8_SB(0, 1), b2 + hstep, voffB);
            PG8_WAIT_V(6); PG8_BAR; PG8_MMA(1, 1, At, B1); PG8_BAR;
            PG8_LDB(B0, 1, 0); PG8_SCHED; PG8_LDA(At, 1, 0); PG8_STAGE(PG8_SA(0, 1), a2 + hstep, voffA);
            PG8_WAIT_L(8); PG8_BAR; PG8_WAIT_L(0); PG8_MMA(0, 0, At, B0); PG8_BAR; PG8_SCHED;
            PG8_LDB(B1, 1, 1); PG8_STAGE(PG8_SB(1, 0), b3, voffB);
            PG8_BAR; PG8_WAIT_L(0); PG8_MMA(0, 1, At, B1); PG8_BAR;
            PG8_LDA(At, 1, 1); PG8_STAGE(PG8_SA(1, 0), a3, voffA);
            PG8_BAR; PG8_WAIT_L(0); PG8_MMA(1, 0, At, B0); PG8_BAR; PG8_SCHED;
            PG8_STAGE(PG8_SB(1, 1), b3 + hstep, voffB);
            PG8_WAIT_V(6); PG8_BAR; PG8_MMA(1, 1, At, B1); PG8_BAR;
            }
            if constexpr (Epi::HAS_HOOK) { if ((((t + 2) & 7) == 0) && (t + 2 < nt)) E.hook(acc, cur, (t + 2) >> 3, wr, wc, fr, fq); }
        }
        if constexpr (ALIGN_EPI) { if (wr == 0) PG8_BAR; }
        if constexpr (!Epi::AFTER_DRAIN) { E(acc, cur, wr, wc, fr, fq); S.done(cur); }
        if (!has_next) break;
#pragma unroll
        for (int a = 0; a < 2; ++a)
#pragma unroll
            for (int b = 0; b < 2; ++b)
#pragma unroll
                for (int m = 0; m < 4; ++m)
#pragma unroll
                    for (int n = 0; n < 2; ++n) acc[a][b][m][n] = (f32x4){0.f, 0.f, 0.f, 0.f};
        cur = nxt; cA = nA; cB = nB; ++ui;
        if constexpr (ALIGN_EPI) { if (wr == 1) PG8_BAR; }
    }
    PG8_WAIT_V(0);
    if constexpr (!ALIGN_EPI) { if (wr == 0) PG8_BAR; }
    PG8_BAR;
    if constexpr (Epi::AFTER_DRAIN) { E.fused(acc, cur, wr, wc, fr, fq, lds, wid, lane); S.done(cur); }
#undef PG8_SA
#undef PG8_SB
#undef PG8_STAGE
#undef PG8_LDA
#undef PG8_LDB
#undef PG8_MMA
#undef PG8_WAIT_V
#undef PG8_WAIT_L
#undef PG8_BAR
#undef PG8_SCHED
}
}

struct P2Sched {
  int vb, nb, ntiles;
  __device__ __forceinline__ bool next(int i, pg8::Unit& u) const {
    const int t = vb + i * nb; if (t >= ntiles) return false;
    const int band = t / (8 * 33), w = t - band * 8 * 33;
    u.pn = w >> 3; u.pm = band * 8 + (w & 7); return true;
  }
  __device__ __forceinline__ void a_ready(const pg8::Unit&) const {}
  __device__ __forceinline__ void done(const pg8::Unit&) const {}
};
struct P2Epi {
  static constexpr bool PERM = true, AFTER_DRAIN = false, HAS_HOOK = false;
  const float* rope; const float* gq; const float* gk; char* smem;
  bf16_t* U; bf16_t* GP; unsigned* KMAXH; int kbase;
  __device__ __forceinline__ void operator()(const f32x4 (&acc)[2][2][4][2], const pg8::Unit& u, int wr, int wc, int fr, int fq) const {
    if (u.pn >= 21) {
      bf16_t* gb = GP + ((size_t)((u.pm * 12 + (u.pn - 21)) * 8 + (wr * 4 + wc)) * 16) * 512 + (fq * 16 + fr) * 8;
#pragma unroll
      for (int k = 0; k < 16; ++k) {
        const f32x4 v0 = acc[k >> 3][(k >> 2) & 1][k & 3][0], v1 = acc[k >> 3][(k >> 2) & 1][k & 3][1];
        *(u32x4*)(gb + k * 512) = (u32x4){pk_bf16(v0[0], v0[1]), pk_bf16(v0[2], v0[3]), pk_bf16(v1[0], v1[1]), pk_bf16(v1[2], v1[3])};
      }
      return;
    }
    if (u.pn >= 8 && u.pn <= 10) {
      float* XP = (float*)(smem + 131072 + 16 + 5120);
      const bool qtile = u.pn < 10;
#pragma unroll
      for (int ai = 0; ai < 2; ++ai)
#pragma unroll
        for (int m = 0; m < 4; ++m)
#pragma unroll
          for (int bj = 0; bj < 2; ++bj) {
            const f32x4 v0 = acc[ai][bj][m][0], v1 = acc[ai][bj][m][1];
            float ss = (v0[0] * v0[0] + v0[1] * v0[1]) + (v0[2] * v0[2] + v0[3] * v0[3]) + (v1[0] * v1[0] + v1[1] * v1[1]) + (v1[2] * v1[2] + v1[3] * v1[3]);
            ss += __shfl_xor(ss, 16); ss += __shfl_xor(ss, 32);
            if (fq == 0) XP[((128 * ai + 64 * wr + 16 * m + fr) * 2 + bj) * 4 + wc] = ss;
          }
      __syncthreads();
      const float* gsrc = (qtile ? gq : gk) + 32 * (wc & 1) + 8 * fq;
      const float qs = qtile ? (LOG2E * 0.125f) : 1.0f;
      const f32x4 ga = *(const f32x4*)gsrc * qs, gb4 = *(const f32x4*)(gsrc + 4) * qs;
      const float sgn = ((fq >> 1) & 1) ? 1.0f : -1.0f;
      const int rowl0 = 64 * wr + fr, colg = u.pn * 256 + wc * 32 + 8 * fq;
#pragma unroll
      for (int ai = 0; ai < 2; ++ai)
#pragma unroll
        for (int m = 0; m < 4; ++m) {
          const int rl = 128 * ai + 16 * m + rowl0;
          const int tt = (u.pm * 256 + rl) & (SEQ - 1);
          const int pos = (wc & 1) ? (tt & 63) : (tt >> 6);
          const float* ct = rope + pos * 16 + 8 * (fq & 1);
          const f32x4 c0 = *(const f32x4*)ct, c1 = *(const f32x4*)(ct + 4), s0 = *(const f32x4*)(ct + 1024), s1 = *(const f32x4*)(ct + 1028);
#pragma unroll
          for (int bj = 0; bj < 2; ++bj) {
            f32x4 v0 = acc[ai][bj][m][0], v1 = acc[ai][bj][m][1];
            if (qtile || bj == 0) {
              const float* xp = XP + (rl * 2 + bj) * 4 + (wc & 2);
              const float rs = rsqrtf((xp[0] + xp[1]) * (1.0f / 64.0f) + EPS);
              v0 = v0 * rs * ga; v1 = v1 * rs * gb4;
              f32x4 p0, p1;
#pragma unroll
              for (int e = 0; e < 4; ++e) { p0[e] = __shfl_xor(v0[e], 32); p1[e] = __shfl_xor(v1[e], 32); }
              v0 = v0 * c0 + sgn * (p0 * s0); v1 = v1 * c1 + sgn * (p1 * s1);
            }
            *(u32x4*)(U + (size_t)(u.pm * 256 + rl) * UP + colg + bj * 128) = (u32x4){pk_bf16(v0[0], v0[1]), pk_bf16(v0[2], v0[3]), pk_bf16(v1[0], v1[1]), pk_bf16(v1[2], v1[3])};
          }
        }
      __syncthreads();
      return;
    }
    const float sc = (u.pn == 0 || u.pn == 1 || u.pn == 13 || u.pn == 14) ? (LOG2E * 0.125f) : 1.0f;
    const bool akt = (u.pn == 2) || (u.pn == 3);
    const int row0 = u.pm * 256 + wr * 64 + fr, col0 = u.pn * 256 + wc * 32 + 8 * fq;
    float kmx0 = 0.f, kmx1 = 0.f;
#pragma unroll
    for (int ai = 0; ai < 2; ++ai)
#pragma unroll
      for (int m = 0; m < 4; ++m) {
        bf16_t* rowp = U + (size_t)(row0 + ai * 128 + m * 16) * UP + col0;
#pragma unroll
        for (int bj = 0; bj < 2; ++bj) {
          const f32x4 v0 = acc[ai][bj][m][0] * sc, v1 = acc[ai][bj][m][1] * sc;
          const u32x4 w = (u32x4){pk_bf16(v0[0], v0[1]), pk_bf16(v0[2], v0[3]), pk_bf16(v1[0], v1[1]), pk_bf16(v1[2], v1[3])};
          *(u32x4*)(rowp + bj * 128) = w;
          if (akt) {
            float ss = 0.f;
#pragma unroll
            for (int e = 0; e < 4; ++e) { const float a0 = bflo(w[e]), a1 = bfhi(w[e]); ss += a0 * a0 + a1 * a1; }
            ss += __shfl_xor(ss, 16); ss += __shfl_xor(ss, 32);
            if (bj == 0) kmx0 = fmaxf(kmx0, ss); else kmx1 = fmaxf(kmx1, ss);
          }
        }
      }
    if (akt) {
#pragma unroll
      for (int o_ = 1; o_ <= 8; o_ <<= 1) { kmx0 = fmaxf(kmx0, __shfl_xor(kmx0, o_)); kmx1 = fmaxf(kmx1, __shfl_xor(kmx1, o_)); }
      if (fr == 0 && fq == 0) {
        unsigned* kp = KMAXH + kbase + (u.pm >> 4) * 16 + ((u.pn - 2) * 4 + (wc >> 1)) * 2 + (wc & 1);
        atomicMax(kp, __float_as_uint(kmx0));
        atomicMax(kp + 4, __float_as_uint(kmx1));
      }
    }
  }
};

DI void gemm_accT(f32x4 (&acc)[2][2][4][2], const bf16_t* Aptr, int lda, const bf16_t* Wt, int ldw, int K, char* smem) {
  constexpr int A_BYTES = 32768, STG = 65536;
  const int tid = opaque_tid(), lane = tid & 63, wave = __builtin_amdgcn_readfirstlane(tid >> 6), wr = wave >> 2, wc = wave & 3, r16 = lane & 15, q = lane >> 4;
  const int drow = wave * 8 + (lane >> 3);
  const int dch = (lane & 7) ^ ((drow >> 1) & 7);
  const bf16_t* wsrc = Wt + (size_t)drow * ldw + dch * 8;
  const bf16_t* asrc = Aptr + (size_t)drow * lda + dch * 8;
  auto issue = [&](int kt, int buf) {
    char* sa = smem + buf * STG + wave * 1024;
    char* sb = sa + A_BYTES;
#pragma unroll
    for (int j = 0; j < 4; ++j) dma16(asrc + (size_t)(64 * j) * lda + kt * 64, sa + j * 8192);
#pragma unroll
    for (int j = 0; j < 4; ++j) dma16(wsrc + (size_t)(64 * j) * ldw + kt * 64, sb + j * 8192);
  };
  const int nk = K >> 6;
  const int xa = (r16 >> 1) & 7;
  const int a_base = (64 * wr + r16) * 128;
  const int wrow0 = 32 * wc + 8 * (r16 >> 2) + (r16 & 3);
  __syncthreads();
  issue(0, 0);
  for (int kt = 0; kt < nk; ++kt) {
    dma_sync();
    if (kt + 1 < nk) issue(kt + 1, (kt + 1) & 1);
    const char* st = smem + (kt & 1) * STG;
#pragma unroll
    for (int ks = 0; ks < 2; ++ks) {
      const int chunk = 4 * ks + q;
      bf16x8 afr[2][4], wfr[2][2];
#pragma unroll
      for (int ai = 0; ai < 2; ++ai)
#pragma unroll
        for (int m = 0; m < 4; ++m) afr[ai][m] = *(const bf16x8*)(st + a_base + (128 * ai + 16 * m) * 128 + ((chunk ^ xa) << 4));
#pragma unroll
      for (int bj = 0; bj < 2; ++bj)
#pragma unroll
        for (int n = 0; n < 2; ++n) {
          const int wrow = wrow0 + 128 * bj + 4 * n;
          wfr[bj][n] = *(const bf16x8*)(st + A_BYTES + wrow * 128 + ((chunk ^ ((wrow >> 1) & 7)) << 4));
        }
#pragma unroll
      for (int ai = 0; ai < 2; ++ai)
#pragma unroll
        for (int m = 0; m < 4; ++m)
#pragma unroll
          for (int bj = 0; bj < 2; ++bj)
#pragma unroll
            for (int n = 0; n < 2; ++n) acc[ai][bj][m][n] = __builtin_amdgcn_mfma_f32_16x16x32_bf16(wfr[bj][n], afr[ai][m], acc[ai][bj][m][n], 0, 0, 0);
    }
  }
}

struct P7Sched {
  int vb, nb, ntiles;
  __device__ __forceinline__ bool next(int i, pg8::Unit& u) const {
    const int t = vb + i * nb; if (t >= ntiles) return false;
    const int band = t >> 5, w = t & 31; u.pn = w >> 3; u.pm = band * 8 + (w & 7); return true;
  }
  __device__ __forceinline__ void a_ready(const pg8::Unit&) const {}
  __device__ __forceinline__ void done(const pg8::Unit&) const {}
};
struct P7Epi {
  static constexpr bool PERM = true, AFTER_DRAIN = false, HAS_HOOK = false;
  const float* xres; float* xout; bf16_t* H; const float* g; float* XCH; unsigned* XCNT; unsigned want; char* smem;
  __device__ __forceinline__ void operator()(const f32x4 (&acc)[2][2][4][2], const pg8::Unit& u, int wr, int wc, int fr, int fq) const {
    float* PT = (float*)(smem + 131072 + 16);
    float* RT = PT + 1024;
    const int tid = (wr * 4 + wc) * 64 + fq * 16 + fr;
    u32x4 zw[2][4][2];
#pragma unroll
    for (int ai = 0; ai < 2; ++ai)
#pragma unroll
      for (int m = 0; m < 4; ++m) {
        float ss = 0.f;
#pragma unroll
        for (int bj = 0; bj < 2; ++bj) {
          const f32x4 v0 = acc[ai][bj][m][0], v1 = acc[ai][bj][m][1];
          const u32x4 w = (u32x4){pk_bf16(v0[0], v0[1]), pk_bf16(v0[2], v0[3]), pk_bf16(v1[0], v1[1]), pk_bf16(v1[2], v1[3])};
          zw[ai][m][bj] = w;
#pragma unroll
          for (int e = 0; e < 4; ++e) { const float a0 = bflo(w[e]), a1 = bfhi(w[e]); ss += a0 * a0 + a1 * a1; }
        }
        ss += __shfl_xor(ss, 16); ss += __shfl_xor(ss, 32);
        if (fq == 0) PT[(128 * ai + 64 * wr + 16 * m + fr) * 4 + wc] = ss;
      }
    __syncthreads();
    float* xrow = XCH + ((size_t)u.pm * 256 + (tid & 255)) * 4;
    if (tid < 256) {
      const f32x4 q = *(const f32x4*)(PT + tid * 4);
      __hip_atomic_store(xrow + u.pn, (q[0] + q[1]) + (q[2] + q[3]), __ATOMIC_RELAXED, __HIP_MEMORY_SCOPE_AGENT);
    }
    asm volatile("s_waitcnt vmcnt(0)" ::: "memory");
    __syncthreads();
    if (tid == 0) {
      unsigned* c = XCNT + u.pm;
      __hip_atomic_fetch_add(c, 1u, __ATOMIC_RELAXED, __HIP_MEMORY_SCOPE_AGENT);
      unsigned sp = 0;
      while (__hip_atomic_load(c, __ATOMIC_RELAXED, __HIP_MEMORY_SCOPE_AGENT) < want) { __builtin_amdgcn_s_sleep(2); if (++sp > (1u << 22)) break; }
    }
    __syncthreads();
    if (tid < 256) {
      float s = 0.f;
#pragma unroll
      for (int e = 0; e < 4; ++e) s += __hip_atomic_load(xrow + e, __ATOMIC_RELAXED, __HIP_MEMORY_SCOPE_AGENT);
      RT[tid] = rsqrtf(s * (1.0f / DM) + EPS);
    }
    __syncthreads();
    const int col0 = u.pn * 256 + wc * 32 + 8 * fq;
#pragma unroll
    for (int bj = 0; bj < 2; ++bj) {
      const f32x4 g0 = *(const f32x4*)(g + col0 + 128 * bj), g1 = *(const f32x4*)(g + col0 + 128 * bj + 4);
#pragma unroll
      for (int ai = 0; ai < 2; ++ai)
#pragma unroll
        for (int m = 0; m < 4; ++m) {
          const int rl = 128 * ai + 64 * wr + 16 * m + fr;
          const float rs = RT[rl];
          const size_t off = (size_t)(u.pm * 256 + rl) * DM + col0 + 128 * bj;
          const u32x4 v = zw[ai][m][bj];
          const f32x4 x0 = *(const f32x4*)(xres + off), x1v = *(const f32x4*)(xres + off + 4);
          f32x4 o0, o1;
          o0[0] = x0[0] + bflo(v[0]) * rs * g0[0]; o0[1] = x0[1] + bfhi(v[0]) * rs * g0[1]; o0[2] = x0[2] + bflo(v[1]) * rs * g0[2]; o0[3] = x0[3] + bfhi(v[1]) * rs * g0[3];
          o1[0] = x1v[0] + bflo(v[2]) * rs * g1[0]; o1[1] = x1v[1] + bfhi(v[2]) * rs * g1[1]; o1[2] = x1v[2] + bflo(v[3]) * rs * g1[2]; o1[3] = x1v[3] + bfhi(v[3]) * rs * g1[3];
          *(f32x4*)(xout + off) = o0; *(f32x4*)(xout + off + 4) = o1;
          *(u32x4*)(H + off) = (u32x4){pk_bf16(o0[0], o0[1]), pk_bf16(o0[2], o0[3]), pk_bf16(o1[0], o1[1]), pk_bf16(o1[2], o1[3])};
        }
    }
    __syncthreads();
  }
};

struct P9Sched {
  int vb, nb, ntiles;
  __device__ __forceinline__ bool next(int i, pg8::Unit& u) const {
    const int t = vb + i * nb; if (t >= ntiles) return false;
    const int band = t >> 5, w = t & 31; u.pn = w >> 3; u.pm = band * 8 + (w & 7); return true;
  }
  __device__ __forceinline__ void a_ready(const pg8::Unit&) const {}
  __device__ __forceinline__ void done(const pg8::Unit&) const {}
};
struct PEPSched {
  int hv, hb, ntiles;
  __device__ __forceinline__ bool next(int i, pg8::Unit& u) const {
    if (hv < 0) return false;
    const int t = hv + i * hb; if (t >= ntiles) return false;
    const int band = t >> 5, w = t & 31; u.pn = w >> 3; u.pm = band * 8 + (w & 7); return true;
  }
  __device__ __forceinline__ void a_ready(const pg8::Unit&) const {}
  __device__ __forceinline__ void done(const pg8::Unit&) const {}
};
struct PEPEpi {
  static constexpr bool PERM = true, AFTER_DRAIN = false, HAS_HOOK = false;
  bf16_t* PE;
  __device__ __forceinline__ void operator()(const f32x4 (&acc)[2][2][4][2], const pg8::Unit& u, int wr, int wc, int fr, int fq) const {
    bf16_t* base = PE + (size_t)(u.pm * 256 + wr * 64 + fr) * DM + u.pn * 256 + wc * 32 + 8 * fq;
#pragma unroll
    for (int ai = 0; ai < 2; ++ai)
#pragma unroll
      for (int m = 0; m < 4; ++m)
#pragma unroll
        for (int bj = 0; bj < 2; ++bj) {
          const f32x4 v0 = acc[ai][bj][m][0], v1 = acc[ai][bj][m][1];
          *(u32x4*)(base + (size_t)(ai * 128 + m * 16) * DM + bj * 128) = (u32x4){pk_bf16(v0[0], v0[1]), pk_bf16(v0[2], v0[3]), pk_bf16(v1[0], v1[1]), pk_bf16(v1[2], v1[3])};
        }
  }
};
struct P9EpiX {
  static constexpr bool PERM = true, AFTER_DRAIN = false, HAS_HOOK = false;
  const bf16_t* PE; float* xout;
  __device__ __forceinline__ void operator()(const f32x4 (&acc)[2][2][4][2], const pg8::Unit& u, int wr, int wc, int fr, int fq) const {
    const unsigned base = (unsigned)(u.pm * 256 + wr * 64 + fr) * DM + u.pn * 256 + wc * 32 + 8 * fq;
    u32x4 zw[2][4][2];
#pragma unroll
    for (int ai = 0; ai < 2; ++ai)
#pragma unroll
      for (int m = 0; m < 4; ++m)
#pragma unroll
        for (int bj = 0; bj < 2; ++bj) {
          f32x4 v0 = acc[ai][bj][m][0], v1 = acc[ai][bj][m][1];
#pragma unroll
          for (int e = 0; e < 4; ++e) { v0[e] = __builtin_amdgcn_rcpf(1.0f + __expf(-v0[e])); v1[e] = __builtin_amdgcn_rcpf(1.0f + __expf(-v1[e])); }
          zw[ai][m][bj] = (u32x4){pk_bf16(v0[0], v0[1]), pk_bf16(v0[2], v0[3]), pk_bf16(v1[0], v1[1]), pk_bf16(v1[2], v1[3])};
        }
#pragma unroll
    for (int ai = 0; ai < 2; ++ai)
#pragma unroll
      for (int m = 0; m < 4; ++m)
#pragma unroll
        for (int bj = 0; bj < 2; ++bj) {
          const unsigned off = base + (unsigned)((ai * 128 + m * 16) * DM + bj * 128);
          const u32x4 g = zw[ai][m][bj];
          const u32x4 pw = *(const u32x4*)(PE + off);
          f32x4 x0 = *(const f32x4*)(xout + off), x1v = *(const f32x4*)(xout + off + 4);
          x0[0] += bflo(g[0]) * bflo(pw[0]); x0[1] += bfhi(g[0]) * bfhi(pw[0]); x0[2] += bflo(g[1]) * bflo(pw[1]); x0[3] += bfhi(g[1]) * bfhi(pw[1]);
          x1v[0] += bflo(g[2]) * bflo(pw[2]); x1v[1] += bfhi(g[2]) * bfhi(pw[2]); x1v[2] += bflo(g[3]) * bflo(pw[3]); x1v[3] += bfhi(g[3]) * bfhi(pw[3]);
          *(f32x4*)(xout + off) = x0; *(f32x4*)(xout + off + 4) = x1v;
          asm volatile("" ::: "memory");
        }
  }
};

struct P6Epi {
  static constexpr bool PERM = true, AFTER_DRAIN = false, HAS_HOOK = true;
  const bf16_t* GP; bf16_t* M;
  __device__ __forceinline__ void rescale(f32x4 (&acc)[2][2][4][2], const pg8::Unit& u, int j, bool last, int wr, int wc, int fr, int fq) const {
    const unsigned ga = (unsigned)(((u.pm * 12 + 4 * j + u.pn) * 8 + (wr * 4 + wc)) * 16) * 512u + (unsigned)(fq * 16 + fr) * 8u;
    const unsigned gb = last ? ga : ga + 4u * 8u * 16u * 512u;
    const float fl = last ? 0.0f : 1.0f;
#pragma unroll
    for (int k = 0; k < 16; ++k) {
      const u32x4 wa = *(const u32x4*)(GP + ga + k * 512), wb = *(const u32x4*)(GP + gb + k * 512);
#pragma unroll
      for (int q = 0; q < 8; ++q) {
        const float av = (q & 1) ? bfhi(wa[q >> 1]) : bflo(wa[q >> 1]), bv = (q & 1) ? bfhi(wb[q >> 1]) : bflo(wb[q >> 1]);
        const float ea = __expf(-av), eb = __expf(-bv) * fl;
        acc[k >> 3][(k >> 2) & 1][k & 3][q >> 2][q & 3] *= (1.0f + eb) * __builtin_amdgcn_rcpf(1.0f + ea);
      }
      asm volatile("" ::: "memory");
    }
  }
  __device__ __forceinline__ void hook(f32x4 (&acc)[2][2][4][2], const pg8::Unit& u, int seam, int wr, int wc, int fr, int fq) const { rescale(acc, u, seam - 1, false, wr, wc, fr, fq); }
  __device__ __forceinline__ void operator()(f32x4 (&acc)[2][2][4][2], const pg8::Unit& u, int wr, int wc, int fr, int fq) const {
    rescale(acc, u, 2, true, wr, wc, fr, fq);
    bf16_t* mb = M + (size_t)(u.pm * 256 + 64 * wr + fr) * DM + u.pn * 256 + 32 * wc + 8 * fq;
#pragma unroll
    for (int ai = 0; ai < 2; ++ai)
#pragma unroll
      for (int m = 0; m < 4; ++m)
#pragma unroll
        for (int bj = 0; bj < 2; ++bj) {
          const f32x4 v0 = acc[ai][bj][m][0], v1 = acc[ai][bj][m][1];
          *(u32x4*)(mb + (size_t)(128 * ai + 16 * m) * DM + 128 * bj) = (u32x4){pk_bf16(v0[0], v0[1]), pk_bf16(v0[2], v0[3]), pk_bf16(v1[0], v1[1]), pk_bf16(v1[2], v1[3])};
        }
  }
};

#define XB_TMO      128
#define XB_XCNT(j)  (256  + 64 * (j))
#define XB_XSUB(j)  (1280 + 64 * (j))
#define XB_XGEN(j)  (2304 + 64 * (j))
#define XB_TOP      3328
#define XB_TOPGEN   3392
#define XCD_BAR_WORDS 3456
#define XB_SPIN_CAP (1u << 20)
DI unsigned xb_ld(unsigned* p) { return __hip_atomic_load(p, __ATOMIC_RELAXED, __HIP_MEMORY_SCOPE_AGENT); }
DI unsigned xb_add(unsigned* p, unsigned v) { return __hip_atomic_fetch_add(p, v, __ATOMIC_RELAXED, __HIP_MEMORY_SCOPE_AGENT); }
DI unsigned xb_xcc_id() { return (unsigned)__builtin_amdgcn_s_getreg((3 << 11) | 20) & 0xFu; }
#define XB_SPIN(cond, bar) do { unsigned _sp = 0; while (cond) { __builtin_amdgcn_s_sleep(1); \
    if ((++_sp & 255u) == 0u) { if (xb_ld(&(bar)[XB_TMO])) break; if (_sp > XB_SPIN_CAP) { atomicAdd(&(bar)[XB_TMO], 1u); break; } } } } while (0)
struct XcdBarrier { unsigned* bar; unsigned x; volatile LDSAS unsigned* st; };
DI XcdBarrier xcd_barrier_post(unsigned* bar, volatile LDSAS unsigned* st) {
  XcdBarrier b; b.bar = bar; b.x = xb_xcc_id(); b.st = st;
  if (threadIdx.x == 0) (void)xb_add(&bar[XB_XCNT(b.x)], 1u);
  return b;
}
DI void xcd_barrier_complete(unsigned* bar, unsigned x, unsigned& nloc, unsigned& nx) {
  const unsigned Gn = gridDim.x * gridDim.y * gridDim.z;
  unsigned sum, cnt, mine, sp = 0u;
  for (;;) {
    sum = 0u; cnt = 0u; mine = 0u;
#pragma unroll
    for (unsigned j = 0; j < 16; ++j) { const unsigned c = xb_ld(&bar[XB_XCNT(j)]); sum += c; cnt += (c > 0u) ? 1u : 0u; mine = (j == x) ? c : mine; }
    if (sum == Gn) break;
    __builtin_amdgcn_s_sleep(1);
    if ((++sp & 255u) == 0u) { if (xb_ld(&bar[XB_TMO])) break; if (sp > XB_SPIN_CAP) { atomicAdd(&bar[XB_TMO], 1u); break; } }
  }
  nloc = mine > 0u ? mine : 1u; nx = cnt > 0u ? cnt : 1u;
}
DI void xcd_barrier(const XcdBarrier& b) {
  asm volatile("s_waitcnt vmcnt(0)" ::: "memory");
  __syncthreads();
  if (threadIdx.x == 0) {
    unsigned* bar = b.bar;
    __builtin_amdgcn_s_waitcnt(0);
    unsigned nloc = b.st[0], nx = b.st[1];
    if (nloc == 0u) { xcd_barrier_complete(bar, b.x, nloc, nx); b.st[0] = nloc; b.st[1] = nx; }
    const unsigned old = xb_add(&bar[XB_XSUB(b.x)], 1u);
    const unsigned gen = old / nloc;
    if (old + 1u == (gen + 1u) * nloc) {
      __builtin_amdgcn_fence(__ATOMIC_RELEASE, "agent");
      asm volatile("s_waitcnt vmcnt(0)" ::: "memory");
      const unsigned og = xb_add(&bar[XB_TOP], 1u);
      const unsigned tg = og / nx;
      if (og + 1u == (tg + 1u) * nx) xb_add(&bar[XB_TOPGEN], 1u);
      else XB_SPIN(xb_ld(&bar[XB_TOPGEN]) == tg, bar);
      __builtin_amdgcn_fence(__ATOMIC_ACQUIRE, "agent");
      xb_add(&bar[XB_XGEN(b.x)], 1u);
      asm volatile("s_waitcnt vmcnt(0)" ::: "memory");
    } else {
      XB_SPIN(xb_ld(&bar[XB_XGEN(b.x)]) == gen, bar);
      __builtin_amdgcn_fence(__ATOMIC_ACQUIRE, "agent");
      asm volatile("s_waitcnt vmcnt(0)" ::: "memory");
    }
  }
  __syncthreads();
}

constexpr int LDS_BYTES = 131072 + 16 + 5120 + 8192;
__global__ void __launch_bounds__(512, 2) fwd_kernel(Params p) {
  extern __shared__ __attribute__((aligned(16))) char smem[];
  cg::grid_group grid = cg::this_grid();
  const int nb = gridDim.x, bid = blockIdx.x;
  volatile LDSAS unsigned* xb_st = (volatile LDSAS unsigned*)(smem + 131072);
  if (threadIdx.x == 0) { xb_st[0] = 0u; xb_st[1] = 0u; xb_st[2] = 0u; xb_st[3] = 0u; }
  __syncthreads();
  const XcdBarrier xb = xcd_barrier_post((unsigned*)(p.ws + WS_BAR), xb_st);
#define GSYNC() xcd_barrier(xb)
  const int vb = (bid & 7) * (nb >> 3) + (bid >> 3);
  const int nw = nb * 8;
#define PHASE_IDS const int tid = opaque_tid(), lane = tid & 63, wave = tid >> 6, gw = vb * 8 + wave; (void)lane; (void)gw;
  unsigned char* ws = p.ws;
  bf16_t* WIN = (bf16_t*)(ws + WS_WIN);
  bf16_t* WBR = (bf16_t*)(ws + WS_WBR);
  bf16_t* WOUT = (bf16_t*)(ws + WS_WOUT);
  bf16_t* WPG = (bf16_t*)(ws + WS_WPG);
  bf16_t* WPE = (bf16_t*)(ws + WS_WPE);
  float* ROPE = (float*)(ws + WS_ROPE);
  bf16_t* U = (bf16_t*)(ws + WS_U);
  bf16_t* H = (bf16_t*)(ws + WS_H);
  bf16_t* OA = (bf16_t*)(ws + WS_OA);
  bf16_t* Y = (bf16_t*)(ws + WS_Y);
  bf16_t* M = (bf16_t*)(ws + WS_M);
  bf16_t* Zb = (bf16_t*)(ws + WS_Z);
  bf16_t* GP = (bf16_t*)(ws + WS_GP);
  float* XCH = (float*)(ws + WS_XCH);
  bf16_t* PB = (bf16_t*)(ws + WS_PB);
  bf16_t* PE = (bf16_t*)(ws + WS_PE);
  unsigned* KMAX = (unsigned*)(ws + WS_KMAX);
  unsigned* XCNT = (unsigned*)(ws + WS_BAR) + 3584;

  {
        PHASE_IDS
    for (int t = bid; t < 4 * 3072; t += nb) {
      const int layer = t / 3072;
      int r = t - layer * 3072;
      if (r < 2112) {
        transpose_tile(p.in[6] + (size_t)layer * DM * INW, WIN + (size_t)layer * INW * DM, DM, INW, r / 132, r % 132, smem);
      } else if (r < 2112 + 384) {
        r -= 2112;
        const int j = r / 128; r -= j * 128;
        transpose_tile(p.in[12 + j] + (size_t)layer * 512 * DM, WBR + (size_t)layer * DM * 1536 + 512 * j, 512, DM, r / 16, r % 16, smem, 1536);
      } else if (r < 2112 + 384 + 256) {
        r -= 2112 + 384;
        transpose_tile(p.in[15] + (size_t)layer * DM * DM, WOUT + (size_t)layer * DM * DM, DM, DM, r / 16, r % 16, smem);
      } else if (r < 2112 + 384 + 512) {
        r -= 2112 + 384 + 256;
        transpose_tile(p.in[18] + (size_t)layer * DM * DM, WPG + (size_t)layer * DM * DM, DM, DM, r / 16, r % 16, smem);
      } else {
        r -= 2112 + 384 + 512;
        transpose_tile(p.in[17] + (size_t)layer * DPLE * DM, WPE + (size_t)layer * DM * DPLE, DPLE, DM, r / 16, r % 16, smem);
      }
    }
    if (bid < 2) {
      const int i = bid * 512 + tid;
      const int pos = i >> 4, f = i & 15;
      const float inv = powf(10000.0f, -(float)f / 16.0f);
      const float ang = (float)pos * inv;
      ROPE[i] = cosf(ang);
      ROPE[1024 + i] = sinf(ang);
    }
  }
  grid.sync();

  for (int gi = 0; gi < NG; ++gi) {
    const int seq0 = gi * G;
    const bool is_prompt = seq0 < 16;
    const float* xin = is_prompt ? p.in[0] + (size_t)seq0 * SEQ * DM : p.in[1] + (size_t)(seq0 - 16) * SEQ * DM;
    float* xout = p.out + (size_t)seq0 * SEQ * DM;
    for (int layer = 0; layer < NL; ++layer) {
      const float* xres = (layer == 0) ? xin : (const float*)xout;
      const float* pin = is_prompt ? p.in[2] + ((size_t)layer * 16 + seq0) * SEQ * DPLE : p.in[3] + ((size_t)layer * 8 + (seq0 - 16)) * SEQ * DPLE;
      const bf16_t* win = WIN + (size_t)layer * INW * DM;
      const bf16_t* wbr = WBR + (size_t)layer * DM * 1536;
      const bf16_t* wout = WOUT + (size_t)layer * DM * DM;
      const bf16_t* wpg = WPG + (size_t)layer * DM * DM;
      const bf16_t* wpe = WPE + (size_t)layer * DM * DPLE;

      {
        PHASE_IDS
        const float* g = p.in[5] + layer * DM;
        f32x4 gv[4];
#pragma unroll
        for (int j = 0; j < 4; ++j) gv[j] = *(const f32x4*)(g + 4 * (lane + 64 * j));
        for (int row0 = gw; row0 < TG; row0 += 4 * nw) {
          f32x4 v[4][4];
#pragma unroll
          for (int r = 0; r < 4; ++r) {
            const int row = min(row0 + r * nw, TG - 1);
#pragma unroll
            for (int j = 0; j < 4; ++j) v[r][j] = __builtin_nontemporal_load((const f32x4*)(xres + (size_t)row * DM + 4 * (lane + 64 * j)));
          }
#pragma unroll
          for (int r = 0; r < 4; ++r) {
            const int row = row0 + r * nw;
            float ss = 0.f;
#pragma unroll
            for (int j = 0; j < 4; ++j) ss += v[r][j][0] * v[r][j][0] + v[r][j][1] * v[r][j][1] + v[r][j][2] * v[r][j][2] + v[r][j][3] * v[r][j][3];
            ss = wave_sum(ss);
            const float rstd = rsqrtf(ss * (1.0f / DM) + EPS);
            if (row < TG) {
#pragma unroll
              for (int j = 0; j < 4; ++j)
                *(u32x2*)(H + (size_t)row * DM + 4 * (lane + 64 * j)) =
                    (u32x2){pk_bf16(v[r][j][0] * rstd * gv[j][0], v[r][j][1] * rstd * gv[j][1]), pk_bf16(v[r][j][2] * rstd * gv[j][2], v[r][j][3] * rstd * gv[j][3])};
              const f32x4 pv = __builtin_nontemporal_load((const f32x4*)(pin + (size_t)row * DPLE + lane * 4));
              *(u32x2*)(PB + (size_t)row * DPLE + lane * 4) = (u32x2){pk_bf16(pv[0], pv[1]), pk_bf16(pv[2], pv[3])};
            }
          }
        }
      }
      GSYNC();
      {
        const int ntp2 = (TG / 256) * 33;
        const int rem = ntp2 % nb;
        PEPSched SP; SP.hb = rem ? nb - rem : nb; SP.hv = rem ? vb - rem : vb; SP.ntiles = (TG / 256) * 4;
        PEPEpi EP; EP.PE = PE;
        pg8::Gemm gp; gp.A = PB; gp.Bt = wpe; gp.M = TG; gp.N = DM; gp.K = DPLE;
        pg8::gemm_phase<PEPEpi, PEPSched, false, true>((PG8_LAS unsigned char*)smem, gp, SP, EP);
      }
      {
        P2Sched S2; S2.vb = vb; S2.nb = nb; S2.ntiles = (TG / 256) * 33;
        P2Epi E2; E2.U = U; E2.GP = GP; E2.KMAXH = KMAX; E2.rope = ROPE; E2.gq = p.in[9] + layer * 64; E2.gk = p.in[10] + layer * 64; E2.smem = smem; E2.kbase = (gi * NL + layer) * G * 16;
        pg8::Gemm g2; g2.A = H; g2.Bt = win; g2.M = TG; g2.N = INW; g2.K = DM;
        pg8::gemm_phase<P2Epi, P2Sched, true, true>((PG8_LAS unsigned char*)smem, g2, S2, E2);
      }
      GSYNC();
      {
        PHASE_IDS
        const float* rpb = p.in[11] + (size_t)layer * 8 * 465;
        const int nu = G * 8 * 16;
        int t = vb;
        for (; t < nu; t += nb) attn_unit<0>(U, OA, Y, t >> 7, (t >> 4) & 7, t & 15, p.in[4], rpb, smem, nullptr, nullptr, __uint_as_float(__hip_atomic_load(KMAX + (((gi * NL + layer) * G + (t >> 7)) * 16 + ((t >> 4) & 7) * 2), __ATOMIC_RELAXED, __HIP_MEMORY_SCOPE_AGENT)) +
                                                       __uint_as_float(__hip_atomic_load(KMAX + (((gi * NL + layer) * G + (t >> 7)) * 16 + ((t >> 4) & 7) * 2 + 1), __ATOMIC_RELAXED, __HIP_MEMORY_SCOPE_AGENT)));
        for (; t < 2 * nu; t += nb) { const int r = t - nu; attn_unit<1>(U, OA, Y, r >> 7, (r >> 4) & 7, r & 15, p.in[4], rpb, smem, p.in[9] + layer * 64, p.in[10] + layer * 64); }
        for (; t < 3 * nu; t += nb) { const int r = t - 2 * nu; attn_unit<2>(U, OA, Y, r >> 7, (r >> 4) & 7, r & 15, p.in[4], rpb, smem); }
      }
      GSYNC();
      {
        PHASE_IDS
        const float* lp = p.in[7] + layer * 256;
        const float li = p.lambda_init[layer];
        const float s1 = wave_sum(lp[lane] * lp[64 + lane]), s2 = wave_sum(lp[128 + lane] * lp[192 + lane]);
        const float lam = __expf(s1) - __expf(s2) + li;
        const float* sg = p.in[8] + layer * 128 + (lane & 15) * 8;
        float sgv[8];
#pragma unroll
        for (int e = 0; e < 8; ++e) sgv[e] = sg[e] * (1.0f - li);
        const int hh = lane >> 4, dd = (lane & 15) * 8;
        for (int row0 = gw; row0 < TG; row0 += 4 * nw) {
          u32x4 a0[4], a1[4], gt[4];
#pragma unroll
          for (int r = 0; r < 4; ++r) {
            const int row = min(row0 + r * nw, TG - 1);
            a0[r] = __builtin_nontemporal_load((const u32x4*)(OA + (size_t)row * DM + hh * 256 + dd));
            a1[r] = __builtin_nontemporal_load((const u32x4*)(OA + (size_t)row * DM + hh * 256 + 128 + dd));
            gt[r] = __builtin_nontemporal_load((const u32x4*)(U + (size_t)row * UP + C_AG + lane * 8));
          }
#pragma unroll
          for (int r = 0; r < 4; ++r) {
            const int row = row0 + r * nw;
            float dv[8];
            float ss = 0.f;
#pragma unroll
            for (int e = 0; e < 4; ++e) {
              dv[2 * e] = bflo(a0[r][e]) - lam * bflo(a1[r][e]);
              dv[2 * e + 1] = bfhi(a0[r][e]) - lam * bfhi(a1[r][e]);
              ss += dv[2 * e] * dv[2 * e] + dv[2 * e + 1] * dv[2 * e + 1];
            }
            ss += __shfl_xor(ss, 1); ss += __shfl_xor(ss, 2); ss += __shfl_xor(ss, 4); ss += __shfl_xor(ss, 8);
            const float rstd = rsqrtf(ss * (1.0f / 128.0f) + EPS);
            u32x4 ow;
#pragma unroll
            for (int e = 0; e < 4; ++e)
              ow[e] = pk_bf16(dv[2 * e] * rstd * sgv[2 * e] * siluf_(bflo(gt[r][e])), dv[2 * e + 1] * rstd * sgv[2 * e + 1] * siluf_(bfhi(gt[r][e])));
            if (row < TG) {
              *(u32x4*)(Y + (size_t)row * 1536 + lane * 8) = ow;
            }
          }
        }
      }
      GSYNC();
      {
        P7Sched S6; S6.vb = vb; S6.nb = nb; S6.ntiles = (TG / 256) * 4;
        P6Epi E6; E6.GP = GP; E6.M = M;
        pg8::Gemm g6; g6.A = Y; g6.Bt = wbr; g6.M = TG; g6.N = DM; g6.K = 1536;
        pg8::gemm_phase<P6Epi, P7Sched, true, true>((PG8_LAS unsigned char*)smem, g6, S6, E6);
      }
      GSYNC();
      {
        P7Sched S7; S7.vb = vb; S7.nb = nb; S7.ntiles = (TG / 256) * 4;
        P7Epi E7; E7.xres = xres; E7.xout = xout; E7.H = H; E7.g = p.in[16] + layer * DM; E7.XCH = XCH; E7.XCNT = XCNT; E7.want = 4u * (unsigned)(gi * NL + layer + 1); E7.smem = smem;
        pg8::Gemm g7; g7.A = M; g7.Bt = wout; g7.M = TG; g7.N = DM; g7.K = DM;
        pg8::gemm_phase<P7Epi, P7Sched, true, true>((PG8_LAS unsigned char*)smem, g7, S7, E7);
      }
      GSYNC();
      {
        P9Sched S9; S9.vb = vb; S9.nb = nb; S9.ntiles = (TG / 256) * 4;
        P9EpiX E9b; E9b.PE = PE; E9b.xout = xout;
        pg8::Gemm g9b; g9b.A = H; g9b.Bt = wpg; g9b.M = TG; g9b.N = DM; g9b.K = DM;
        pg8::gemm_phase<P9EpiX, P9Sched, false, true>((PG8_LAS unsigned char*)smem, g9b, S9, E9b);
      }
      GSYNC();
    }
  }
}

extern "C" void kernel_launch(void* const* d_in, const int* in_sizes, int n_in, void* d_out, int out_size, void* d_ws, size_t ws_size, hipStream_t stream) {
  static int grid_blocks = 0;
  if (!grid_blocks) {
    int dev = 0, cus = 0, per_cu = 0;
    (void)hipGetDevice(&dev);
    (void)hipDeviceGetAttribute(&cus, hipDeviceAttributeMultiprocessorCount, dev);
    (void)hipFuncSetAttribute((const void*)fwd_kernel, hipFuncAttributeMaxDynamicSharedMemorySize, LDS_BYTES);
    (void)hipOccupancyMaxActiveBlocksPerMultiprocessor(&per_cu, fwd_kernel, 512, LDS_BYTES);
    if (per_cu < 1) per_cu = 1;
    if (per_cu > 1) per_cu = 1;
    grid_blocks = cus * per_cu;
    grid_blocks -= grid_blocks % 8;
    if (ws_size < WS_END) fprintf(stderr, "kernel_launch: workspace too small: %zu < %zu\n", ws_size, (size_t)WS_END);
  }
  Params p{};
  for (int i = 0; i < 19; ++i) p.in[i] = (const float*)d_in[i];
  p.out = (float*)d_out;
  p.ws = (unsigned char*)d_ws;
  const float li[4] = {0.2f, 0.35550906759096926f, 0.47071301834358413f, 0.5560582041556852f};
  for (int i = 0; i < 4; ++i) p.lambda_init[i] = li[i];
  (void)hipMemsetAsync((char*)d_ws + WS_BAR, 0, 32768, stream);
  void* args[] = {&p};
  hipError_t e = hipLaunchCooperativeKernel((void*)fwd_kernel, dim3(grid_blocks), dim3(512), args, LDS_BYTES, stream);
  if (e != hipSuccess) fprintf(stderr, "cooperative launch failed: %s (grid %d)\n", hipGetErrorString(e), grid_blocks);
}
```
